# Optimizing an MI355X kernel written in HIP

```python
import math
import jax
import jax.numpy as jnp
from jax import lax
import numpy as np

D_MODEL = 2048
BATCH = 4
SEQ = 2048
DEPTH = 1
DEC_BATCH = 128
DEC_SEQ = 1
PAST_LEN = 16384
PAGE_SIZE = 128

HGRN_WIDTH = D_MODEL // 2
HGRN_HEAD_DIM = 128
HGRN_HEADS = HGRN_WIDTH // HGRN_HEAD_DIM
HGRN_CHUNK = 16
S5_WIDTH = D_MODEL - HGRN_WIDTH
S5_GROUP = 16
S5_GROUPS = S5_WIDTH // S5_GROUP
S5_STATE = 64
FFN_HIDDEN = -(-8 * D_MODEL // (3 * 256)) * 256
IN_PROJ_WIDTH = 4 * HGRN_WIDTH + S5_WIDTH + 2 * D_MODEL
RMS_EPS = 1e-6

kernel_name = 'hgrn2_s5_gated_hybrid_step'


def rmsnorm(x, g):
    xf = x.astype(jnp.float32)
    xf = xf * lax.rsqrt(jnp.mean(xf * xf, axis=-1, keepdims=True) + RMS_EPS)
    return (xf * g.astype(jnp.float32)).astype(x.dtype)


def hgrn_lower_bounds(lb_logits):
    return jnp.cumsum(jax.nn.softmax(lb_logits.astype(jnp.float32), axis=0), axis=0)


def hgrn2_recurrence(q, k, v, g, S0):
    Bsz, T, H, _ = q.shape
    C = min(HGRN_CHUNK, T)
    n_chunks = -(-T // C)
    pad = n_chunks * C - T

    def prep(a):
        a = jnp.pad(a, ((0, 0), (0, pad), (0, 0), (0, 0)))
        return a.reshape(Bsz, n_chunks, C, H, a.shape[-1]).transpose(1, 0, 3, 2, 4)

    qc, kc, vc, gc = prep(q), prep(k), prep(v), prep(g)
    b = jnp.cumsum(gc, axis=3)
    mid = C // 2
    b_mid = b[:, :, :, mid:mid + 1]
    b_last = b[:, :, :, -1:]
    scores = jnp.einsum('nbhtk,nbhsk->nbhts', qc * jnp.exp(b - b_mid), kc * jnp.exp(b_mid - b))
    causal = jnp.tril(jnp.ones((C, C), dtype=bool))
    scores = jnp.where(causal, scores, 0.0)
    o_intra = jnp.einsum('nbhts,nbhsv->nbhtv', scores, vc)
    q_in = qc * jnp.exp(b)
    k_upd = kc * jnp.exp(b_last - b)
    decay = jnp.exp(b_last[:, :, :, 0, :])

    def step(S, inp):
        q_i, k_u, v_i, dec = inp
        o_inter = jnp.einsum('bhtk,bhkv->bhtv', q_i, S)
        S = dec[..., None] * S + jnp.einsum('bhsk,bhsv->bhkv', k_u, v_i)
        return S, o_inter

    S_final, o_inter = lax.scan(step, S0, (q_in, k_upd, vc, decay))
    o = (o_intra + o_inter).transpose(1, 0, 3, 2, 4).reshape(Bsz, n_chunks * C, H, vc.shape[-1])[:, :T]
    return o, S_final


def s5_scan(u, lam_re, lam_im, log_dt, B_re, B_im, C_re, C_im, d_skip, h0_re, h0_im):
    dt = jnp.exp(log_dt)[:, None]
    mag = jnp.exp(lam_re * dt)
    ab_re = mag * jnp.cos(lam_im * dt)
    ab_im = mag * jnp.sin(lam_im * dt)
    den = lam_re * lam_re + lam_im * lam_im
    nr = ab_re - 1.0
    ni = ab_im
    z_re = (nr * lam_re + ni * lam_im) / den
    z_im = (ni * lam_re - nr * lam_im) / den
    bb_re = z_re[:, :, None] * B_re - z_im[:, :, None] * B_im
    bb_im = z_re[:, :, None] * B_im + z_im[:, :, None] * B_re
    bu_re = jnp.einsum('gnp,btgp->btgn', bb_re, u)
    bu_im = jnp.einsum('gnp,btgp->btgn', bb_im, u)
    bu_re = bu_re.at[:, 0].add(ab_re * h0_re - ab_im * h0_im)
    bu_im = bu_im.at[:, 0].add(ab_re * h0_im + ab_im * h0_re)
    T = u.shape[1]
    a_re = jnp.broadcast_to(ab_re, (1, T) + ab_re.shape)
    a_im = jnp.broadcast_to(ab_im, (1, T) + ab_im.shape)

    def combine(e1, e2):
        a1r, a1i, b1r, b1i = e1
        a2r, a2i, b2r, b2i = e2
        return (a2r * a1r - a2i * a1i,
                a2r * a1i + a2i * a1r,
                a2r * b1r - a2i * b1i + b2r,
                a2r * b1i + a2i * b1r + b2i)

    _, _, h_re, h_im = lax.associative_scan(combine, (a_re, a_im, bu_re, bu_im), axis=1)
    y = (jnp.einsum('gpn,btgn->btgp', C_re, h_re) - jnp.einsum('gpn,btgn->btgp', C_im, h_im)
         + d_skip.reshape(S5_GROUPS, S5_GROUP) * u)
    return y, h_re[:, -1], h_im[:, -1]


def decoder_layer(x, S0, h0_re, h0_im, l, w):
    Bsz, T, _ = x.shape
    f32 = jnp.float32
    h = rmsnorm(x, w['norm1_g'][l])
    proj = h @ w['w_in'][l]
    hw = HGRN_WIDTH
    splits = [hw, 2 * hw, 3 * hw, 4 * hw, 4 * hw + S5_WIDTH, 4 * hw + S5_WIDTH + D_MODEL]
    q, f_logit, i_in, og, u_in, gate_a, gate_b = jnp.split(proj, splits, axis=-1)

    lb = hgrn_lower_bounds(w['lb_logits'])[l]
    f = lb + (1.0 - lb) * jax.nn.sigmoid(f_logit.astype(f32))

    def heads(a):
        return a.astype(f32).reshape(Bsz, T, HGRN_HEADS, HGRN_HEAD_DIM)

    o_h, S_new = hgrn2_recurrence(heads(q), heads(1.0 - f), heads(i_in), heads(jnp.log(f)), S0.astype(f32))
    o_h = o_h * lax.rsqrt(jnp.mean(o_h * o_h, axis=-1, keepdims=True) + RMS_EPS)
    o_h = o_h * w['hgrn_norm_g'][l].astype(f32).reshape(HGRN_HEADS, HGRN_HEAD_DIM)
    o_a = (o_h.reshape(Bsz, T, hw) * jax.nn.silu(og.astype(f32))).astype(x.dtype)

    u = u_in.astype(f32).reshape(Bsz, T, S5_GROUPS, S5_GROUP)
    y5, h_re, h_im = s5_scan(u, w['s5_lam_re'][l].astype(f32), w['s5_lam_im'][l].astype(f32),
                             w['s5_log_dt'][l].astype(f32), w['s5_B_re'][l].astype(f32),
                             w['s5_B_im'][l].astype(f32), w['s5_C_re'][l].astype(f32),
                             w['s5_C_im'][l].astype(f32), w['s5_D'][l].astype(f32),
                             h0_re.astype(f32), h0_im.astype(f32))
    z = jax.nn.gelu(y5.reshape(Bsz, T, S5_WIDTH), approximate=False).astype(x.dtype)
    zg = z @ w['w_s5_glu'][l]
    o_b = zg[..., :S5_WIDTH] * jax.nn.sigmoid(zg[..., S5_WIDTH:])

    merged = (jax.nn.sigmoid(gate_a) * (o_a @ w['w_proj_a'][l])
              + jax.nn.sigmoid(gate_b) * (o_b @ w['w_proj_b'][l]))
    x = x + merged @ w['w_out'][l]

    h2 = rmsnorm(x, w['norm2_g'][l])
    up = h2 @ w['w_ffn_up'][l]
    x = x + (jax.nn.silu(up[..., :FFN_HIDDEN]) * up[..., FFN_HIDDEN:]) @ w['w_ffn_down'][l]
    return x, S_new, h_re, h_im


def setup_inputs(seed: int = 0) -> dict:
    key = jax.random.key(seed)
    ks = jax.random.split(key, 26)
    nrm = jax.random.normal
    L, D, hw, sw = DEPTH, D_MODEL, HGRN_WIDTH, S5_WIDTH
    G, N, P = S5_GROUPS, S5_STATE, S5_GROUP
    inp = {}
    inp['x_prompt'] = nrm(ks[0], (BATCH, SEQ, D), jnp.float32)
    inp['x_sample'] = nrm(ks[1], (DEC_BATCH, DEC_SEQ, D), jnp.float32)
    inp['state_hgrn'] = 0.3 * nrm(ks[2], (L, DEC_BATCH, HGRN_HEADS, HGRN_HEAD_DIM, HGRN_HEAD_DIM), jnp.float32)
    inp['state_s5_re'] = 0.1 * nrm(ks[3], (L, DEC_BATCH, G, N), jnp.float32)
    inp['state_s5_im'] = 0.1 * nrm(ks[4], (L, DEC_BATCH, G, N), jnp.float32)
    inp['lb_logits'] = 0.1 * nrm(ks[5], (L + 1, hw), jnp.float32)
    inp['norm1_g'] = 1.0 + 0.02 * nrm(ks[6], (L, D), jnp.float32)
    inp['w_in'] = nrm(ks[7], (L, D, IN_PROJ_WIDTH), jnp.float32) * D ** -0.5
    inp['hgrn_norm_g'] = 1.0 + 0.02 * nrm(ks[8], (L, hw), jnp.float32)
    inp['s5_lam_re'] = -0.5 + 0.01 * nrm(ks[9], (L, G, N), jnp.float32)
    inp['s5_lam_im'] = (math.pi * jnp.arange(N, dtype=jnp.float32))[None, None, :] + 0.01 * nrm(ks[10], (L, G, N), jnp.float32)
    inp['s5_log_dt'] = jax.random.uniform(ks[11], (L, G), jnp.float32, math.log(1e-3), math.log(1e-1))
    inp['s5_B_re'] = nrm(ks[12], (L, G, N, P), jnp.float32) * (2 * P) ** -0.5
    inp['s5_B_im'] = nrm(ks[13], (L, G, N, P), jnp.float32) * (2 * P) ** -0.5
    inp['s5_C_re'] = nrm(ks[14], (L, G, P, N), jnp.float32) * N ** -0.5
    inp['s5_C_im'] = nrm(ks[15], (L, G, P, N), jnp.float32) * N ** -0.5
    inp['s5_D'] = nrm(ks[16], (L, sw), jnp.float32)
    inp['w_s5_glu'] = nrm(ks[17], (L, sw, 2 * sw), jnp.float32) * sw ** -0.5
    inp['w_proj_a'] = nrm(ks[18], (L, hw, D), jnp.float32) * hw ** -0.5
    inp['w_proj_b'] = nrm(ks[19], (L, sw, D), jnp.float32) * sw ** -0.5
    inp['w_out'] = nrm(ks[20], (L, D, D), jnp.float32) * D ** -0.5
    inp['norm2_g'] = 1.0 + 0.02 * nrm(ks[21], (L, D), jnp.float32)
    inp['w_ffn_up'] = nrm(ks[22], (L, D, 2 * FFN_HIDDEN), jnp.float32) * D ** -0.5
    inp['w_ffn_down'] = nrm(ks[23], (L, FFN_HIDDEN, D), jnp.float32) * FFN_HIDDEN ** -0.5
    inp['final_norm_g'] = 1.0 + 0.02 * nrm(ks[24], (D,), jnp.float32)
    return inp


def reference(x_prompt, x_sample, state_hgrn, state_s5_re, state_s5_im, lb_logits, norm1_g, w_in,
              hgrn_norm_g, s5_lam_re, s5_lam_im, s5_log_dt, s5_B_re, s5_B_im, s5_C_re, s5_C_im, s5_D,
              w_s5_glu, w_proj_a, w_proj_b, w_out, norm2_g, w_ffn_up, w_ffn_down, final_norm_g):
    w = {'lb_logits': lb_logits, 'norm1_g': norm1_g, 'w_in': w_in, 'hgrn_norm_g': hgrn_norm_g,
         's5_lam_re': s5_lam_re, 's5_lam_im': s5_lam_im, 's5_log_dt': s5_log_dt,
         's5_B_re': s5_B_re, 's5_B_im': s5_B_im, 's5_C_re': s5_C_re, 's5_C_im': s5_C_im, 's5_D': s5_D,
         'w_s5_glu': w_s5_glu, 'w_proj_a': w_proj_a, 'w_proj_b': w_proj_b, 'w_out': w_out,
         'norm2_g': norm2_g, 'w_ffn_up': w_ffn_up, 'w_ffn_down': w_ffn_down}
    bp = x_prompt.shape[0]
    xp, xs = x_prompt, x_sample
    p_h, p_re, p_im, s_h, s_re, s_im = [], [], [], [], [], []
    for l in range(DEPTH):
        zero_h = jnp.zeros((bp, HGRN_HEADS, HGRN_HEAD_DIM, HGRN_HEAD_DIM), jnp.float32)
        zero_s5 = jnp.zeros((bp, S5_GROUPS, S5_STATE), jnp.float32)
        xp, sh, sr, si = decoder_layer(xp, zero_h, zero_s5, zero_s5, l, w)
        p_h.append(sh); p_re.append(sr); p_im.append(si)
        xs, sh, sr, si = decoder_layer(xs, state_hgrn[l], state_s5_re[l], state_s5_im[l], l, w)
        s_h.append(sh); s_re.append(sr); s_im.append(si)
    y_prompt = rmsnorm(xp, final_norm_g)
    y_sample = rmsnorm(xs, final_norm_g)
    return (y_prompt, y_sample, jnp.stack(p_h), jnp.stack(p_re), jnp.stack(p_im),
            jnp.stack(s_h), jnp.stack(s_re), jnp.stack(s_im))
```

```cpp
#include <hip/hip_runtime.h>
#include <hip/hip_cooperative_groups.h>
#include <cstdio>
#include <cstdint>
namespace cg = cooperative_groups;

#define DI __device__ __forceinline__
#define LAS __attribute__((address_space(3)))
typedef float f32x2 __attribute__((ext_vector_type(2)));
typedef __bf16 bf16x2_t __attribute__((ext_vector_type(2)));
typedef unsigned u32x2 __attribute__((ext_vector_type(2)));

constexpr int DM = 2048, TSEQ = 2048, NB = 4, TP = NB * TSEQ  , NSMP = 128, MV = TP + NSMP  , MP = 8448  ;
constexpr int HW = 1024, NH = 8, HD = 128, SW = 1024, SG = 64, SPC = 16, SN = 64, FF = 5632, NIN = 9216;
constexpr int C_Q = 0, C_F = 1024, C_I = 2048, C_OG = 3072, C_U = 4096, C_GA = 5120, C_GB = 7168;
constexpr float RMS_EPS = 1e-6f;
#ifndef MERGE_MID
#define MERGE_MID true
#endif

constexpr size_t MiB = 1u << 20;
constexpr size_t WS_R1 = 2 * MiB;
constexpr size_t WS_WIN = WS_R1, WS_XB = WS_R1 + 36 * MiB;
constexpr size_t WS_OL = WS_R1, WS_Z = WS_R1 + 32 * MiB;
constexpr size_t WS_X1 = WS_R1;
constexpr size_t WS_R2 = WS_R1 + 69 * MiB;
constexpr size_t WS_PB = WS_R2;
constexpr size_t WS_ACT = WS_R2, WS_X1B = WS_R2 + 91 * MiB;
constexpr size_t WS_R3 = WS_R2 + 148 * MiB + MiB / 2;
constexpr size_t WS_WGLU = WS_R3, WS_WCAT = WS_R3 + 4 * MiB, WS_WOUT = WS_R3 + 12 * MiB, WS_WUP = WS_R3 + 20 * MiB, WS_WDN = WS_R3 + 64 * MiB;
constexpr size_t WS_R4 = WS_R3 + 86 * MiB;
constexpr size_t WS_OAB = WS_R4, WS_MRG = WS_R4 + 33 * MiB;
constexpr size_t WS_USC = WS_MRG, WS_DSC = WS_MRG + 16 * MiB;
constexpr size_t WS_END = WS_R4 + 66 * MiB;
constexpr size_t WS_RS1 = 0, WS_SS2 = 64 * 1024, WS_SS3 = 128 * 1024, WS_LB = 192 * 1024, WS_PARA = 256 * 1024  , WS_PARB = 512 * 1024  , WS_PARC = 768 * 1024  ;

constexpr int LDS_BYTES = 147456;

DI float bflo(unsigned u) { return __uint_as_float(u << 16); }
DI float bfhi(unsigned u) { return __uint_as_float(u & 0xffff0000u); }
DI float bf2f(unsigned short b) { return __uint_as_float((unsigned)b << 16); }
DI unsigned pk2(float lo, float hi) { f32x2 v = {lo, hi}; bf16x2_t b = __builtin_convertvector(v, bf16x2_t); return __builtin_bit_cast(unsigned, b); }
DI unsigned short f2bf(float f) { return (unsigned short)(pk2(f, 0.f) & 0xffffu); }
DI float fexp(float x) { return __expf(x); }
DI float sigm(float x) { return __builtin_amdgcn_rcpf(1.f + __expf(-x)); }
DI float wave_sum(float v) {
#pragma unroll
    for (int o = 1; o < 64; o <<= 1) v += __shfl_xor(v, o);
    return v;
}

namespace pg8 {
#define PG8_LAS __attribute__((address_space(3)))
typedef unsigned short bf16_t;
typedef short bf16x8 __attribute__((ext_vector_type(8)));
typedef float f32x4 __attribute__((ext_vector_type(4)));
typedef unsigned u32x4 __attribute__((ext_vector_type(4)));
constexpr int BM = 256, BK = 64, HALF = 128, HTB = HALF * BK * 2  , STAGE_BYTES = 8 * HTB, NXCD = 8, WGM = 8;

__host__ __device__ __forceinline__ int lds_byte(int r, int c) { const int st = (r >> 4) * 2 + (c >> 5), rr = r & 15, cc = c & 31, ob = rr * 64 + cc * 2; return st * 1024 + (ob ^ (((ob >> 9) & 1) << 5)); }
__host__ __device__ __forceinline__ void stage_rc(int b, int& R, int& C) { const int st = b / 1024, sb = b % 1024, swz = sb ^ (((sb >> 9) & 1) << 5); R = (st >> 1) * 16 + swz / 64; C = (st & 1) * 32 + (swz % 64) / 2; }
__host__ __device__ __forceinline__ int perm32(int rho) { const int n = rho >> 4, i = rho & 15; return 8 * (i >> 2) + 4 * n + (i & 3); }

struct Unit { int pm, pn, kh; };
struct Gemm { const bf16_t* A; const bf16_t* Bt; int M, N, K, KL; };

struct StaticOrder {
    int nM, nN, nwg, G, c;
    __host__ __device__ void init(int M, int N, int G_, int c_) { nM = M / BM; nN = N / BM; nwg = nM * nN; G = G_; c = c_; }
    __host__ __device__ bool next(int i, Unit& u) const {
        const long L = (long)i * G + c; if (L >= nwg) return false;
        int wgid = (int)L; { const int q = nwg / NXCD, r = nwg % NXCD, xcd = wgid % NXCD, off = wgid / NXCD; wgid = (xcd < r ? xcd * (q + 1) : r * (q + 1) + (xcd - r) * q) + off; }
        const int nig = WGM * nN, gid = wgid / nig, fm = gid * WGM, gsz = (nM - fm) < WGM ? (nM - fm) : WGM;
        u.pm = fm + ((wgid % nig) % gsz); u.pn = (wgid % nig) / gsz; u.kh = 0; return true;
    }
    __device__ __forceinline__ void a_ready(const Unit&) const {}
    __device__ __forceinline__ void done(const Unit&) const {}
};

struct HalvedOrder {
    StaticOrder so;
    __host__ __device__ void init(int M, int N, int G_, int c_) { so.init(M, N, G_, c_); }
    __host__ __device__ bool next(int i, Unit& u) const { if (!so.next(i >> 1, u)) return false; u.kh = i & 1; return true; }
    __device__ __forceinline__ void a_ready(const Unit&) const {}
    __device__ __forceinline__ void done(const Unit&) const {}
};
__device__ __forceinline__ u32x4 pack8(f32x4 v0, f32x4 v1) { u32x4 w; w.x = ::pk2(v0[0], v0[1]); w.y = ::pk2(v0[2], v0[3]); w.z = ::pk2(v1[0], v1[1]); w.w = ::pk2(v1[2], v1[3]); return w; }
__device__ __forceinline__ void unpack8(u32x4 w, f32x4& v0, f32x4& v1) { v0 = (f32x4){::bflo(w.x), ::bfhi(w.x), ::bflo(w.y), ::bfhi(w.y)}; v1 = (f32x4){::bflo(w.z), ::bfhi(w.z), ::bflo(w.w), ::bfhi(w.w)}; }
__device__ __forceinline__ f32x4 sig4(f32x4 x) { return (f32x4){::sigm(x[0]), ::sigm(x[1]), ::sigm(x[2]), ::sigm(x[3])}; }

struct EpiIn {
    static constexpr bool PERM = true, AFTER_DRAIN = false, HAS_MID = false;
    bf16_t* O; const float* rs; int ldc;
    __device__ __forceinline__ void operator()(const f32x4 (&acc)[2][2][4][2], const Unit& u, int wr, int wc, int fr, int fq) const {
        const int row0 = u.pm * BM + wr * 64 + fr, col0 = u.pn * BM + wc * 32 + 8 * fq;
#pragma unroll
        for (int ai = 0; ai < 2; ++ai)
#pragma unroll
            for (int m = 0; m < 4; ++m) { const int row = row0 + ai * HALF + m * 16; const float s = rs[row]; bf16_t* rowp = O + (size_t)row * ldc + col0;
#pragma unroll
                for (int bj = 0; bj < 2; ++bj) *(u32x4*)(rowp + bj * HALF) = pack8(acc[ai][bj][m][0] * s, acc[ai][bj][m][1] * s); }
    }
};
struct EpiGlu {
    static constexpr bool PERM = true, AFTER_DRAIN = false, HAS_MID = false;
    bf16_t* O; int ldc;
    __device__ __forceinline__ void operator()(const f32x4 (&acc)[2][2][4][2], const Unit& u, int wr, int wc, int fr, int fq) const {
        const int row0 = u.pm * BM + wr * 64 + fr, col0 = u.pn * HALF + wc * 32 + 8 * fq;
#pragma unroll
        for (int ai = 0; ai < 2; ++ai)
#pragma unroll
            for (int m = 0; m < 4; ++m) { const int row = row0 + ai * HALF + m * 16;
                *(u32x4*)(O + (size_t)row * ldc + col0) = pack8(acc[ai][0][m][0] * sig4(acc[ai][1][m][0]), acc[ai][0][m][1] * sig4(acc[ai][1][m][1])); }
    }
};
struct EpiMerge {
    static constexpr bool PERM = true, AFTER_DRAIN = false, HAS_MID = MERGE_MID;
    bf16_t* O; const bf16_t* P; int ldp; int cga, cgb; int ldc;
    __device__ __forceinline__ void mid(f32x4 (&acc)[2][2][4][2], const Unit& u, int wr, int wc, int fr, int fq) const {
        const int row0 = u.pm * BM + wr * 64 + fr, col0 = u.pn * BM + wc * 32 + 8 * fq;
#pragma unroll
        for (int ai = 0; ai < 2; ++ai)
#pragma unroll
            for (int m = 0; m < 4; ++m) { const int row = row0 + ai * HALF + m * 16; const bf16_t* pr = P + (size_t)row * ldp + col0;
#pragma unroll
                for (int bj = 0; bj < 2; ++bj) { f32x4 a0, a1, b0, b1; unpack8(*(const u32x4*)(pr + cga + bj * HALF), a0, a1); unpack8(*(const u32x4*)(pr + cgb + bj * HALF), b0, b1);
#pragma unroll
                    for (int i = 0; i < 4; ++i) { acc[ai][bj][m][0][i] *= (1.f + __expf(-b0[i])) * __builtin_amdgcn_rcpf(1.f + __expf(-a0[i])); acc[ai][bj][m][1][i] *= (1.f + __expf(-b1[i])) * __builtin_amdgcn_rcpf(1.f + __expf(-a1[i])); } }
                asm volatile("" ::: "memory"); }
    }
    __device__ __forceinline__ void operator()(const f32x4 (&acc)[2][2][4][2], const Unit& u, int wr, int wc, int fr, int fq) const {
        const int row0 = u.pm * BM + wr * 64 + fr, col0 = u.pn * BM + wc * 32 + 8 * fq;
#pragma unroll
        for (int ai = 0; ai < 2; ++ai)
#pragma unroll
            for (int m = 0; m < 4; ++m) { const int row = row0 + ai * HALF + m * 16; const bf16_t* pr = P + (size_t)row * ldp + col0 + cgb; bf16_t* rowp = O + (size_t)row * ldc + col0;
#pragma unroll
                for (int bj = 0; bj < 2; ++bj) { f32x4 b0, b1; unpack8(*(const u32x4*)(pr + bj * HALF), b0, b1);
                    *(u32x4*)(rowp + bj * HALF) = pack8(acc[ai][bj][m][0] * sig4(b0), acc[ai][bj][m][1] * sig4(b1)); }
                asm volatile("" ::: "memory"); }
    }
};
template <bool WRITE_BF16> struct EpiRes {
    static constexpr bool PERM = true, AFTER_DRAIN = false, HAS_MID = false;
    const float* base0; const float* base1; int split;
    float* out; bf16_t* ob; float* ss; int nvalid; int ldc;
    __device__ __forceinline__ void operator()(const f32x4 (&acc)[2][2][4][2], const Unit& u, int wr, int wc, int fr, int fq) const {
        const int row0 = u.pm * BM + wr * 64 + fr, col0 = u.pn * BM + wc * 32 + 8 * fq;
#pragma unroll
        for (int ai = 0; ai < 2; ++ai)
#pragma unroll
            for (int m = 0; m < 4; ++m) { const int row = row0 + ai * HALF + m * 16;
                if (row < nvalid) {
                    const float* bp = (row < split ? base0 + (size_t)row * ldc : base1 + (size_t)(row - split) * ldc) + col0; float* op = out + (size_t)row * ldc + col0; float s = 0.f;
#pragma unroll
                    for (int bj = 0; bj < 2; ++bj) { const f32x4 x0 = *(const f32x4*)(bp + bj * HALF), x1 = *(const f32x4*)(bp + bj * HALF + 4);
                        const f32x4 y0 = x0 + acc[ai][bj][m][0], y1 = x1 + acc[ai][bj][m][1];
                        *(f32x4*)(op + bj * HALF) = y0; *(f32x4*)(op + bj * HALF + 4) = y1;
                        if (WRITE_BF16) *(u32x4*)(ob + (size_t)row * ldc + col0 + bj * HALF) = pack8(y0, y1);
                        s += (y0[0] * y0[0] + y0[1] * y0[1]) + (y0[2] * y0[2] + y0[3] * y0[3]) + (y1[0] * y1[0] + y1[1] * y1[1]) + (y1[2] * y1[2] + y1[3] * y1[3]); }
                    s += __shfl_xor(s, 16); s += __shfl_xor(s, 32);
                    if (fq == 0) atomicAdd(ss + row, s);
                } }
    }
};
struct EpiSwiGlu {
    static constexpr bool PERM = true, AFTER_DRAIN = false, HAS_MID = false;
    bf16_t* O; const float* ss; int ldc;
    __device__ __forceinline__ void operator()(const f32x4 (&acc)[2][2][4][2], const Unit& u, int wr, int wc, int fr, int fq) const {
        const int row0 = u.pm * BM + wr * 64 + fr, col0 = u.pn * HALF + wc * 32 + 8 * fq;
#pragma unroll
        for (int ai = 0; ai < 2; ++ai)
#pragma unroll
            for (int m = 0; m < 4; ++m) { const int row = row0 + ai * HALF + m * 16; const float r = __builtin_amdgcn_rsqf(ss[row] * (1.0f / 2048.0f) + 1e-6f);
                const f32x4 a0 = acc[ai][0][m][0] * r, a1 = acc[ai][0][m][1] * r, b0 = acc[ai][1][m][0] * r, b1 = acc[ai][1][m][1] * r;
                *(u32x4*)(O + (size_t)row * ldc + col0) = pack8(a0 * sig4(a0) * b0, a1 * sig4(a1) * b1); }
    }
};
template <class Epi, class Sched, bool ALIGN_EPI = false, bool SP2 = false>
__device__ __forceinline__ void gemm_phase(PG8_LAS unsigned char* lds, const Gemm g, const Sched& S, const Epi& E) {
    const int tid = threadIdx.x, wid = __builtin_amdgcn_readfirstlane(tid >> 6), lane = tid & 63, wr = wid >> 2, wc = wid & 3, fr = lane & 15, fq = lane >> 4;
    const int K = g.K, nt = g.KL / BK; const size_t khb = (size_t)g.KL * 2;
    unsigned voffA[2], voffB[2];
#pragma unroll
    for (int i = 0; i < 2; ++i) { int R, C; stage_rc(tid * 16 + i * 8192, R, C); const int Rb = Epi::PERM ? ((R & ~31) + perm32(R & 31)) : R;
        voffA[i] = (unsigned)(R * K + C) * 2u; voffB[i] = (unsigned)(Rb * K + C) * 2u; }
    const size_t kstep = (size_t)(BK * 2);
    const size_t hstep = (size_t)HALF * K * 2;
    const size_t tstep = 2 * hstep;
    const unsigned ldsw = (unsigned)wid * 1024u;
    const int aoff = lds_byte(wr * 64 + fr, fq * 8), boff = lds_byte(wc * 32 + fr, fq * 8);
#define PG8_SA(b, h) (((b) * 2 + (h)) * HTB)
#define PG8_SB(b, h) ((4 + (b) * 2 + (h)) * HTB)
#define PG8_STAGE(bufoff, gbase, voff) do { _Pragma("unroll") for (int _i = 0; _i < 2; ++_i) \
        __builtin_amdgcn_global_load_lds((const unsigned*)((const char*)(gbase) + (voff)[_i]), (PG8_LAS unsigned*)(lds + (bufoff) + ldsw + _i * 8192), 16, 0, 0); } while (0)
#define PG8_LDA(dst, b, h) do { _Pragma("unroll") for (int m = 0; m < 4; ++m) _Pragma("unroll") for (int k = 0; k < 2; ++k) dst[m][k] = *(const PG8_LAS bf16x8*)(lds + PG8_SA(b, h) + aoff + m * 2048 + k * 1024); } while (0)
#define PG8_LDB(dst, b, h) do { _Pragma("unroll") for (int n = 0; n < 2; ++n) _Pragma("unroll") for (int k = 0; k < 2; ++k) dst[n][k] = *(const PG8_LAS bf16x8*)(lds + PG8_SB(b, h) + boff + n * 2048 + k * 1024); } while (0)
#define PG8_MMA(ai, bj, At, Bt) do { __builtin_amdgcn_s_setprio(1); _Pragma("unroll") for (int m = 0; m < 4; ++m) _Pragma("unroll") for (int n = 0; n < 2; ++n) _Pragma("unroll") for (int k = 0; k < 2; ++k) \
        acc[ai][bj][m][n] = __builtin_amdgcn_mfma_f32_16x16x32_bf16(Bt[n][k], At[m][k], acc[ai][bj][m][n], 0, 0, 0); __builtin_amdgcn_s_setprio(0); } while (0)
#define PG8_WAIT_V(n) asm volatile("s_waitcnt vmcnt(" #n ")" ::: "memory")
#define PG8_WAIT_L(n) asm volatile("s_waitcnt lgkmcnt(" #n ")" ::: "memory")
#define PG8_BAR __builtin_amdgcn_s_barrier()
#define PG8_SCHED __builtin_amdgcn_sched_barrier(0)
    Unit cur, nxt; int ui = 0;
    if (!S.next(0, cur)) return;
    f32x4 acc[2][2][4][2];
#pragma unroll
    for (int a = 0; a < 2; ++a)
#pragma unroll
        for (int b = 0; b < 2; ++b)
#pragma unroll
            for (int m = 0; m < 4; ++m)
#pragma unroll
                for (int n = 0; n < 2; ++n) acc[a][b][m][n] = (f32x4){0.f, 0.f, 0.f, 0.f};
    bf16x8 At[4][2], B0[2][2], B1[2][2];
    const char* cA = (const char*)g.A + (size_t)cur.pm * tstep + cur.kh * khb; const char* cB = (const char*)g.Bt + (size_t)cur.pn * tstep + cur.kh * khb;
    S.a_ready(cur);
    if constexpr (SP2) {
        PG8_STAGE(PG8_SB(0, 0), cB, voffB); PG8_STAGE(PG8_SB(0, 1), cB + hstep, voffB); PG8_STAGE(PG8_SA(0, 0), cA, voffA); PG8_STAGE(PG8_SA(0, 1), cA + hstep, voffA);
        if (wr == 1) PG8_BAR;
        PG8_WAIT_V(2); PG8_BAR;
        PG8_STAGE(PG8_SB(1, 0), cB + kstep, voffB); PG8_STAGE(PG8_SA(1, 0), cA + kstep, voffA); PG8_STAGE(PG8_SB(1, 1), cB + hstep + kstep, voffB);
        PG8_WAIT_V(6); PG8_BAR;
    } else {
        PG8_STAGE(PG8_SB(0, 0), cB, voffB); PG8_STAGE(PG8_SA(0, 0), cA, voffA); PG8_STAGE(PG8_SB(0, 1), cB + hstep, voffB); PG8_STAGE(PG8_SA(0, 1), cA + hstep, voffA);
        if (wr == 1) PG8_BAR;
        PG8_WAIT_V(4); PG8_BAR;
        PG8_STAGE(PG8_SB(1, 0), cB + kstep, voffB); PG8_STAGE(PG8_SA(1, 0), cA + kstep, voffA); PG8_STAGE(PG8_SB(1, 1), cB + hstep + kstep, voffB);
        PG8_WAIT_V(6); PG8_BAR;
    }
    for (;;) {
        const bool has_next = S.next(ui + 1, nxt);
        const char* nA = has_next ? (const char*)g.A + (size_t)nxt.pm * tstep + nxt.kh * khb : cA; const char* nB = has_next ? (const char*)g.Bt + (size_t)nxt.pn * tstep + nxt.kh * khb : cB;
        for (int t = 0; t < nt; t += 2) {
            const bool last = (t == nt - 2);
            const char* a1 = cA + (size_t)(t + 1) * kstep;
            const char* a2 = last ? nA : cA + (size_t)(t + 2) * kstep; const char* b2 = last ? nB : cB + (size_t)(t + 2) * kstep;
            const char* a3 = a2 + kstep; const char* b3 = b2 + kstep;
            if (last && has_next) S.a_ready(nxt);
            if constexpr (SP2) {
            PG8_LDB(B0, 0, 0); PG8_LDB(B1, 0, 1); PG8_SCHED; PG8_LDA(At, 0, 0); PG8_STAGE(PG8_SA(1, 1), a1 + hstep, voffA);
            PG8_WAIT_V(8); PG8_WAIT_L(0); PG8_BAR; PG8_MMA(0, 0, At, B0); PG8_MMA(0, 1, At, B1); PG8_BAR; PG8_SCHED;
            PG8_LDA(At, 0, 1); PG8_STAGE(PG8_SB(0, 0), b2, voffB); PG8_STAGE(PG8_SB(0, 1), b2 + hstep, voffB); PG8_STAGE(PG8_SA(0, 0), a2, voffA);
            PG8_WAIT_V(8); PG8_WAIT_L(0); PG8_BAR; PG8_MMA(1, 0, At, B0); PG8_MMA(1, 1, At, B1); PG8_BAR; PG8_SCHED;
            PG8_LDB(B0, 1, 0); PG8_LDB(B1, 1, 1); PG8_SCHED; PG8_LDA(At, 1, 0); PG8_STAGE(PG8_SA(0, 1), a2 + hstep, voffA);
            PG8_WAIT_V(8); PG8_WAIT_L(0); PG8_BAR; PG8_MMA(0, 0, At, B0); PG8_MMA(0, 1, At, B1); PG8_BAR; PG8_SCHED;
            PG8_LDA(At, 1, 1); PG8_STAGE(PG8_SB(1, 0), b3, voffB); PG8_STAGE(PG8_SB(1, 1), b3 + hstep, voffB); PG8_STAGE(PG8_SA(1, 0), a3, voffA);
            PG8_WAIT_V(8); PG8_WAIT_L(0); PG8_BAR; PG8_MMA(1, 0, At, B0); PG8_MMA(1, 1, At, B1); PG8_BAR; PG8_SCHED;
            } else {
            PG8_LDB(B0, 0, 0); PG8_SCHED; PG8_LDA(At, 0, 0); PG8_STAGE(PG8_SA(1, 1), a1 + hstep, voffA);
            PG8_WAIT_L(8); PG8_BAR; PG8_WAIT_L(0); PG8_MMA(0, 0, At, B0); PG8_BAR; PG8_SCHED;
            PG8_LDB(B1, 0, 1); PG8_STAGE(PG8_SB(0, 0), b2, voffB);
            PG8_BAR; PG8_WAIT_L(0); PG8_MMA(0, 1, At, B1); PG8_BAR;
            PG8_LDA(At, 0, 1); PG8_STAGE(PG8_SA(0, 0), a2, voffA);
            PG8_BAR; PG8_WAIT_L(0); PG8_MMA(1, 0, At, B0); PG8_BAR; PG8_SCHED;
            PG8_STAGE(PG8_SB(0, 1), b2 + hstep, voffB);
            PG8_WAIT_V(6); PG8_BAR; PG8_MMA(1, 1, At, B1); PG8_BAR;
            PG8_LDB(B0, 1, 0); PG8_SCHED; PG8_LDA(At, 1, 0); PG8_STAGE(PG8_SA(0, 1), a2 + hstep, voffA);
            PG8_WAIT_L(8); PG8_BAR; PG8_WAIT_L(0); PG8_MMA(0, 0, At, B0); PG8_BAR; PG8_SCHED;
            PG8_LDB(B1, 1, 1); PG8_STAGE(PG8_SB(1, 0), b3, voffB);
            PG8_BAR; PG8_WAIT_L(0); PG8_MMA(0, 1, At, B1); PG8_BAR;
            PG8_LDA(At, 1, 1); PG8_STAGE(PG8_SA(1, 0), a3, voffA);
            PG8_BAR; PG8_WAIT_L(0); PG8_MMA(1, 0, At, B0); PG8_BAR; PG8_SCHED;
            PG8_STAGE(PG8_SB(1, 1), b3 + hstep, voffB);
            PG8_WAIT_V(6); PG8_BAR; PG8_MMA(1, 1, At, B1); PG8_BAR;
            }
        }
        if constexpr (ALIGN_EPI) { if (wr == 0) PG8_BAR; }
        bool keep = false;
        if constexpr (Epi::HAS_MID) { if (cur.kh == 0) { E.mid(acc, cur, wr, wc, fr, fq); keep = true; } }
        if (!keep) { if constexpr (!Epi::AFTER_DRAIN) { E(acc, cur, wr, wc, fr, fq); S.done(cur); } }
        if (!has_next) break;
        if (!keep) {
#pragma unroll
        for (int a = 0; a < 2; ++a)
#pragma unroll
            for (int b = 0; b < 2; ++b)
#pragma unroll
                for (int m = 0; m < 4; ++m)
#pragma unroll
                    for (int n = 0; n < 2; ++n) acc[a][b][m][n] = (f32x4){0.f, 0.f, 0.f, 0.f};
        }
        cur = nxt; cA = nA; cB = nB; ++ui;
        if constexpr (ALIGN_EPI) { if (wr == 1) PG8_BAR; }
    }
    PG8_WAIT_V(0);
    if constexpr (!ALIGN_EPI) { if (wr == 0) PG8_BAR; }
    PG8_BAR;
    if constexpr (Epi::AFTER_DRAIN) { E.fused(acc, cur, wr, wc, fr, fq, lds, wid, lane); S.done(cur); }
#undef PG8_SA
#undef PG8_SB
#undef PG8_STAGE
#undef PG8_LDA
#undef PG8_LDB
#undef PG8_MMA
#undef PG8_WAIT_V
#undef PG8_WAIT_L
#undef PG8_BAR
#undef PG8_SCHED
}
}

typedef unsigned short bf16;
typedef unsigned v4u __attribute__((ext_vector_type(4)));
typedef float f32x4 __attribute__((ext_vector_type(4)));
typedef short bf16x8 __attribute__((ext_vector_type(8)));
constexpr int NWAVES = 8, NTHR = 512;
#define MFMA16(a, b, c) __builtin_amdgcn_mfma_f32_16x16x32_bf16((a), (b), (c), 0, 0, 0)
#define LDS_FENCE() asm volatile("s_waitcnt lgkmcnt(0)" ::: "memory")

struct Args {
    const float* in[25]; float* out; unsigned char* ws; int ph_lo, ph_hi;
};
struct Frame {
    LAS unsigned char* lds; int tid, lane, wave, G, bid;
    const float* in[25]; float* out; unsigned char* ws;
};
constexpr size_t O_YP = 0, O_YS = (size_t)TP * DM, O_HP = O_YS + (size_t)NSMP * DM, O_S5RP = O_HP + (size_t)NB * NH * HD * HD, O_S5IP = O_S5RP + NB * SG * SN,
                 O_HS = O_S5IP + NB * SG * SN, O_S5RS = O_HS + (size_t)NSMP * NH * HD * HD, O_S5IS = O_S5RS + (size_t)NSMP * SG * SN, O_END = O_S5IS + (size_t)NSMP * SG * SN;
enum { I_XP = 0, I_XS, I_SH, I_SRE, I_SIM, I_LB, I_N1, I_WIN, I_HG, I_LRE, I_LIM, I_LDT, I_BRE, I_BIM, I_CRE, I_CIM, I_D, I_WGLU, I_WPA, I_WPB, I_WOUT, I_N2, I_WUP, I_WDN, I_NF };

DI void p0_transpose_item(const float* W, int K, int N, bf16* WT, int ldk, int koff, int glu_half, const float* gk, LAS float* scr, int item, int lane) {
    const int nblk = N / 32, kb = item / nblk, nb = item % nblk, k0 = 64 * kb, n0 = 32 * nb;
    int d0 = n0;
    if (glu_half) { const int hf = n0 >= glu_half ? 1 : 0, nn = n0 - hf * glu_half; d0 = (nn / 128) * 256 + hf * 128 + (nn % 128); }
#pragma unroll 8
    for (int i = 0; i < 32; ++i) { const int kk = 2 * i + (lane >> 5); float v = W[(size_t)(k0 + kk) * N + n0 + (lane & 31)]; if (gk) v *= gk[k0 + kk]; scr[kk * 33 + (lane & 31)] = v; }
    LDS_FENCE();
    const int c = lane & 7;
#pragma unroll
    for (int j = 0; j < 4; ++j) { const int n = (lane >> 3) + 8 * j; const LAS float* s = scr + (8 * c) * 33 + n;
        v4u o; o.x = pk2(s[0 * 33], s[1 * 33]); o.y = pk2(s[2 * 33], s[3 * 33]); o.z = pk2(s[4 * 33], s[5 * 33]); o.w = pk2(s[6 * 33], s[7 * 33]);
        *(v4u*)(WT + (size_t)(d0 + n) * ldk + koff + k0 + 8 * c) = o; }
    LDS_FENCE();
}
DI double exp_d(double x) {
    const double k = __builtin_rint(x * 1.4426950408889634); const double r = (x - k * 0.693147180369123816490e+00) - k * 1.90821492927058770002e-10;
    double p = 1.0 / 6227020800.0;
    p = p * r + 1.0 / 479001600.0; p = p * r + 1.0 / 39916800.0; p = p * r + 1.0 / 3628800.0; p = p * r + 1.0 / 362880.0; p = p * r + 1.0 / 40320.0; p = p * r + 1.0 / 5040.0;
    p = p * r + 1.0 / 720.0; p = p * r + 1.0 / 120.0; p = p * r + 1.0 / 24.0; p = p * r + 1.0 / 6.0; p = p * r + 0.5; p = p * r + 1.0; p = p * r + 1.0;
    const long long ki = (long long)k; const double sc = __builtin_bit_cast(double, (unsigned long long)(1023 + ki) << 52);
    return p * sc;
}
DI void sincos_d(double x, double& s, double& c) {
    const double k = __builtin_rint(x * 0.15915494309189535); double r = (x - k * 6.28318530717958623200e+00) - k * 2.44929359829470635445e-16;
    const double q = r * 0.25, q2 = q * q;
    double sp = -1.0 / 1307674368000.0; sp = sp * q2 + 1.0 / 6227020800.0; sp = sp * q2 - 1.0 / 39916800.0; sp = sp * q2 + 1.0 / 362880.0; sp = sp * q2 - 1.0 / 5040.0; sp = sp * q2 + 1.0 / 120.0; sp = sp * q2 - 1.0 / 6.0; sp = sp * q2 + 1.0;
    double cp = 1.0 / 20922789888000.0; cp = cp * q2 - 1.0 / 87178291200.0; cp = cp * q2 + 1.0 / 479001600.0; cp = cp * q2 - 1.0 / 3628800.0; cp = cp * q2 + 1.0 / 40320.0; cp = cp * q2 - 1.0 / 720.0; cp = cp * q2 + 1.0 / 24.0; cp = cp * q2 - 0.5; cp = cp * q2 + 1.0;
    double s1 = sp * q, c1 = cp;
    double s2 = 2.0 * s1 * c1, c2 = c1 * c1 - s1 * s1;
    s = 2.0 * s2 * c2; c = c2 * c2 - s2 * s2;
}
DI void p0_prologue(Frame& F) {
    LAS float* scr = (LAS float*)(F.lds + F.wave * 16384);
    const int gw = F.bid * NWAVES + F.wave, NGW = F.G * NWAVES;
    bf16* Win_t = (bf16*)(F.ws + WS_WIN); bf16* Wglu_t = (bf16*)(F.ws + WS_WGLU); bf16* Wcat_t = (bf16*)(F.ws + WS_WCAT); bf16* Wout_t = (bf16*)(F.ws + WS_WOUT);
    bf16* Wup_t = (bf16*)(F.ws + WS_WUP); bf16* Wdn_t = (bf16*)(F.ws + WS_WDN);
    constexpr int IT_IN = (DM / 64) * (NIN / 32), IT_GLU = (SW / 64) * (2 * SW / 32), IT_PA = (HW / 64) * (DM / 32), IT_PB = (SW / 64) * (DM / 32), IT_OUT = (DM / 64) * (DM / 32),
                  IT_UP = (DM / 64) * (2 * FF / 32), IT_DN = (FF / 64) * (DM / 32), NITEMS = IT_IN + IT_GLU + IT_PA + IT_PB + IT_OUT + IT_UP + IT_DN;
    for (int it = gw; it < NITEMS; it += NGW) {
        int r = it;
        if (r < IT_UP) { p0_transpose_item(F.in[I_WUP], DM, 2 * FF, Wup_t, DM, 0, FF, F.in[I_N2], scr, r, F.lane); continue; } r -= IT_UP;
        if (r < IT_IN) { p0_transpose_item(F.in[I_WIN], DM, NIN, Win_t, DM, 0, 0, F.in[I_N1], scr, r, F.lane); continue; } r -= IT_IN;
        if (r < IT_DN) { p0_transpose_item(F.in[I_WDN], FF, DM, Wdn_t, FF, 0, 0, nullptr, scr, r, F.lane); continue; } r -= IT_DN;
        if (r < IT_OUT) { p0_transpose_item(F.in[I_WOUT], DM, DM, Wout_t, DM, 0, 0, nullptr, scr, r, F.lane); continue; } r -= IT_OUT;
        if (r < IT_GLU) { p0_transpose_item(F.in[I_WGLU], SW, 2 * SW, Wglu_t, SW, 0, SW, nullptr, scr, r, F.lane); continue; } r -= IT_GLU;
        if (r < IT_PA) { p0_transpose_item(F.in[I_WPA], HW, DM, Wcat_t, 2048, 0, 0, nullptr, scr, r, F.lane); continue; } r -= IT_PA;
        p0_transpose_item(F.in[I_WPB], SW, DM, Wcat_t, 2048, 1024, 0, nullptr, scr, r, F.lane);
    }
    bf16* xb = (bf16*)(F.ws + WS_XB); float* rs1 = (float*)(F.ws + WS_RS1);
    for (int m = gw; m < MP; m += NGW) {
        unsigned long long* o8 = (unsigned long long*)(xb + (size_t)m * DM) + F.lane;
        if (m < MV) {
            const float* xr = m < TP ? F.in[I_XP] + (size_t)m * DM : F.in[I_XS] + (size_t)(m - TP) * DM;
            const f32x4* x4 = (const f32x4*)xr + F.lane; f32x4 v[8]; float s = 0.f;
#pragma unroll
            for (int j = 0; j < 8; ++j) { v[j] = x4[64 * j]; s += (v[j].x * v[j].x + v[j].y * v[j].y) + (v[j].z * v[j].z + v[j].w * v[j].w); }
            s = wave_sum(s);
            if (F.lane == 0) rs1[m] = 1.0f / sqrtf(s * (1.0f / DM) + RMS_EPS);
#pragma unroll
            for (int j = 0; j < 8; ++j) o8[64 * j] = (unsigned long long)pk2(v[j].x, v[j].y) | ((unsigned long long)pk2(v[j].z, v[j].w) << 32);
        } else {
            if (F.lane == 0) rs1[m] = 0.f;
#pragma unroll
            for (int j = 0; j < 8; ++j) o8[64 * j] = 0ull;
        }
    }
    { float* ss2 = (float*)(F.ws + WS_SS2); float* ss3 = (float*)(F.ws + WS_SS3); float* lb = (float*)(F.ws + WS_LB);
      for (int i = F.bid * NTHR + F.tid; i < MP; i += F.G * NTHR) { ss2[i] = 0.f; ss3[i] = 0.f; }
      for (int i = F.bid * NTHR + F.tid; i < HW; i += F.G * NTHR) { const float l0 = F.in[I_LB][i], l1 = F.in[I_LB][HW + i]; lb[i] = 1.0f / (1.0f + expf(l1 - l0)); } }
    for (int g = gw; g < SG; g += NGW) {
        const int n = F.lane;
        const double dt = exp_d((double)F.in[I_LDT][g]);
        const double lr = (double)F.in[I_LRE][g * SN + n], li = (double)F.in[I_LIM][g * SN + n];
        const double mag = exp_d(lr * dt); double sn, cs; sincos_d(li * dt, sn, cs);
        const double are = mag * cs, aim = mag * sn, den = lr * lr + li * li, nr = are - 1.0, ni = aim;
        const double zre = (nr * lr + ni * li) / den, zim = (ni * lr - nr * li) / den;
        double pr = are, pi = aim;
#pragma unroll 1
        for (int i = 0; i < 8; ++i) { const double t = pr * pr - pi * pi; pi = 2.0 * pr * pi; pr = t; }
        float* pa = (float*)(F.ws + WS_PARA) + (size_t)g * 256;
        pa[n] = (float)are; pa[64 + n] = (float)aim; pa[128 + n] = (float)pr; pa[192 + n] = (float)pi;
        bf16* pb = (bf16*)(F.ws + WS_PARB) + (size_t)g * 2048;
        const float* Bre = F.in[I_BRE] + ((size_t)g * SN + n) * SPC; const float* Bim = F.in[I_BIM] + ((size_t)g * SN + n) * SPC;
#pragma unroll
        for (int p = 0; p < SPC; ++p) { const double br = (double)Bre[p], bi = (double)Bim[p];
            pb[n * 16 + p] = f2bf((float)(zre * br - zim * bi)); pb[(64 + n) * 16 + p] = f2bf((float)(zre * bi + zim * br)); }
        bf16* pc = (bf16*)(F.ws + WS_PARC) + (size_t)g * 2048;
#pragma unroll
        for (int p = 0; p < SPC; ++p) { pc[p * 128 + n] = f2bf(F.in[I_CRE][((size_t)g * SPC + p) * SN + n]); pc[p * 128 + 64 + n] = f2bf(-F.in[I_CIM][((size_t)g * SPC + p) * SN + n]); }
    }
}

DI float gelu1(float v) {
    const float av = fabsf(v), t = __builtin_amdgcn_rcpf(av * 0.2316418882f + 1.0f);
    float q = t * 0.5307027145f + (-0.7265760135f); q = q * t + 0.7107068705f; q = q * t + (-0.142248368f); q = q * t + 0.127414796f; q = q * t;
    const float e = __builtin_amdgcn_exp2f((v * v) * (-0.72134752044f));
    const float m = v * (q * e);
    return v < 0.f ? m : v - m;
}

constexpr int S5_BU_STRIDE = 132  , S5_H_STRIDE = 272  , S5_WAVE_BYTES = 16 * S5_BU_STRIDE * 4 + 16 * S5_H_STRIDE  , S5_HE_OFF = 8 * S5_WAVE_BYTES;
DI void s5_prompt_unit(Frame& F, int unit) {
    const int b = unit >> 6, g = unit & 63, lane = F.lane, w = F.wave, r16 = lane & 15, q4 = lane >> 4;
    LAS float* BU = (LAS float*)(F.lds + w * S5_WAVE_BYTES);
    LAS unsigned char* Hb = F.lds + w * S5_WAVE_BYTES + 16 * S5_BU_STRIDE * 4;
    LAS float* HE = (LAS float*)(F.lds + S5_HE_OFF);
    const bf16* Pb = (const bf16*)(F.ws + WS_PB);
    const float* pa = (const float*)(F.ws + WS_PARA) + (size_t)g * 256;
    const float ar = pa[lane], ai = pa[64 + lane], a256r = pa[128 + lane], a256i = pa[192 + lane];
    const bf16* pb = (const bf16*)(F.ws + WS_PARB) + (size_t)g * 2048; const bf16* pc = (const bf16*)(F.ws + WS_PARC) + (size_t)g * 2048;
    bf16x8 Bf[8], Cf[4];
    const bf16x8 zero8 = {0, 0, 0, 0, 0, 0, 0, 0};
#pragma unroll
    for (int nb = 0; nb < 8; ++nb) Bf[nb] = q4 < 2 ? *(const bf16x8*)(pb + (nb * 16 + r16) * 16 + 8 * q4) : zero8;
#pragma unroll
    for (int ks = 0; ks < 4; ++ks) Cf[ks] = *(const bf16x8*)(pc + r16 * 128 + ks * 32 + 8 * q4);
    const float dsk = F.in[I_D][g * 16 + r16];
    const size_t row0 = (size_t)b * TSEQ + w * 256;
    const bf16* ucol = Pb + C_U + g * 16;
    float hr = 0.f, hi = 0.f;
#pragma unroll 1
    for (int pass = 0; pass < 2; ++pass) {
        if (pass == 1) {
            HE[w * 128 + lane] = hr; HE[w * 128 + 64 + lane] = hi;
            __syncthreads();
            float cr = 0.f, ci = 0.f;
            for (int j = 0; j < w; ++j) { const float er = HE[j * 128 + lane], ei = HE[j * 128 + 64 + lane]; const float t = a256r * cr - a256i * ci + er; ci = a256r * ci + a256i * cr + ei; cr = t; }
            if (w == 7) { const float fr_ = a256r * cr - a256i * ci + hr, fi_ = a256r * ci + a256i * cr + hi;
                F.out[O_S5RP + ((size_t)b * SG + g) * SN + lane] = fr_; F.out[O_S5IP + ((size_t)b * SG + g) * SN + lane] = fi_; }
            hr = cr; hi = ci;
        }
#pragma unroll 1
        for (int tile = 0; tile < 16; ++tile) {
            const size_t trow = row0 + tile * 16;
            const bf16x8 uf = q4 < 2 ? *(const bf16x8*)(ucol + (trow + r16) * NIN + 8 * q4) : zero8;
#pragma unroll
            for (int nb = 0; nb < 8; ++nb) { f32x4 a = {0.f, 0.f, 0.f, 0.f}; a = MFMA16(uf, Bf[nb], a);
#pragma unroll
                for (int i = 0; i < 4; ++i) BU[(4 * q4 + i) * S5_BU_STRIDE + nb * 16 + r16] = a[i]; }
            LDS_FENCE();
            if (pass == 0) {
#pragma unroll
                for (int tt = 0; tt < 16; ++tt) { const float br = BU[tt * S5_BU_STRIDE + lane], bi = BU[tt * S5_BU_STRIDE + 64 + lane];
                    const float t = ar * hr - ai * hi + br; hi = ar * hi + ai * hr + bi; hr = t; }
                LDS_FENCE();
            } else {
#pragma unroll
                for (int tt = 0; tt < 16; ++tt) { const float br = BU[tt * S5_BU_STRIDE + lane], bi = BU[tt * S5_BU_STRIDE + 64 + lane];
                    const float t = ar * hr - ai * hi + br; hi = ar * hi + ai * hr + bi; hr = t;
                    *(LAS unsigned short*)(Hb + tt * S5_H_STRIDE + lane * 2) = f2bf(hr); *(LAS unsigned short*)(Hb + tt * S5_H_STRIDE + 128 + lane * 2) = f2bf(hi); }
                LDS_FENCE();
                f32x4 y = {0.f, 0.f, 0.f, 0.f};
#pragma unroll
                for (int ks = 0; ks < 4; ++ks) { const bf16x8 hf = *(const LAS bf16x8*)(Hb + r16 * S5_H_STRIDE + (ks * 32 + 8 * q4) * 2); y = MFMA16(hf, Cf[ks], y); }
                bf16* Z = (bf16*)(F.ws + WS_Z);
#pragma unroll
                for (int i = 0; i < 4; ++i) { const size_t rr = trow + 4 * q4 + i; const float uv = bf2f(ucol[rr * NIN + r16]);
                    Z[rr * SW + g * 16 + r16] = f2bf(gelu1(y[i] + dsk * uv)); }
                LDS_FENCE();
            }
        }
    }
    __syncthreads();
}
DI void s5_sample_wave(Frame& F, int bs, int g) {
    const int lane = F.lane, r16 = lane & 15, q4 = lane >> 4;
    LAS float* hv = (LAS float*)(F.lds + F.wave * 512);
    const float* pa = (const float*)(F.ws + WS_PARA) + (size_t)g * 256; const float ar = pa[lane], ai = pa[64 + lane];
    const bf16* pb = (const bf16*)(F.ws + WS_PARB) + (size_t)g * 2048;
    const bf16* urow = (const bf16*)(F.ws + WS_PB) + (size_t)(TP + bs) * NIN + C_U + g * 16;
    const v4u u0 = *(const v4u*)urow, u1 = *(const v4u*)(urow + 8);
    const v4u bre0 = *(const v4u*)(pb + lane * 16), bre1 = *(const v4u*)(pb + lane * 16 + 8), bim0 = *(const v4u*)(pb + (64 + lane) * 16), bim1 = *(const v4u*)(pb + (64 + lane) * 16 + 8);
    float br = 0.f, bi = 0.f;
#define S5ACC(uw, rw, iw) { br += bflo(uw) * bflo(rw) + bfhi(uw) * bfhi(rw); bi += bflo(uw) * bflo(iw) + bfhi(uw) * bfhi(iw); }
    S5ACC(u0.x, bre0.x, bim0.x) S5ACC(u0.y, bre0.y, bim0.y) S5ACC(u0.z, bre0.z, bim0.z) S5ACC(u0.w, bre0.w, bim0.w)
    S5ACC(u1.x, bre1.x, bim1.x) S5ACC(u1.y, bre1.y, bim1.y) S5ACC(u1.z, bre1.z, bim1.z) S5ACC(u1.w, bre1.w, bim1.w)
#undef S5ACC
    const size_t so = ((size_t)bs * SG + g) * SN + lane;
    const float h0r = F.in[I_SRE][so], h0i = F.in[I_SIM][so];
    const float hr = ar * h0r - ai * h0i + br, hi = ar * h0i + ai * h0r + bi;
    F.out[O_S5RS + so] = hr; F.out[O_S5IS + so] = hi;
    hv[lane] = hr; hv[64 + lane] = hi;
    LDS_FENCE();
    const float* cre = F.in[I_CRE] + ((size_t)g * SPC + r16) * SN + 16 * q4; const float* cim = F.in[I_CIM] + ((size_t)g * SPC + r16) * SN + 16 * q4;
    float y = 0.f;
#pragma unroll
    for (int j = 0; j < 16; ++j) y += cre[j] * hv[16 * q4 + j] - cim[j] * hv[64 + 16 * q4 + j];
    y += __shfl_xor(y, 16); y += __shfl_xor(y, 32);
    const float uv = bf2f(urow[r16]);
    if (q4 == 0) ((bf16*)(F.ws + WS_Z))[(size_t)(TP + bs) * SW + g * 16 + r16] = f2bf(gelu1(y + F.in[I_D][g * 16 + r16] * uv));
    LDS_FENCE();
}

constexpr int HQ_STRIDE = 272, HK_STRIDE = 80;
constexpr int L_QT = 0, L_KT = 8704, L_QIN = 17408, L_KU = 26112, L_VT = 36352, L_ST = 46592, L_SC = 81408, L_PT = 83968, L_G16 = 88064, L_DEC = 88576, L_HG_END = 89088;
DI void hgrn_local_unit(Frame& F, int unit) {
    const int b = unit >> 6, h = (unit >> 3) & 7, sc = unit & 7, lane = F.lane, w = F.wave, r16 = lane & 15, q4 = lane >> 4;
    LAS unsigned char* L = F.lds;
    bf16* Pb = (bf16*)(F.ws + WS_PB);
    float* OL = (float*)(F.ws + WS_OL);
    const float* lbp = (const float*)(F.ws + WS_LB) + h * HD + 2 * lane;
    const float lb0 = lbp[0], lb1 = lbp[1];
    const size_t urow0 = (size_t)b * TSEQ + sc * 256;
    f32x4 S[8];
#pragma unroll
    for (int kb = 0; kb < 8; ++kb) S[kb] = (f32x4){0.f, 0.f, 0.f, 0.f};
#pragma unroll
    for (int kb = 0; kb < 8; ++kb) *(LAS u32x2*)(L + L_ST + (w * 16 + r16) * HQ_STRIDE + (kb * 16 + 4 * q4) * 2) = (u32x2){0u, 0u};
    float Bp0 = 0.f, Bp1 = 0.f;
    unsigned qn[4], fn[4], vn[4];
#pragma unroll
    for (int j = 0; j < 4; ++j) { const bf16* rp = Pb + (urow0 + 4 * w + j) * NIN + h * HD + 2 * lane; qn[j] = *(const unsigned*)(rp + C_Q); fn[j] = *(const unsigned*)(rp + C_F); vn[j] = *(const unsigned*)(rp + C_I); }
#pragma unroll 1
    for (int c = 0; c < 8; ++c) {
        const size_t t0 = urow0 + c * 32;
        unsigned qc[4], fc[4], vc[4];
#pragma unroll
        for (int j = 0; j < 4; ++j) { qc[j] = qn[j]; fc[j] = fn[j]; vc[j] = vn[j]; }
        if (c < 7) {
#pragma unroll
            for (int j = 0; j < 4; ++j) { const bf16* rp = Pb + (t0 + 32 + 4 * w + j) * NIN + h * HD + 2 * lane; qn[j] = *(const unsigned*)(rp + C_Q); fn[j] = *(const unsigned*)(rp + C_F); vn[j] = *(const unsigned*)(rp + C_I); }
        }
        float kk0[4], kk1[4], cu0[4], cu1[4]; float g16a = 0.f, g16b = 0.f;
        { float c0 = 0.f, c1 = 0.f;
#pragma unroll
          for (int j = 0; j < 4; ++j) { const float f0 = lb0 + (1.f - lb0) * sigm(bflo(fc[j])), f1 = lb1 + (1.f - lb1) * sigm(bfhi(fc[j]));
              const float g0 = __logf(f0), g1 = __logf(f1); kk0[j] = 1.f - f0; kk1[j] = 1.f - f1; c0 += g0; c1 += g1; cu0[j] = c0; cu1[j] = c1; if (j == 0) { g16a = g0; g16b = g1; } } }
        *(LAS f32x2*)(L + L_PT + (w * 128 + 2 * lane) * 4) = (f32x2){cu0[3], cu1[3]};
        if (w == 4) *(LAS f32x2*)(L + L_G16 + 2 * lane * 4) = (f32x2){g16a, g16b};
        __syncthreads();
        float pre0 = 0.f, pre1 = 0.f, tot0 = 0.f, tot1 = 0.f, mid0 = 0.f, mid1 = 0.f;
#pragma unroll
        for (int j = 0; j < 8; ++j) { const f32x2 p = *(const LAS f32x2*)(L + L_PT + (j * 128 + 2 * lane) * 4); tot0 += p.x; tot1 += p.y; if (j < w) { pre0 += p.x; pre1 += p.y; } if (j < 4) { mid0 += p.x; mid1 += p.y; } }
        { const f32x2 p = *(const LAS f32x2*)(L + L_G16 + 2 * lane * 4); mid0 += p.x; mid1 += p.y; }
        unsigned ku0[2], ku1[2], vt0[2], vt1[2];
        { float kuA[4], kuB[4];
#pragma unroll
          for (int j = 0; j < 4; ++j) {
              const float b0 = pre0 + cu0[j], b1 = pre1 + cu1[j]; const float q0 = bflo(qc[j]), q1 = bfhi(qc[j]);
              const int trow = 4 * w + j;
              *(LAS unsigned*)(L + L_QT + trow * HQ_STRIDE + lane * 4) = pk2(q0 * fexp(b0 - mid0), q1 * fexp(b1 - mid1));
              *(LAS unsigned*)(L + L_KT + trow * HQ_STRIDE + lane * 4) = pk2(kk0[j] * fexp(mid0 - b0), kk1[j] * fexp(mid1 - b1));
              *(LAS unsigned*)(L + L_QIN + trow * HQ_STRIDE + lane * 4) = pk2(q0 * fexp(b0), q1 * fexp(b1));
              kuA[j] = kk0[j] * fexp(tot0 - b0); kuB[j] = kk1[j] * fexp(tot1 - b1);
              *(unsigned*)(Pb + (t0 + trow) * NIN + C_Q + h * HD + 2 * lane) = pk2(q0 * fexp(Bp0 + b0), q1 * fexp(Bp1 + b1));
          }
          ku0[0] = pk2(kuA[0], kuA[1]); ku0[1] = pk2(kuA[2], kuA[3]); ku1[0] = pk2(kuB[0], kuB[1]); ku1[1] = pk2(kuB[2], kuB[3]); }
        vt0[0] = (vc[0] & 0xffffu) | (vc[1] << 16); vt0[1] = (vc[2] & 0xffffu) | (vc[3] << 16);
        vt1[0] = (vc[0] >> 16) | (vc[1] & 0xffff0000u); vt1[1] = (vc[2] >> 16) | (vc[3] & 0xffff0000u);
        *(LAS u32x2*)(L + L_KU + (2 * lane) * HK_STRIDE + 8 * w) = (u32x2){ku0[0], ku0[1]};
        *(LAS u32x2*)(L + L_KU + (2 * lane + 1) * HK_STRIDE + 8 * w) = (u32x2){ku1[0], ku1[1]};
        *(LAS u32x2*)(L + L_VT + (2 * lane) * HK_STRIDE + 8 * w) = (u32x2){vt0[0], vt0[1]};
        *(LAS u32x2*)(L + L_VT + (2 * lane + 1) * HK_STRIDE + 8 * w) = (u32x2){vt1[0], vt1[1]};
        if (w == 0) *(LAS f32x2*)(L + L_DEC + 2 * lane * 4) = (f32x2){fexp(tot0), fexp(tot1)};
        Bp0 += tot0; Bp1 += tot1;
        __syncthreads();
        if (w < 3) {
            const int tb = w == 0 ? 0 : 1, sb = w == 2 ? 1 : 0;
            f32x4 a = {0.f, 0.f, 0.f, 0.f};
#pragma unroll
            for (int ks = 0; ks < 4; ++ks) { const bf16x8 af = *(const LAS bf16x8*)(L + L_QT + (tb * 16 + r16) * HQ_STRIDE + (ks * 32 + 8 * q4) * 2), bf = *(const LAS bf16x8*)(L + L_KT + (sb * 16 + r16) * HQ_STRIDE + (ks * 32 + 8 * q4) * 2); a = MFMA16(af, bf, a); }
#pragma unroll
            for (int i = 0; i < 4; ++i) { const int t = tb * 16 + 4 * q4 + i, s = sb * 16 + r16; *(LAS unsigned short*)(L + L_SC + t * HK_STRIDE + s * 2) = s <= t ? f2bf(a[i]) : (unsigned short)0; }
        } else if (w == 3) {
#pragma unroll
            for (int i = 0; i < 4; ++i) *(LAS unsigned short*)(L + L_SC + (4 * q4 + i) * HK_STRIDE + (16 + r16) * 2) = (unsigned short)0;
        }
        __syncthreads();
        const bf16x8 vtf = *(const LAS bf16x8*)(L + L_VT + (w * 16 + r16) * HK_STRIDE + 16 * q4);
        bf16x8 stf[4];
#pragma unroll
        for (int ks = 0; ks < 4; ++ks) stf[ks] = *(const LAS bf16x8*)(L + L_ST + (w * 16 + r16) * HQ_STRIDE + (ks * 32 + 8 * q4) * 2);
#pragma unroll
        for (int tb = 0; tb < 2; ++tb) {
            f32x4 o = {0.f, 0.f, 0.f, 0.f};
            { const bf16x8 sf = *(const LAS bf16x8*)(L + L_SC + (tb * 16 + r16) * HK_STRIDE + 16 * q4); o = MFMA16(sf, vtf, o); }
#pragma unroll
            for (int ks = 0; ks < 4; ++ks) { const bf16x8 qf = *(const LAS bf16x8*)(L + L_QIN + (tb * 16 + r16) * HQ_STRIDE + (ks * 32 + 8 * q4) * 2); o = MFMA16(qf, stf[ks], o); }
#pragma unroll
            for (int i = 0; i < 4; ++i) OL[(t0 + tb * 16 + 4 * q4 + i) * HW + h * HD + w * 16 + r16] = o[i];
        }
#pragma unroll
        for (int kb = 0; kb < 8; ++kb) {
            const f32x4 d = *(const LAS f32x4*)(L + L_DEC + (kb * 16 + 4 * q4) * 4);
            const bf16x8 kf = *(const LAS bf16x8*)(L + L_KU + (kb * 16 + r16) * HK_STRIDE + 16 * q4);
            S[kb] = MFMA16(kf, vtf, S[kb] * d);
            *(LAS u32x2*)(L + L_ST + (w * 16 + r16) * HQ_STRIDE + (kb * 16 + 4 * q4) * 2) = (u32x2){pk2(S[kb][0], S[kb][1]), pk2(S[kb][2], S[kb][3])};
        }
    }
    float* USC = (float*)(F.ws + WS_USC) + (size_t)unit * HD * HD; float* DSC = (float*)(F.ws + WS_DSC) + (size_t)unit * HD;
#pragma unroll
    for (int kb = 0; kb < 8; ++kb)
#pragma unroll
        for (int i = 0; i < 4; ++i) USC[(kb * 16 + 4 * q4 + i) * HD + w * 16 + r16] = S[kb][i];
    if (w == 0) { DSC[2 * lane] = fexp(Bp0); DSC[2 * lane + 1] = fexp(Bp1); }
    __syncthreads();
}

DI void hgrn_sample_unit(Frame& F, int unit) {
    const int bs = unit >> 3, h = unit & 7, tid = F.tid, lane = F.lane, w = F.wave;
    LAS float* part = (LAS float*)F.lds;
    const bf16* prow = (const bf16*)(F.ws + WS_PB) + (size_t)(TP + bs) * NIN + h * HD;
    const float* lb = (const float*)(F.ws + WS_LB) + h * HD;
    const int vq = tid & 31, kr = tid >> 5;
    const float* S0 = F.in[I_SH] + ((size_t)bs * NH + h) * HD * HD; float* S1 = F.out + O_HS + ((size_t)bs * NH + h) * HD * HD;
    f32x4 iv; { const u32x2 t = *(const u32x2*)(prow + C_I + 4 * vq); iv = (f32x4){bflo(t.x), bfhi(t.x), bflo(t.y), bfhi(t.y)}; }
    f32x4 o = {0.f, 0.f, 0.f, 0.f};
#pragma unroll
    for (int j = 0; j < 8; ++j) { const int k = kr + 16 * j;
        const float l = lb[k], f = l + (1.f - l) * sigm(bf2f(prow[C_F + k])), q = bf2f(prow[C_Q + k]);
        const f32x4 s = *(const f32x4*)(S0 + (size_t)k * HD + 4 * vq) * f + iv * (1.f - f);
        *(f32x4*)(S1 + (size_t)k * HD + 4 * vq) = s; o += s * q; }
#pragma unroll
    for (int i = 0; i < 4; ++i) o[i] += __shfl_xor(o[i], 32);
    if (lane < 32) *(LAS f32x4*)(part + w * 128 + 4 * vq) = o;
    __syncthreads();
    if (w == 0) {
        float o0 = 0.f, o1 = 0.f;
#pragma unroll
        for (int j = 0; j < 8; ++j) { o0 += part[j * 128 + lane]; o1 += part[j * 128 + 64 + lane]; }
        const float rs = 1.0f / sqrtf(wave_sum(o0 * o0 + o1 * o1) * (1.0f / HD) + RMS_EPS);
        const float* gn = F.in[I_HG] + h * HD; bf16* oa = (bf16*)(F.ws + WS_OAB) + (size_t)(TP + bs) * DM + h * HD;
        const float g0 = bf2f(prow[C_OG + lane]), g1 = bf2f(prow[C_OG + 64 + lane]);
        oa[lane] = f2bf(o0 * rs * gn[lane] * g0 * sigm(g0)); oa[64 + lane] = f2bf(o1 * rs * gn[64 + lane] * g1 * sigm(g1));
    }
    __syncthreads();
}

DI void hgrn_finish_unit(Frame& F, int unit) {
    const int b = unit >> 6, h = (unit >> 3) & 7, sc = unit & 7, lane = F.lane, w = F.wave, r16 = lane & 15, q4 = lane >> 4;
    LAS unsigned char* L = F.lds;
    const bf16* Pb = (const bf16*)(F.ws + WS_PB);
    const float* OL = (const float*)(F.ws + WS_OL);
    const size_t urow0 = (size_t)b * TSEQ + sc * 256;
    f32x4 S[8];
#pragma unroll
    for (int kb = 0; kb < 8; ++kb) S[kb] = (f32x4){0.f, 0.f, 0.f, 0.f};
    const int nprev = sc == 7 ? 8 : sc;
#pragma unroll 1
    for (int j = 0; j < nprev; ++j) {
        if (j == sc) {
#pragma unroll
            for (int kb = 0; kb < 8; ++kb) *(LAS u32x2*)(L + L_ST + (w * 16 + r16) * HQ_STRIDE + (kb * 16 + 4 * q4) * 2) = (u32x2){pk2(S[kb][0], S[kb][1]), pk2(S[kb][2], S[kb][3])};
        }
        const float* USC = (const float*)(F.ws + WS_USC) + (size_t)((unit & ~7) + j) * HD * HD; const float* DSC = (const float*)(F.ws + WS_DSC) + (size_t)((unit & ~7) + j) * HD;
#pragma unroll
        for (int kb = 0; kb < 8; ++kb) { const f32x4 d = *(const f32x4*)(DSC + kb * 16 + 4 * q4);
#pragma unroll
            for (int i = 0; i < 4; ++i) S[kb][i] = S[kb][i] * d[i] + USC[(kb * 16 + 4 * q4 + i) * HD + w * 16 + r16]; }
    }
    if (sc == 7) {
        float* HP = F.out + O_HP + ((size_t)b * NH + h) * HD * HD;
#pragma unroll
        for (int kb = 0; kb < 8; ++kb)
#pragma unroll
            for (int i = 0; i < 4; ++i) HP[(kb * 16 + 4 * q4 + i) * HD + w * 16 + r16] = S[kb][i];
    } else {
#pragma unroll
        for (int kb = 0; kb < 8; ++kb) *(LAS u32x2*)(L + L_ST + (w * 16 + r16) * HQ_STRIDE + (kb * 16 + 4 * q4) * 2) = (u32x2){pk2(S[kb][0], S[kb][1]), pk2(S[kb][2], S[kb][3])};
    }
    __syncthreads();
    const float* gn = F.in[I_HG] + h * HD; bf16* OA = (bf16*)(F.ws + WS_OAB);
#pragma unroll 1
    for (int tbi = 0; tbi < 2; ++tbi) {
        const size_t t0 = urow0 + (2 * w + tbi) * 16;
        bf16x8 qf[4];
#pragma unroll
        for (int ks = 0; ks < 4; ++ks) qf[ks] = *(const bf16x8*)(Pb + (t0 + r16) * NIN + C_Q + h * HD + ks * 32 + 8 * q4);
        f32x4 o[8]; float ssq[4] = {0.f, 0.f, 0.f, 0.f};
        const float* olp = OL + (t0 + 4 * q4) * HW + h * HD + r16;
#pragma unroll
        for (int vb = 0; vb < 8; ++vb) {
            f32x4 a = {0.f, 0.f, 0.f, 0.f};
#pragma unroll
            for (int ks = 0; ks < 4; ++ks) { const bf16x8 sf = *(const LAS bf16x8*)(L + L_ST + (vb * 16 + r16) * HQ_STRIDE + (ks * 32 + 8 * q4) * 2); a = MFMA16(qf[ks], sf, a); }
#pragma unroll
            for (int i = 0; i < 4; ++i) { a[i] += olp[i * HW + vb * 16]; ssq[i] += a[i] * a[i]; }
            o[vb] = a;
            asm volatile("" ::: "memory");
        }
#pragma unroll
        for (int i = 0; i < 4; ++i) { float s = ssq[i]; s += __shfl_xor(s, 1); s += __shfl_xor(s, 2); s += __shfl_xor(s, 4); s += __shfl_xor(s, 8); ssq[i] = 1.0f / sqrtf(s * (1.0f / HD) + RMS_EPS); }
        const bf16* ogp = Pb + (t0 + 4 * q4) * NIN + C_OG + h * HD + r16; bf16* oap = OA + (t0 + 4 * q4) * DM + h * HD + r16;
#pragma unroll
        for (int vb = 0; vb < 8; ++vb) { const float gv = gn[vb * 16 + r16];
#pragma unroll
            for (int i = 0; i < 4; ++i) { const float og = bf2f(ogp[i * NIN + vb * 16]);
                oap[i * DM + vb * 16] = f2bf(o[vb][i] * ssq[i] * gv * og * sigm(og)); }
            asm volatile("" ::: "memory"); }
    }
    __syncthreads();
}

DI void final_norm(Frame& F) {
    const int gw = F.bid * NWAVES + F.wave, NGW = F.G * NWAVES;
    const float* ss3 = (const float*)(F.ws + WS_SS3); const f32x4* gf = (const f32x4*)F.in[I_NF] + F.lane;
    for (int m = gw; m < MV; m += NGW) {
        const float r = 1.0f / sqrtf(ss3[m] * (1.0f / DM) + RMS_EPS);
        f32x4* x4 = (f32x4*)(F.out + (size_t)m * DM) + F.lane;
#pragma unroll
        for (int j = 0; j < 8; ++j) x4[64 * j] = x4[64 * j] * r * gf[64 * j];
    }
}

#ifndef N_LAUNCHES
#define N_LAUNCHES 1
#endif
constexpr int NPHASE = 9;
__global__ void __launch_bounds__(NTHR, 2) hybrid_fwd(Args args) {
    extern __shared__ __attribute__((aligned(16))) unsigned char lds_raw[];
    cg::grid_group grid = cg::this_grid();
    Frame F;
    F.lds = (LAS unsigned char*)lds_raw; F.tid = threadIdx.x; F.lane = F.tid & 63; F.wave = __builtin_amdgcn_readfirstlane(F.tid >> 6);
    F.G = gridDim.x; F.bid = blockIdx.x; F.out = args.out; F.ws = args.ws;
#pragma unroll
    for (int i = 0; i < 25; ++i) F.in[i] = args.in[i];
    const int lo = args.ph_lo, hi = args.ph_hi;
#ifndef PHMASK
#define PHMASK 0x1ff
#endif
#define IN(k) (((PHMASK >> (k)) & 1) && lo <= (k) && (k) < hi)
#define SEAM(k) do { if (IN(k) && IN((k) + 1)) grid.sync(); } while (0)
    typedef pg8::bf16_t pb;
    if (IN(0)) { p0_prologue(F); } SEAM(0);
    if (IN(1)) {
        pg8::Gemm g{(const pb*)(F.ws + WS_XB), (const pb*)(F.ws + WS_WIN), MP, NIN, DM, DM}; pg8::StaticOrder S; S.init(MP, NIN, F.G, F.bid);
        pg8::EpiIn E{(pb*)(F.ws + WS_PB), (const float*)(F.ws + WS_RS1), NIN};
        pg8::gemm_phase<pg8::EpiIn, pg8::StaticOrder, true, true>(F.lds, g, S, E);
    } SEAM(1);
    if (IN(2)) {
        for (int u = F.bid; u < NB * SG; u += F.G) s5_prompt_unit(F, u);
        for (int u = F.bid; u < NB * NH * 8; u += F.G) hgrn_local_unit(F, u);
        for (int u = F.bid; u < NSMP * NH; u += F.G) hgrn_sample_unit(F, u);
        { const int gw = F.bid * NWAVES + F.wave, NGW = F.G * NWAVES; for (int u = gw; u < NSMP * SG; u += NGW) s5_sample_wave(F, u >> 6, u & 63); }
        __syncthreads();
    } SEAM(2);
    if (IN(3)) {
#ifndef NO_FIN
        for (int u = F.bid; u < NB * NH * 8; u += F.G) hgrn_finish_unit(F, u);
#endif
#ifndef NO_GLU
        pg8::Gemm g{(const pb*)(F.ws + WS_Z), (const pb*)(F.ws + WS_WGLU), MP, 2 * SW, SW, SW}; pg8::StaticOrder S; S.init(MP, 2 * SW, F.G, F.bid);
        pg8::EpiGlu E{(pb*)(F.ws + WS_OAB) + HW, DM};
        pg8::gemm_phase<pg8::EpiGlu, pg8::StaticOrder, true, true>(F.lds, g, S, E);
#endif
    } SEAM(3);
    if (IN(4)) {
        pg8::Gemm g{(const pb*)(F.ws + WS_OAB), (const pb*)(F.ws + WS_WCAT), MP, DM, DM, MERGE_MID ? DM / 2 : DM}; pg8::HalvedOrder S; S.init(MP, DM, F.G, F.bid);
        pg8::EpiMerge E{(pb*)(F.ws + WS_MRG), (const pb*)(F.ws + WS_PB), NIN, C_GA, C_GB, DM};
        pg8::gemm_phase<pg8::EpiMerge, pg8::HalvedOrder, true, true>(F.lds, g, S, E);
    } SEAM(4);
    if (IN(5)) {
        pg8::Gemm g{(const pb*)(F.ws + WS_MRG), (const pb*)(F.ws + WS_WOUT), MP, DM, DM, DM}; pg8::StaticOrder S; S.init(MP, DM, F.G, F.bid);
        pg8::EpiRes<true> E{F.in[I_XP], F.in[I_XS], TP, (float*)(F.ws + WS_X1), (pb*)(F.ws + WS_X1B), (float*)(F.ws + WS_SS2), MV, DM};
        pg8::gemm_phase<pg8::EpiRes<true>, pg8::StaticOrder, true, true>(F.lds, g, S, E);
    } SEAM(5);
    if (IN(6)) {
        pg8::Gemm g{(const pb*)(F.ws + WS_X1B), (const pb*)(F.ws + WS_WUP), MP, 2 * FF, DM, DM}; pg8::StaticOrder S; S.init(MP, 2 * FF, F.G, F.bid);
        pg8::EpiSwiGlu E{(pb*)(F.ws + WS_ACT), (const float*)(F.ws + WS_SS2), FF};
        pg8::gemm_phase<pg8::EpiSwiGlu, pg8::StaticOrder, true, true>(F.lds, g, S, E);
    } SEAM(6);
    if (IN(7)) {
        pg8::Gemm g{(const pb*)(F.ws + WS_ACT), (const pb*)(F.ws + WS_WDN), MP, DM, FF, FF}; pg8::StaticOrder S; S.init(MP, DM, F.G, F.bid);
        pg8::EpiRes<false> E{(const float*)(F.ws + WS_X1), (const float*)(F.ws + WS_X1), MP, F.out, nullptr, (float*)(F.ws + WS_SS3), MV, DM};
        pg8::gemm_phase<pg8::EpiRes<false>, pg8::StaticOrder, true, true>(F.lds, g, S, E);
    } SEAM(7);
    if (IN(8)) final_norm(F);
#undef IN
#undef SEAM
}

extern "C" void kernel_launch(void* const* d_in, const int* in_sizes, int n_in, void* d_out, int out_size, void* d_ws, size_t ws_size, hipStream_t stream) {
    static int grid = 0;
    if (grid == 0) {
        if (n_in != 25 || ws_size < WS_END || (size_t)out_size != O_END) { fprintf(stderr, "kernel_launch: unexpected problem: n_in %d ws %zu (need %zu) out %d (expect %zu)\n", n_in, ws_size, (size_t)WS_END, out_size, (size_t)O_END); grid = -1; return; }
        int dev = 0, cus = 0, per_cu = 0;
        hipGetDevice(&dev); hipDeviceGetAttribute(&cus, hipDeviceAttributeMultiprocessorCount, dev);
        hipFuncSetAttribute((const void*)hybrid_fwd, hipFuncAttributeMaxDynamicSharedMemorySize, LDS_BYTES);
        hipOccupancyMaxActiveBlocksPerMultiprocessor(&per_cu, (const void*)hybrid_fwd, NTHR, LDS_BYTES);
        if (per_cu < 1) { fprintf(stderr, "kernel_launch: occupancy query reports %d blocks per CU\n", per_cu); per_cu = 1; }
        (void)hipGetLastError();
        grid = cus;
    }
    if (grid < 0) return;
    Args a{};
    for (int i = 0; i < 25; ++i) a.in[i] = (const float*)d_in[i];
    a.out = (float*)d_out; a.ws = (unsigned char*)d_ws;
#if N_LAUNCHES == 1
    a.ph_lo = 0; a.ph_hi = NPHASE;
    void* params[] = {&a};
    hipError_t e = hipLaunchCooperativeKernel((const void*)hybrid_fwd, dim3(grid), dim3(NTHR), params, LDS_BYTES, stream);
    if (e != hipSuccess) fprintf(stderr, "cooperative launch failed: %s (grid %d)\n", hipGetErrorString(e), grid);
#else
    for (int p = 0; p < NPHASE; ++p) { a.ph_lo = p; a.ph_hi = p + 1; hipLaunchKernelGGL(hybrid_fwd, dim3(grid), dim3(NTHR), LDS_BYTES, stream, a); }
#endif
}
```

```cpp
#include <hip/hip_runtime.h>
#include <hip/hip_cooperative_groups.h>
#include <cstdio>
#include <cstdint>
namespace cg = cooperative_groups;

#define DI __device__ __forceinline__
#define LAS __attribute__((address_space(3)))
typedef float f32x2 __attribute__((ext_vector_type(2)));
typedef __bf16 bf16x2_t __attribute__((ext_vector_type(2)));
typedef unsigned u32x2 __attribute__((ext_vector_type(2)));

constexpr int DM = 2048, TSEQ = 2048, NB = 4, TP = NB * TSEQ  , NSMP = 128, MV = TP + NSMP  , MP = 8448  ;
constexpr int HW = 1024, NH = 8, HD = 128, SW = 1024, SG = 64, SPC = 16, SN = 64, FF = 5632, NIN = 9216;
constexpr int C_Q = 0, C_F = 1024, C_I = 2048, C_OG = 3072, C_U = 4096, C_GA = 5120, C_GB = 7168;
constexpr float RMS_EPS = 1e-6f;
#ifndef MERGE_MID
#define MERGE_MID true
#endif

constexpr size_t MiB = 1u << 20;
constexpr size_t WS_R1 = 2 * MiB;
constexpr size_t WS_WIN = WS_R1, WS_XB = WS_R1 + 36 * MiB;
constexpr size_t WS_OL = WS_R1, WS_Z = WS_R1 + 32 * MiB;
constexpr size_t WS_X1 = WS_R1;
constexpr size_t WS_R2 = WS_R1 + 69 * MiB;
constexpr size_t WS_PB = WS_R2;
constexpr size_t WS_ACT = WS_R2, WS_X1B = WS_R2 + 91 * MiB;
constexpr size_t WS_R3 = WS_R2 + 148 * MiB + MiB / 2;
constexpr size_t WS_WGLU = WS_R3, WS_WCAT = WS_R3 + 4 * MiB, WS_WOUT = WS_R3 + 12 * MiB, WS_WUP = WS_R3 + 20 * MiB, WS_WDN = WS_R3 + 64 * MiB;
constexpr size_t WS_R4 = WS_R3 + 86 * MiB;
constexpr size_t WS_OAB = WS_R4, WS_MRG = WS_R4 + 33 * MiB;
constexpr size_t WS_USC = WS_MRG, WS_DSC = WS_MRG + 16 * MiB;
constexpr size_t WS_END = WS_R4 + 66 * MiB;
constexpr size_t WS_RS1 = 0, WS_SS2 = 64 * 1024, WS_SS3 = 128 * 1024, WS_LB = 192 * 1024, WS_PARA = 256 * 1024  , WS_PARB = 512 * 1024  , WS_PARC = 768 * 1024  ;

constexpr int LDS_BYTES = 147456;

DI float bflo(unsigned u) { return __uint_as_float(u << 16); }
DI float bfhi(unsigned u) { return __uint_as_float(u & 0xffff0000u); }
DI float bf2f(unsigned short b) { return __uint_as_float((unsigned)b << 16); }
DI unsigned pk2(float lo, float hi) { f32x2 v = {lo, hi}; bf16x2_t b = __builtin_convertvector(v, bf16x2_t); return __builtin_bit_cast(unsigned, b); }
DI unsigned short f2bf(float f) { return (unsigned short)(pk2(f, 0.f) & 0xffffu); }
DI float fexp(float x) { return __expf(x); }
DI float sigm(float x) { return __builtin_amdgcn_rcpf(1.f + __expf(-x)); }
DI float wave_sum(float v) {
#pragma unroll
    for (int o = 1; o < 64; o <<= 1) v += __shfl_xor(v, o);
    return v;
}

namespace pg8 {
#define PG8_LAS __attribute__((address_space(3)))
typedef unsigned short bf16_t;
typedef short bf16x8 __attribute__((ext_vector_type(8)));
typedef float f32x4 __attribute__((ext_vector_type(4)));
typedef unsigned u32x4 __attribute__((ext_vector_type(4)));
constexpr int BM = 256, BK = 64, HALF = 128, HTB = HALF * BK * 2  , STAGE_BYTES = 8 * HTB, NXCD = 8, WGM = 8;

__host__ __device__ __forceinline__ int lds_byte(int r, int c) { const int st = (r >> 4) * 2 + (c >> 5), rr = r & 15, cc = c & 31, ob = rr * 64 + cc * 2; return st * 1024 + (ob ^ (((ob >> 9) & 1) << 5)); }
__host__ __device__ __forceinline__ void stage_rc(int b, int& R, int& C) { const int st = b / 1024, sb = b % 1024, swz = sb ^ (((sb >> 9) & 1) << 5); R = (st >> 1) * 16 + swz / 64; C = (st & 1) * 32 + (swz % 64) / 2; }
__host__ __device__ __forceinline__ int perm32(int rho) { const int n = rho >> 4, i = rho & 15; return 8 * (i >> 2) + 4 * n + (i & 3); }

struct Unit { int pm, pn, kh; };
struct Gemm { const bf16_t* A; const bf16_t* Bt; int M, N, K, KL; };

struct StaticOrder {
    int nM, nN, nwg, G, c;
    __host__ __device__ void init(int M, int N, int G_, int c_) { nM = M / BM; nN = N / BM; nwg = nM * nN; G = G_; c = c_; }
    __host__ __device__ bool next(int i, Unit& u) const {
        const long L = (long)i * G + c; if (L >= nwg) return false;
        int wgid = (int)L; { const int q = nwg / NXCD, r = nwg % NXCD, xcd = wgid % NXCD, off = wgid / NXCD; wgid = (xcd < r ? xcd * (q + 1) : r * (q + 1) + (xcd - r) * q) + off; }
        const int nig = WGM * nN, gid = wgid / nig, fm = gid * WGM, gsz = (nM - fm) < WGM ? (nM - fm) : WGM;
        u.pm = fm + ((wgid % nig) % gsz); u.pn = (wgid % nig) / gsz; u.kh = 0; return true;
    }
    __device__ __forceinline__ void a_ready(const Unit&) const {}
    __device__ __forceinline__ void done(const Unit&) const {}
};

struct HalvedOrder {
    StaticOrder so;
    __host__ __device__ void init(int M, int N, int G_, int c_) { so.init(M, N, G_, c_); }
    __host__ __device__ bool next(int i, Unit& u) const { if (!so.next(i >> 1, u)) return false; u.kh = i & 1; return true; }
    __device__ __forceinline__ void a_ready(const Unit&) const {}
    __device__ __forceinline__ void done(const Unit&) const {}
};
__device__ __forceinline__ u32x4 pack8(f32x4 v0, f32x4 v1) { u32x4 w; w.x = ::pk2(v0[0], v0[1]); w.y = ::pk2(v0[2], v0[3]); w.z = ::pk2(v1[0], v1[1]); w.w = ::pk2(v1[2], v1[3]); return w; }
__device__ __forceinline__ void unpack8(u32x4 w, f32x4& v0, f32x4& v1) { v0 = (f32x4){::bflo(w.x), ::bfhi(w.x), ::bflo(w.y), ::bfhi(w.y)}; v1 = (f32x4){::bflo(w.z), ::bfhi(w.z), ::bflo(w.w), ::bfhi(w.w)}; }
__device__ __forceinline__ f32x4 sig4(f32x4 x) { return (f32x4){::sigm(x[0]), ::sigm(x[1]), ::sigm(x[2]), ::sigm(x[3])}; }

struct EpiIn {
    static constexpr bool PERM = true, AFTER_DRAIN = false, HAS_MID = false;
    bf16_t* O; const float* rs; int ldc;
    __device__ __forceinline__ void operator()(const f32x4 (&acc)[2][2][4][2], const Unit& u, int wr, int wc, int fr, int fq) const {
        const int row0 = u.pm * BM + wr * 64 + fr, col0 = u.pn * BM + wc * 32 + 8 * fq;
#pragma unroll
        for (int ai = 0; ai < 2; ++ai)
#pragma unroll
            for (int m = 0; m < 4; ++m) { const int row = row0 + ai * HALF + m * 16; const float s = rs[row]; bf16_t* rowp = O + (size_t)row * ldc + col0;
#pragma unroll
                for (int bj = 0; bj < 2; ++bj) *(u32x4*)(rowp + bj * HALF) = pack8(acc[ai][bj][m][0] * s, acc[ai][bj][m][1] * s); }
    }
};
struct EpiGlu {
    static constexpr bool PERM = true, AFTER_DRAIN = false, HAS_MID = false;
    bf16_t* O; int ldc;
    __device__ __forceinline__ void operator()(const f32x4 (&acc)[2][2][4][2], const Unit& u, int wr, int wc, int fr, int fq) const {
        const int row0 = u.pm * BM + wr * 64 + fr, col0 = u.pn * HALF + wc * 32 + 8 * fq;
#pragma unroll
        for (int ai = 0; ai < 2; ++ai)
#pragma unroll
            for (int m = 0; m < 4; ++m) { const int row = row0 + ai * HALF + m * 16;
                *(u32x4*)(O + (size_t)row * ldc + col0) = pack8(acc[ai][0][m][0] * sig4(acc[ai][1][m][0]), acc[ai][0][m][1] * sig4(acc[ai][1][m][1])); }
    }
};
struct EpiMerge {
    static constexpr bool PERM = true, AFTER_DRAIN = false, HAS_MID = MERGE_MID;
    bf16_t* O; const bf16_t* P; int ldp; int cga, cgb; int ldc;
    __device__ __forceinline__ void mid(f32x4 (&acc)[2][2][4][2], const Unit& u, int wr, int wc, int fr, int fq) const {
        const int row0 = u.pm * BM + wr * 64 + fr, col0 = u.pn * BM + wc * 32 + 8 * fq;
#pragma unroll
        for (int ai = 0; ai < 2; ++ai)
#pragma unroll
            for (int m = 0; m < 4; ++m) { const int row = row0 + ai * HALF + m * 16; const bf16_t* pr = P + (size_t)row * ldp + col0;
#pragma unroll
                for (int bj = 0; bj < 2; ++bj) { f32x4 a0, a1, b0, b1; unpack8(*(const u32x4*)(pr + cga + bj * HALF), a0, a1); unpack8(*(const u32x4*)(pr + cgb + bj * HALF), b0, b1);
#pragma unroll
                    for (int i = 0; i < 4; ++i) { acc[ai][bj][m][0][i] *= (1.f + __expf(-b0[i])) * __builtin_amdgcn_rcpf(1.f + __expf(-a0[i])); acc[ai][bj][m][1][i] *= (1.f + __expf(-b1[i])) * __builtin_amdgcn_rcpf(1.f + __expf(-a1[i])); } }
                asm volatile("" ::: "memory"); }
    }
    __device__ __forceinline__ void operator()(const f32x4 (&acc)[2][2][4][2], const Unit& u, int wr, int wc, int fr, int fq) const {
        const int row0 = u.pm * BM + wr * 64 + fr, col0 = u.pn * BM + wc * 32 + 8 * fq;
#pragma unroll
        for (int ai = 0; ai < 2; ++ai)
#pragma unroll
            for (int m = 0; m < 4; ++m) { const int row = row0 + ai * HALF + m * 16; const bf16_t* pr = P + (size_t)row * ldp + col0 + cgb; bf16_t* rowp = O + (size_t)row * ldc + col0;
#pragma unroll
                for (int bj = 0; bj < 2; ++bj) { f32x4 b0, b1; unpack8(*(const u32x4*)(pr + bj * HALF), b0, b1);
                    *(u32x4*)(rowp + bj * HALF) = pack8(acc[ai][bj][m][0] * sig4(b0), acc[ai][bj][m][1] * sig4(b1)); }
                asm volatile("" ::: "memory"); }
    }
};
template <bool WRITE_BF16> struct EpiRes {
    static constexpr bool PERM = true, AFTER_DRAIN = false, HAS_MID = false;
    const float* base0; const float* base1; int split;
    float* out; bf16_t* ob; float* ss; int nvalid; int ldc;
    __device__ __forceinline__ void operator()(const f32x4 (&acc)[2][2][4][2], const Unit& u, int wr, int wc, int fr, int fq) const {
        const int row0 = u.pm * BM + wr * 64 + fr, col0 = u.pn * BM + wc * 32 + 8 * fq;
#pragma unroll
        for (int ai = 0; ai < 2; ++ai)
#pragma unroll
            for (int m = 0; m < 4; ++m) { const int row = row0 + ai * HALF + m * 16;
                if (row < nvalid) {
                    const float* bp = (row < split ? base0 + (size_t)row * ldc : base1 + (size_t)(row - split) * ldc) + col0; float* op = out + (size_t)row * ldc + col0; float s = 0.f;
#pragma unroll
                    for (int bj = 0; bj < 2; ++bj) { const f32x4 x0 = *(const f32x4*)(bp + bj * HALF), x1 = *(const f32x4*)(bp + bj * HALF + 4);
                        const f32x4 y0 = x0 + acc[ai][bj][m][0], y1 = x1 + acc[ai][bj][m][1];
                        *(f32x4*)(op + bj * HALF) = y0; *(f32x4*)(op + bj * HALF + 4) = y1;
                        if (WRITE_BF16) *(u32x4*)(ob + (size_t)row * ldc + col0 + bj * HALF) = pack8(y0, y1);
                        s += (y0[0] * y0[0] + y0[1] * y0[1]) + (y0[2] * y0[2] + y0[3] * y0[3]) + (y1[0] * y1[0] + y1[1] * y1[1]) + (y1[2] * y1[2] + y1[3] * y1[3]); }
                    s += __shfl_xor(s, 16); s += __shfl_xor(s, 32);
                    if (fq == 0) atomicAdd(ss + row, s);
                } }
    }
};
struct EpiSwiGlu {
    static constexpr bool PERM = true, AFTER_DRAIN = false, HAS_MID = false;
    bf16_t* O; const float* ss; int ldc;
    __device__ __forceinline__ void operator()(const f32x4 (&acc)[2][2][4][2], const Unit& u, int wr, int wc, int fr, int fq) const {
        const int row0 = u.pm * BM + wr * 64 + fr, col0 = u.pn * HALF + wc * 32 + 8 * fq;
#pragma unroll
        for (int ai = 0; ai < 2; ++ai)
#pragma unroll
            for (int m = 0; m < 4; ++m) { const int row = row0 + ai * HALF + m * 16; const float r = __builtin_amdgcn_rsqf(ss[row] * (1.0f / 2048.0f) + 1e-6f);
                const f32x4 a0 = acc[ai][0][m][0] * r, a1 = acc[ai][0][m][1] * r, b0 = acc[ai][1][m][0] * r, b1 = acc[ai][1][m][1] * r;
                *(u32x4*)(O + (size_t)row * ldc + col0) = pack8(a0 * sig4(a0) * b0, a1 * sig4(a1) * b1); }
    }
};
template <class Epi, class Sched, bool ALIGN_EPI = false, bool SP2 = false>
__device__ __forceinline__ void gemm_phase(PG8_LAS unsigned char* lds, const Gemm g, const Sched& S, const Epi& E) {
    const int tid = threadIdx.x, wid = __builtin_amdgcn_readfirstlane(tid >> 6), lane = tid & 63, wr = wid >> 2, wc = wid & 3, fr = lane & 15, fq = lane >> 4;
    const int K = g.K, nt = g.KL / BK; const size_t khb = (size_t)g.KL * 2;
    unsigned voffA[2], voffB[2];
#pragma unroll
    for (int i = 0; i < 2; ++i) { int R, C; stage_rc(tid * 16 + i * 8192, R, C); const int Rb = Epi::PERM ? ((R & ~31) + perm32(R & 31)) : R;
        voffA[i] = (unsigned)(R * K + C) * 2u; voffB[i] = (unsigned)(Rb * K + C) * 2u; }
    const size_t kstep = (size_t)(BK * 2);
    const size_t hstep = (size_t)HALF * K * 2;
    const size_t tstep = 2 * hstep;
    const unsigned ldsw = (unsigned)wid * 1024u;
    const int aoff = lds_byte(wr * 64 + fr, fq * 8), boff = lds_byte(wc * 32 + fr, fq * 8);
#define PG8_SA(b, h) (((b) * 2 + (h)) * HTB)
#define PG8_SB(b, h) ((4 + (b) * 2 + (h)) * HTB)
#define PG8_STAGE(bufoff, gbase, voff) do { _Pragma("unroll") for (int _i = 0; _i < 2; ++_i) \
        __builtin_amdgcn_global_load_lds((const unsigned*)((const char*)(gbase) + (voff)[_i]), (PG8_LAS unsigned*)(lds + (bufoff) + ldsw + _i * 8192), 16, 0, 0); } while (0)
#define PG8_LDA(dst, b, h) do { _Pragma("unroll") for (int m = 0; m < 4; ++m) _Pragma("unroll") for (int k = 0; k < 2; ++k) dst[m][k] = *(const PG8_LAS bf16x8*)(lds + PG8_SA(b, h) + aoff + m * 2048 + k * 1024); } while (0)
#define PG8_LDB(dst, b, h) do { _Pragma("unroll") for (int n = 0; n < 2; ++n) _Pragma("unroll") for (int k = 0; k < 2; ++k) dst[n][k] = *(const PG8_LAS bf16x8*)(lds + PG8_SB(b, h) + boff + n * 2048 + k * 1024); } while (0)
#define PG8_MMA(ai, bj, At, Bt) do { __builtin_amdgcn_s_setprio(1); _Pragma("unroll") for (int m = 0; m < 4; ++m) _Pragma("unroll") for (int n = 0; n < 2; ++n) _Pragma("unroll") for (int k = 0; k < 2; ++k) \
        acc[ai][bj][m][n] = __builtin_amdgcn_mfma_f32_16x16x32_bf16(Bt[n][k], At[m][k], acc[ai][bj][m][n], 0, 0, 0); __builtin_amdgcn_s_setprio(0); } while (0)
#define PG8_WAIT_V(n) asm volatile("s_waitcnt vmcnt(" #n ")" ::: "memory")
#define PG8_WAIT_L(n) asm volatile("s_waitcnt lgkmcnt(" #n ")" ::: "memory")
#define PG8_BAR __builtin_amdgcn_s_barrier()
#define PG8_SCHED __builtin_amdgcn_sched_barrier(0)
    Unit cur, nxt; int ui = 0;
    if (!S.next(0, cur)) return;
    f32x4 acc[2][2][4][2];
#pragma unroll
    for (int a = 0; a < 2; ++a)
#pragma unroll
        for (int b = 0; b < 2; ++b)
#pragma unroll
            for (int m = 0; m < 4; ++m)
#pragma unroll
                for (int n = 0; n < 2; ++n) acc[a][b][m][n] = (f32x4){0.f, 0.f, 0.f, 0.f};
    bf16x8 At[4][2], B0[2][2], B1[2][2];
    const char* cA = (const char*)g.A + (size_t)cur.pm * tstep + cur.kh * khb; const char* cB = (const char*)g.Bt + (size_t)cur.pn * tstep + cur.kh * khb;
    S.a_ready(cur);
    if constexpr (SP2) {
        PG8_STAGE(PG8_SB(0, 0), cB, voffB); PG8_STAGE(PG8_SB(0, 1), cB + hstep, voffB); PG8_STAGE(PG8_SA(0, 0), cA, voffA); PG8_STAGE(PG8_SA(0, 1), cA + hstep, voffA);
        if (wr == 1) PG8_BAR;
        PG8_WAIT_V(2); PG8_BAR;
        PG8_STAGE(PG8_SB(1, 0), cB + kstep, voffB); PG8_STAGE(PG8_SA(1, 0), cA + kstep, voffA); PG8_STAGE(PG8_SB(1, 1), cB + hstep + kstep, voffB);
        PG8_WAIT_V(6); PG8_BAR;
    } else {
        PG8_STAGE(PG8_SB(0, 0), cB, voffB); PG8_STAGE(PG8_SA(0, 0), cA, voffA); PG8_STAGE(PG8_SB(0, 1), cB + hstep, voffB); PG8_STAGE(PG8_SA(0, 1), cA + hstep, voffA);
        if (wr == 1) PG8_BAR;
        PG8_WAIT_V(4); PG8_BAR;
        PG8_STAGE(PG8_SB(1, 0), cB + kstep, voffB); PG8_STAGE(PG8_SA(1, 0), cA + kstep, voffA); PG8_STAGE(PG8_SB(1, 1), cB + hstep + kstep, voffB);
        PG8_WAIT_V(6); PG8_BAR;
    }
    for (;;) {
        const bool has_next = S.next(ui + 1, nxt);
        const char* nA = has_next ? (const char*)g.A + (size_t)nxt.pm * tstep + nxt.kh * khb : cA; const char* nB = has_next ? (const char*)g.Bt + (size_t)nxt.pn * tstep + nxt.kh * khb : cB;
        for (int t = 0; t < nt; t += 2) {
            const bool last = (t == nt - 2);
            const char* a1 = cA + (size_t)(t + 1) * kstep;
            const char* a2 = last ? nA : cA + (size_t)(t + 2) * kstep; const char* b2 = last ? nB : cB + (size_t)(t + 2) * kstep;
            const char* a3 = a2 + kstep; const char* b3 = b2 + kstep;
            if (last && has_next) S.a_ready(nxt);
            if constexpr (SP2) {
            PG8_LDB(B0, 0, 0); PG8_LDB(B1, 0, 1); PG8_SCHED; PG8_LDA(At, 0, 0); PG8_STAGE(PG8_SA(1, 1), a1 + hstep, voffA);
            PG8_WAIT_V(8); PG8_WAIT_L(0); PG8_BAR; PG8_MMA(0, 0, At, B0); PG8_MMA(0, 1, At, B1); PG8_BAR; PG8_SCHED;
            PG8_LDA(At, 0, 1); PG8_STAGE(PG8_SB(0, 0), b2, voffB); PG8_STAGE(PG8_SB(0, 1), b2 + hstep, voffB); PG8_STAGE(PG8_SA(0, 0), a2, voffA);
            PG8_WAIT_V(8); PG8_WAIT_L(0); PG8_BAR; PG8_MMA(1, 0, At, B0); PG8_MMA(1, 1, At, B1); PG8_BAR; PG8_SCHED;
            PG8_LDB(B0, 1, 0); PG8_LDB(B1, 1, 1); PG8_SCHED; PG8_LDA(At, 1, 0); PG8_STAGE(PG8_SA(0, 1), a2 + hstep, voffA);
            PG8_WAIT_V(8); PG8_WAIT_L(0); PG8_BAR; PG8_MMA(0, 0, At, B0); PG8_MMA(0, 1, At, B1); PG8_BAR; PG8_SCHED;
            PG8_LDA(At, 1, 1); PG8_STAGE(PG8_SB(1, 0), b3, voffB); PG8_STAGE(PG8_SB(1, 1), b3 + hstep, voffB); PG8_STAGE(PG8_SA(1, 0), a3, voffA);
            PG8_WAIT_V(8); PG8_WAIT_L(0); PG8_BAR; PG8_MMA(1, 0, At, B0); PG8_MMA(1, 1, At, B1); PG8_BAR; PG8_SCHED;
            } else {
            PG8_LDB(B0, 0, 0); PG8_SCHED; PG8_LDA(At, 0, 0); PG8_STAGE(PG8_SA(1, 1), a1 + hstep, voffA);
            PG8_WAIT_L(8); PG8_BAR; PG8_WAIT_L(0); PG8_MMA(0, 0, At, B0); PG8_BAR; PG8_SCHED;
            PG8_LDB(B1, 0, 1); PG8_STAGE(PG8_SB(0, 0), b2, voffB);
            PG8_BAR; PG8_WAIT_L(0); PG8_MMA(0, 1, At, B1); PG8_BAR;
            PG8_LDA(At, 0, 1); PG8_STAGE(PG8_SA(0, 0), a2, voffA);
            PG8_BAR; PG8_WAIT_L(0); PG8_MMA(1, 0, At, B0); PG8_BAR; PG8_SCHED;
            PG8_STAGE(PG8_SB(0, 1), b2 + hstep, voffB);
            PG8_WAIT_V(6); PG8_BAR; PG8_MMA(1, 1, At, B1); PG8_BAR;
            PG8_LDB(B0, 1, 0); PG8_SCHED; PG8_LDA(At, 1, 0); PG8_STAGE(PG8_SA(0, 1), a2 + hstep, voffA);
            PG8_WAIT_L(8); PG8_BAR; PG8_WAIT_L(0); PG8_MMA(0, 0, At, B0); PG8_BAR; PG8_SCHED;
            PG8_LDB(B1, 1, 1); PG8_STAGE(PG8_SB(1, 0), b3, voffB);
            PG8_BAR; PG8_WAIT_L(0); PG8_MMA(0, 1, At, B1); PG8_BAR;
            PG8_LDA(At, 1, 1); PG8_STAGE(PG8_SA(1, 0), a3, voffA);
            PG8_BAR; PG8_WAIT_L(0); PG8_MMA(1, 0, At, B0); PG8_BAR; PG8_SCHED;
            PG8_STAGE(PG8_SB(1, 1), b3 + hstep, voffB);
            PG8_WAIT_V(6); PG8_BAR; PG8_MMA(1, 1, At, B1); PG8_BAR;
            }
        }
        if constexpr (ALIGN_EPI) { if (wr == 0) PG8_BAR; }
        bool keep = false;
        if constexpr (Epi::HAS_MID) { if (cur.kh == 0) { E.mid(acc, cur, wr, wc, fr, fq); keep = true; } }
        if (!keep) { if constexpr (!Epi::AFTER_DRAIN) { E(acc, cur, wr, wc, fr, fq); S.done(cur); } }
        if (!has_next) break;
        if (!keep) {
#pragma unroll
        for (int a = 0; a < 2; ++a)
#pragma unroll
            for (int b = 0; b < 2; ++b)
#pragma unroll
                for (int m = 0; m < 4; ++m)
#pragma unroll
                    for (int n = 0; n < 2; ++n) acc[a][b][m][n] = (f32x4){0.f, 0.f, 0.f, 0.f};
        }
        cur = nxt; cA = nA; cB = nB; ++ui;
        if constexpr (ALIGN_EPI) { if (wr == 1) PG8_BAR; }
    }
    PG8_WAIT_V(0);
    if constexpr (!ALIGN_EPI) { if (wr == 0) PG8_BAR; }
    PG8_BAR;
    if constexpr (Epi::AFTER_DRAIN) { E.fused(acc, cur, wr, wc, fr, fq, lds, wid, lane); S.done(cur); }
#undef PG8_SA
#undef PG8_SB
#undef PG8_STAGE
#undef PG8_LDA
#undef PG8_LDB
#undef PG8_MMA
#undef PG8_WAIT_V
#undef PG8_WAIT_L
#undef PG8_BAR
#undef PG8_SCHED
}
}

typedef unsigned short bf16;
typedef unsigned v4u __attribute__((ext_vector_type(4)));
typedef float f32x4 __attribute__((ext_vector_type(4)));
typedef short bf16x8 __attribute__((ext_vector_type(8)));
constexpr int NWAVES = 8, NTHR = 512;
#define MFMA16(a, b, c) __builtin_amdgcn_mfma_f32_16x16x32_bf16((a), (b), (c), 0, 0, 0)
#define LDS_FENCE() asm volatile("s_waitcnt lgkmcnt(0)" ::: "memory")

struct Args {
    const float* in[25]; float* out; unsigned char* ws; int ph_lo, ph_hi;
};
struct Frame {
    LAS unsigned char* lds; int tid, lane, wave, G, bid;
    const float* in[25]; float* out; unsigned char* ws;
};
constexpr size_t O_YP = 0, O_YS = (size_t)TP * DM, O_HP = O_YS + (size_t)NSMP * DM, O_S5RP = O_HP + (size_t)NB * NH * HD * HD, O_S5IP = O_S5RP + NB * SG * SN,
                 O_HS = O_S5IP + NB * SG * SN, O_S5RS = O_HS + (size_t)NSMP * NH * HD * HD, O_S5IS = O_S5RS + (size_t)NSMP * SG * SN, O_END = O_S5IS + (size_t)NSMP * SG * SN;
enum { I_XP = 0, I_XS, I_SH, I_SRE, I_SIM, I_LB, I_N1, I_WIN, I_HG, I_LRE, I_LIM, I_LDT, I_BRE, I_BIM, I_CRE, I_CIM, I_D, I_WGLU, I_WPA, I_WPB, I_WOUT, I_N2, I_WUP, I_WDN, I_NF };

DI void p0_transpose_item(const float* W, int K, int N, bf16* WT, int ldk, int koff, int glu_half, const float* gk, LAS float* scr, int item, int lane) {
    const int nblk = N / 32, kb = item / nblk, nb = item % nblk, k0 = 64 * kb, n0 = 32 * nb;
    int d0 = n0;
    if (glu_half) { const int hf = n0 >= glu_half ? 1 : 0, nn = n0 - hf * glu_half; d0 = (nn / 128) * 256 + hf * 128 + (nn % 128); }
#pragma unroll 8
    for (int i = 0; i < 32; ++i) { const int kk = 2 * i + (lane >> 5); float v = W[(size_t)(k0 + kk) * N + n0 + (lane & 31)]; if (gk) v *= gk[k0 + kk]; scr[kk * 33 + (lane & 31)] = v; }
    LDS_FENCE();
    const int c = lane & 7;
#pragma unroll
    for (int j = 0; j < 4; ++j) { const int n = (lane >> 3) + 8 * j; const LAS float* s = scr + (8 * c) * 33 + n;
        v4u o; o.x = pk2(s[0 * 33], s[1 * 33]); o.y = pk2(s[2 * 33], s[3 * 33]); o.z = pk2(s[4 * 33], s[5 * 33]); o.w = pk2(s[6 * 33], s[7 * 33]);
        *(v4u*)(WT + (size_t)(d0 + n) * ldk + koff + k0 + 8 * c) = o; }
    LDS_FENCE();
}
DI double exp_d(double x) {
    const double k = __builtin_rint(x * 1.4426950408889634); const double r = (x - k * 0.693147180369123816490e+00) - k * 1.90821492927058770002e-10;
    double p = 1.0 / 6227020800.0;
    p = p * r + 1.0 / 479001600.0; p = p * r + 1.0 / 39916800.0; p = p * r + 1.0 / 3628800.0; p = p * r + 1.0 / 362880.0; p = p * r + 1.0 / 40320.0; p = p * r + 1.0 / 5040.0;
    p = p * r + 1.0 / 720.0; p = p * r + 1.0 / 120.0; p = p * r + 1.0 / 24.0; p = p * r + 1.0 / 6.0; p = p * r + 0.5; p = p * r + 1.0; p = p * r + 1.0;
    const long long ki = (long long)k; const double sc = __builtin_bit_cast(double, (unsigned long long)(1023 + ki) << 52);
    return p * sc;
}
DI void sincos_d(double x, double& s, double& c) {
    const double k = __builtin_rint(x * 0.15915494309189535); double r = (x - k * 6.28318530717958623200e+00) - k * 2.44929359829470635445e-16;
    const double q = r * 0.25, q2 = q * q;
    double sp = -1.0 / 1307674368000.0; sp = sp * q2 + 1.0 / 6227020800.0; sp = sp * q2 - 1.0 / 39916800.0; sp = sp * q2 + 1.0 / 362880.0; sp = sp * q2 - 1.0 / 5040.0; sp = sp * q2 + 1.0 / 120.0; sp = sp * q2 - 1.0 / 6.0; sp = sp * q2 + 1.0;
    double cp = 1.0 / 20922789888000.0; cp = cp * q2 - 1.0 / 87178291200.0; cp = cp * q2 + 1.0 / 479001600.0; cp = cp * q2 - 1.0 / 3628800.0; cp = cp * q2 + 1.0 / 40320.0; cp = cp * q2 - 1.0 / 720.0; cp = cp * q2 + 1.0 / 24.0; cp = cp * q2 - 0.5; cp = cp * q2 + 1.0;
    double s1 = sp * q, c1 = cp;
    double s2 = 2.0 * s1 * c1, c2 = c1 * c1 - s1 * s1;
    s = 2.0 * s2 * c2; c = c2 * c2 - s2 * s2;
}
DI void p0_prologue(Frame& F) {
    LAS float* scr = (LAS float*)(F.lds + F.wave * 16384);
    const int gw = F.bid * NWAVES + F.wave, NGW = F.G * NWAVES;
    bf16* Win_t = (bf16*)(F.ws + WS_WIN); bf16* Wglu_t = (bf16*)(F.ws + WS_WGLU); bf16* Wcat_t = (bf16*)(F.ws + WS_WCAT); bf16* Wout_t = (bf16*)(F.ws + WS_WOUT);
    bf16* Wup_t = (bf16*)(F.ws + WS_WUP); bf16* Wdn_t = (bf16*)(F.ws + WS_WDN);
    constexpr int IT_IN = (DM / 64) * (NIN / 32), IT_GLU = (SW / 64) * (2 * SW / 32), IT_PA = (HW / 64) * (DM / 32), IT_PB = (SW / 64) * (DM / 32), IT_OUT = (DM / 64) * (DM / 32),
                  IT_UP = (DM / 64) * (2 * FF / 32), IT_DN = (FF / 64) * (DM / 32), NITEMS = IT_IN + IT_GLU + IT_PA + IT_PB + IT_OUT + IT_UP + IT_DN;
    for (int it = gw; it < NITEMS; it += NGW) {
        int r = it;
        if (r < IT_UP) { p0_transpose_item(F.in[I_WUP], DM, 2 * FF, Wup_t, DM, 0, FF, F.in[I_N2], scr, r, F.lane); continue; } r -= IT_UP;
        if (r < IT_IN) { p0_transpose_item(F.in[I_WIN], DM, NIN, Win_t, DM, 0, 0, F.in[I_N1], scr, r, F.lane); continue; } r -= IT_IN;
        if (r < IT_DN) { p0_transpose_item(F.in[I_WDN], FF, DM, Wdn_t, FF, 0, 0, nullptr, scr, r, F.lane); continue; } r -= IT_DN;
        if (r < IT_OUT) { p0_transpose_item(F.in[I_WOUT], DM, DM, Wout_t, DM, 0, 0, nullptr, scr, r, F.lane); continue; } r -= IT_OUT;
        if (r < IT_GLU) { p0_transpose_item(F.in[I_WGLU], SW, 2 * SW, Wglu_t, SW, 0, SW, nullptr, scr, r, F.lane); continue; } r -= IT_GLU;
        if (r < IT_PA) { p0_transpose_item(F.in[I_WPA], HW, DM, Wcat_t, 2048, 0, 0, nullptr, scr, r, F.lane); continue; } r -= IT_PA;
        p0_transpose_item(F.in[I_WPB], SW, DM, Wcat_t, 2048, 1024, 0, nullptr, scr, r, F.lane);
    }
    bf16* xb = (bf16*)(F.ws + WS_XB); float* rs1 = (float*)(F.ws + WS_RS1);
    for (int m = gw; m < MP; m += NGW) {
        unsigned long long* o8 = (unsigned long long*)(xb + (size_t)m * DM) + F.lane;
        if (m < MV) {
            const float* xr = m < TP ? F.in[I_XP] + (size_t)m * DM : F.in[I_XS] + (size_t)(m - TP) * DM;
            const f32x4* x4 = (const f32x4*)xr + F.lane; f32x4 v[8]; float s = 0.f;
#pragma unroll
            for (int j = 0; j < 8; ++j) { v[j] = x4[64 * j]; s += (v[j].x * v[j].x + v[j].y * v[j].y) + (v[j].z * v[j].z + v[j].w * v[j].w); }
            s = wave_sum(s);
            if (F.lane == 0) rs1[m] = 1.0f / sqrtf(s * (1.0f / DM) + RMS_EPS);
#pragma unroll
            for (int j = 0; j < 8; ++j) o8[64 * j] = (unsigned long long)pk2(v[j].x, v[j].y) | ((unsigned long long)pk2(v[j].z, v[j].w) << 32);
        } else {
            if (F.lane == 0) rs1[m] = 0.f;
#pragma unroll
            for (int j = 0; j < 8; ++j) o8[64 * j] = 0ull;
        }
    }
    { float* ss2 = (float*)(F.ws + WS_SS2); float* ss3 = (float*)(F.ws + WS_SS3); float* lb = (float*)(F.ws + WS_LB);
      for (int i = F.bid * NTHR + F.tid; i < MP; i += F.G * NTHR) { ss2[i] = 0.f; ss3[i] = 0.f; }
      for (int i = F.bid * NTHR + F.tid; i < HW; i += F.G * NTHR) { const float l0 = F.in[I_LB][i], l1 = F.in[I_LB][HW + i]; lb[i] = 1.0f / (1.0f + expf(l1 - l0)); } }
    for (int g = gw; g < SG; g += NGW) {
        const int n = F.lane;
        const double dt = exp_d((double)F.in[I_LDT][g]);
        const double lr = (double)F.in[I_LRE][g * SN + n], li = (double)F.in[I_LIM][g * SN + n];
        const double mag = exp_d(lr * dt); double sn, cs; sincos_d(li * dt, sn, cs);
        const double are = mag * cs, aim = mag * sn, den = lr * lr + li * li, nr = are - 1.0, ni = aim;
        const double zre = (nr * lr + ni * li) / den, zim = (ni * lr - nr * li) / den;
        double pr = are, pi = aim;
#pragma unroll 1
        for (int i = 0; i < 8; ++i) { const double t = pr * pr - pi * pi; pi = 2.0 * pr * pi; pr = t; }
        float* pa = (float*)(F.ws + WS_PARA) + (size_t)g * 256;
        pa[n] = (float)are; pa[64 + n] = (float)aim; pa[128 + n] = (float)pr; pa[192 + n] = (float)pi;
        bf16* pb = (bf16*)(F.ws + WS_PARB) + (size_t)g * 2048;
        const float* Bre = F.in[I_BRE] + ((size_t)g * SN + n) * SPC; const float* Bim = F.in[I_BIM] + ((size_t)g * SN + n) * SPC;
#pragma unroll
        for (int p = 0; p < SPC; ++p) { const double br = (double)Bre[p], bi = (double)Bim[p];
            pb[n * 16 + p] = f2bf((float)(zre * br - zim * bi)); pb[(64 + n) * 16 + p] = f2bf((float)(zre * bi + zim * br)); }
        bf16* pc = (bf16*)(F.ws + WS_PARC) + (size_t)g * 2048;
#pragma unroll
        for (int p = 0; p < SPC; ++p) { pc[p * 128 + n] = f2bf(F.in[I_CRE][((size_t)g * SPC + p) * SN + n]); pc[p * 128 + 64 + n] = f2bf(-F.in[I_CIM][((size_t)g * SPC + p) * SN + n]); }
    }
}

DI float gelu1(float v) {
    const float av = fabsf(v), t = __builtin_amdgcn_rcpf(av * 0.2316418882f + 1.0f);
    float q = t * 0.5307027145f + (-0.7265760135f); q = q * t + 0.7107068705f; q = q * t + (-0.142248368f); q = q * t + 0.127414796f; q = q * t;
    const float e = __builtin_amdgcn_exp2f((v * v) * (-0.72134752044f));
    const float m = v * (q * e);
    return v < 0.f ? m : v - m;
}

constexpr int S5_BU_STRIDE = 132  , S5_H_STRIDE = 272  , S5_WAVE_BYTES = 16 * S5_BU_STRIDE * 4 + 16 * S5_H_STRIDE  , S5_HE_OFF = 8 * S5_WAVE_BYTES;
DI void s5_prompt_unit(Frame& F, int unit) {
    const int b = unit >> 6, g = unit & 63, lane = F.lane, w = F.wave, r16 = lane & 15, q4 = lane >> 4;
    LAS float* BU = (LAS float*)(F.lds + w * S5_WAVE_BYTES);
    LAS unsigned char* Hb = F.lds + w * S5_WAVE_BYTES + 16 * S5_BU_STRIDE * 4;
    LAS float* HE = (LAS float*)(F.lds + S5_HE_OFF);
    const bf16* Pb = (const bf16*)(F.ws + WS_PB);
    const float* pa = (const float*)(F.ws + WS_PARA) + (size_t)g * 256;
    const float ar = pa[lane], ai = pa[64 + lane], a256r = pa[128 + lane], a256i = pa[192 + lane];
    const bf16* pb = (const bf16*)(F.ws + WS_PARB) + (size_t)g * 2048; const bf16* pc = (const bf16*)(F.ws + WS_PARC) + (size_t)g * 2048;
    bf16x8 Bf[8], Cf[4];
    const bf16x8 zero8 = {0, 0, 0, 0, 0, 0, 0, 0};
#pragma unroll
    for (int nb = 0; nb < 8; ++nb) Bf[nb] = q4 < 2 ? *(const bf16x8*)(pb + (nb * 16 + r16) * 16 + 8 * q4) : zero8;
#pragma unroll
    for (int ks = 0; ks < 4; ++ks) Cf[ks] = *(const bf16x8*)(pc + r16 * 128 + ks * 32 + 8 * q4);
    const float dsk = F.in[I_D][g * 16 + r16];
    const size_t row0 = (size_t)b * TSEQ + w * 256;
    const bf16* ucol = Pb + C_U + g * 16;
    float hr = 0.f, hi = 0.f;
#pragma unroll 1
    for (int pass = 0; pass < 2; ++pass) {
        if (pass == 1) {
            HE[w * 128 + lane] = hr; HE[w * 128 + 64 + lane] = hi;
            __syncthreads();
            float cr = 0.f, ci = 0.f;
            for (int j = 0; j < w; ++j) { const float er = HE[j * 128 + lane], ei = HE[j * 128 + 64 + lane]; const float t = a256r * cr - a256i * ci + er; ci = a256r * ci + a256i * cr + ei; cr = t; }
            if (w == 7) { const float fr_ = a256r * cr - a256i * ci + hr, fi_ = a256r * ci + a256i * cr + hi;
                F.out[O_S5RP + ((size_t)b * SG + g) * SN + lane] = fr_; F.out[O_S5IP + ((size_t)b * SG + g) * SN + lane] = fi_; }
            hr = cr; hi = ci;
        }
#pragma unroll 1
        for (int tile = 0; tile < 16; ++tile) {
            const size_t trow = row0 + tile * 16;
            const bf16x8 uf = q4 < 2 ? *(const bf16x8*)(ucol + (trow + r16) * NIN + 8 * q4) : zero8;
#pragma unroll
            for (int nb = 0; nb < 8; ++nb) { f32x4 a = {0.f, 0.f, 0.f, 0.f}; a = MFMA16(uf, Bf[nb], a);
#pragma unroll
                for (int i = 0; i < 4; ++i) BU[(4 * q4 + i) * S5_BU_STRIDE + nb * 16 + r16] = a[i]; }
            LDS_FENCE();
            if (pass == 0) {
#pragma unroll
                for (int tt = 0; tt < 16; ++tt) { const float br = BU[tt * S5_BU_STRIDE + lane], bi = BU[tt * S5_BU_STRIDE + 64 + lane];
                    const float t = ar * hr - ai * hi + br; hi = ar * hi + ai * hr + bi; hr = t; }
                LDS_FENCE();
            } else {
#pragma unroll
                for (int tt = 0; tt < 16; ++tt) { const float br = BU[tt * S5_BU_STRIDE + lane], bi = BU[tt * S5_BU_STRIDE + 64 + lane];
                    const float t = ar * hr - ai * hi + br; hi = ar * hi + ai * hr + bi; hr = t;
                    *(LAS unsigned short*)(Hb + tt * S5_H_STRIDE + lane * 2) = f2bf(hr); *(LAS unsigned short*)(Hb + tt * S5_H_STRIDE + 128 + lane * 2) = f2bf(hi); }
                LDS_FENCE();
                f32x4 y = {0.f, 0.f, 0.f, 0.f};
#pragma unroll
                for (int ks = 0; ks < 4; ++ks) { const bf16x8 hf = *(const LAS bf16x8*)(Hb + r16 * S5_H_STRIDE + (ks * 32 + 8 * q4) * 2); y = MFMA16(hf, Cf[ks], y); }
                bf16* Z = (bf16*)(F.ws + WS_Z);
#pragma unroll
                for (int i = 0; i < 4; ++i) { const size_t rr = trow + 4 * q4 + i; const float uv = bf2f(ucol[rr * NIN + r16]);
                    Z[rr * SW + g * 16 + r16] = f2bf(gelu1(y[i] + dsk * uv)); }
                LDS_FENCE();
            }
        }
    }
    __syncthreads();
}
DI void s5_sample_wave(Frame& F, int bs, int g) {
    const int lane = F.lane, r16 = lane & 15, q4 = lane >> 4;
    LAS float* hv = (LAS float*)(F.lds + F.wave * 512);
    const float* pa = (const float*)(F.ws + WS_PARA) + (size_t)g * 256; const float ar = pa[lane], ai = pa[64 + lane];
    const bf16* pb = (const bf16*)(F.ws + WS_PARB) + (size_t)g * 2048;
    const bf16* urow = (const bf16*)(F.ws + WS_PB) + (size_t)(TP + bs) * NIN + C_U + g * 16;
    const v4u u0 = *(const v4u*)urow, u1 = *(const v4u*)(urow + 8);
    const v4u bre0 = *(const v4u*)(pb + lane * 16), bre1 = *(const v4u*)(pb + lane * 16 + 8), bim0 = *(const v4u*)(pb + (64 + lane) * 16), bim1 = *(const v4u*)(pb + (64 + lane) * 16 + 8);
    float br = 0.f, bi = 0.f;
#define S5ACC(uw, rw, iw) { br += bflo(uw) * bflo(rw) + bfhi(uw) * bfhi(rw); bi += bflo(uw) * bflo(iw) + bfhi(uw) * bfhi(iw); }
    S5ACC(u0.x, bre0.x, bim0.x) S5ACC(u0.y, bre0.y, bim0.y) S5ACC(u0.z, bre0.z, bim0.z) S5ACC(u0.w, bre0.w, bim0.w)
    S5ACC(u1.x, bre1.x, bim1.x) S5ACC(u1.y, bre1.y, bim1.y) S5ACC(u1.z, bre1.z, bim1.z) S5ACC(u1.w, bre1.w, bim1.w)
#undef S5ACC
    const size_t so = ((size_t)bs * SG + g) * SN + lane;
    const float h0r = F.in[I_SRE][so], h0i = F.in[I_SIM][so];
    const float hr = ar * h0r - ai * h0i + br, hi = ar * h0i + ai * h0r + bi;
    F.out[O_S5RS + so] = hr; F.out[O_S5IS + so] = hi;
    hv[lane] = hr; hv[64 + lane] = hi;
    LDS_FENCE();
    const float* cre = F.in[I_CRE] + ((size_t)g * SPC + r16) * SN + 16 * q4; const float* cim = F.in[I_CIM] + ((size_t)g * SPC + r16) * SN + 16 * q4;
    float y = 0.f;
#pragma unroll
    for (int j = 0; j < 16; ++j) y += cre[j] * hv[16 * q4 + j] - cim[j] * hv[64 + 16 * q4 + j];
    y += __shfl_xor(y, 16); y += __shfl_xor(y, 32);
    const float uv = bf2f(urow[r16]);
    if (q4 == 0) ((bf16*)(F.ws + WS_Z))[(size_t)(TP + bs) * SW + g * 16 + r16] = f2bf(gelu1(y + F.in[I_D][g * 16 + r16] * uv));
    LDS_FENCE();
}

constexpr int HQ_STRIDE = 272, HK_STRIDE = 80;
constexpr int L_QT = 0, L_KT = 8704, L_QIN = 17408, L_KU = 26112, L_VT = 36352, L_ST = 46592, L_SC = 81408, L_PT = 83968, L_G16 = 88064, L_DEC = 88576, L_HG_END = 89088;
DI void hgrn_local_unit(Frame& F, int unit) {
    const int b = unit >> 6, h = (unit >> 3) & 7, sc = unit & 7, lane = F.lane, w = F.wave, r16 = lane & 15, q4 = lane >> 4;
    LAS unsigned char* L = F.lds;
    bf16* Pb = (bf16*)(F.ws + WS_PB);
    float* OL = (float*)(F.ws + WS_OL);
    const float* lbp = (const float*)(F.ws + WS_LB) + h * HD + 2 * lane;
    const float lb0 = lbp[0], lb1 = lbp[1];
    const size_t urow0 = (size_t)b * TSEQ + sc * 256;
    f32x4 S[8];
#pragma unroll
    for (int kb = 0; kb < 8; ++kb) S[kb] = (f32x4){0.f, 0.f, 0.f, 0.f};
#pragma unroll
    for (int kb = 0; kb < 8; ++kb) *(LAS u32x2*)(L + L_ST + (w * 16 + r16) * HQ_STRIDE + (kb * 16 + 4 * q4) * 2) = (u32x2){0u, 0u};
    float Bp0 = 0.f, Bp1 = 0.f;
    unsigned qn[4], fn[4], vn[4];
#pragma unroll
    for (int j = 0; j < 4; ++j) { const bf16* rp = Pb + (urow0 + 4 * w + j) * NIN + h * HD + 2 * lane; qn[j] = *(const unsigned*)(rp + C_Q); fn[j] = *(const unsigned*)(rp + C_F); vn[j] = *(const unsigned*)(rp + C_I); }
#pragma unroll 1
    for (int c = 0; c < 8; ++c) {
        const size_t t0 = urow0 + c * 32;
        unsigned qc[4], fc[4], vc[4];
#pragma unroll
        for (int j = 0; j < 4; ++j) { qc[j] = qn[j]; fc[j] = fn[j]; vc[j] = vn[j]; }
        if (c < 7) {
#pragma unroll
            for (int j = 0; j < 4; ++j) { const bf16* rp = Pb + (t0 + 32 + 4 * w + j) * NIN + h * HD + 2 * lane; qn[j] = *(const unsigned*)(rp + C_Q); fn[j] = *(const unsigned*)(rp + C_F); vn[j] = *(const unsigned*)(rp + C_I); }
        }
        float kk0[4], kk1[4], cu0[4], cu1[4]; float g16a = 0.f, g16b = 0.f;
        { float c0 = 0.f, c1 = 0.f;
#pragma unroll
          for (int j = 0; j < 4; ++j) { const float f0 = lb0 + (1.f - lb0) * sigm(bflo(fc[j])), f1 = lb1 + (1.f - lb1) * sigm(bfhi(fc[j]));
              const float g0 = __logf(f0), g1 = __logf(f1); kk0[j] = 1.f - f0; kk1[j] = 1.f - f1; c0 += g0; c1 += g1; cu0[j] = c0; cu1[j] = c1; if (j == 0) { g16a = g0; g16b = g1; } } }
        *(LAS f32x2*)(L + L_PT + (w * 128 + 2 * lane) * 4) = (f32x2){cu0[3], cu1[3]};
        if (w == 4) *(LAS f32x2*)(L + L_G16 + 2 * lane * 4) = (f32x2){g16a, g16b};
        __syncthreads();
        float pre0 = 0.f, pre1 = 0.f, tot0 = 0.f, tot1 = 0.f, mid0 = 0.f, mid1 = 0.f;
#pragma unroll
        for (int j = 0; j < 8; ++j) { const f32x2 p = *(const LAS f32x2*)(L + L_PT + (j * 128 + 2 * lane) * 4); tot0 += p.x; tot1 += p.y; if (j < w) { pre0 += p.x; pre1 += p.y; } if (j < 4) { mid0 += p.x; mid1 += p.y; } }
        { const f32x2 p = *(const LAS f32x2*)(L + L_G16 + 2 * lane * 4); mid0 += p.x; mid1 += p.y; }
        unsigned ku0[2], ku1[2], vt0[2], vt1[2];
        { float kuA[4], kuB[4];
#pragma unroll
          for (int j = 0; j < 4; ++j) {
              const float b0 = pre0 + cu0[j], b1 = pre1 + cu1[j]; const float q0 = bflo(qc[j]), q1 = bfhi(qc[j]);
              const int trow = 4 * w + j;
              *(LAS unsigned*)(L + L_QT + trow * HQ_STRIDE + lane * 4) = pk2(q0 * fexp(b0 - mid0), q1 * fexp(b1 - mid1));
              *(LAS unsigned*)(L + L_KT + trow * HQ_STRIDE + lane * 4) = pk2(kk0[j] * fexp(mid0 - b0), kk1[j] * fexp(mid1 - b1));
              *(LAS unsigned*)(L + L_QIN + trow * HQ_STRIDE + lane * 4) = pk2(q0 * fexp(b0), q1 * fexp(b1));
              kuA[j] = kk0[j] * fexp(tot0 - b0); kuB[j] = kk1[j] * fexp(tot1 - b1);
              *(unsigned*)(Pb + (t0 + trow) * NIN + C_Q + h * HD + 2 * lane) = pk2(q0 * fexp(Bp0 + b0), q1 * fexp(Bp1 + b1));
          }
          ku0[0] = pk2(kuA[0], kuA[1]); ku0[1] = pk2(kuA[2], kuA[3]); ku1[0] = pk2(kuB[0], kuB[1]); ku1[1] = pk2(kuB[2], kuB[3]); }
        vt0[0] = (vc[0] & 0xffffu) | (vc[1] << 16); vt0[1] = (vc[2] & 0xffffu) | (vc[3] << 16);
        vt1[0] = (vc[0] >> 16) | (vc[1] & 0xffff0000u); vt1[1] = (vc[2] >> 16) | (vc[3] & 0xffff0000u);
        *(LAS u32x2*)(L + L_KU + (2 * lane) * HK_STRIDE + 8 * w) = (u32x2){ku0[0], ku0[1]};
        *(LAS u32x2*)(L + L_KU + (2 * lane + 1) * HK_STRIDE + 8 * w) = (u32x2){ku1[0], ku1[1]};
        *(LAS u32x2*)(L + L_VT + (2 * lane) * HK_STRIDE + 8 * w) = (u32x2){vt0[0], vt0[1]};
        *(LAS u32x2*)(L + L_VT + (2 * lane + 1) * HK_STRIDE + 8 * w) = (u32x2){vt1[0], vt1[1]};
        if (w == 0) *(LAS f32x2*)(L + L_DEC + 2 * lane * 4) = (f32x2){fexp(tot0), fexp(tot1)};
        Bp0 += tot0; Bp1 += tot1;
        __syncthreads();
        if (w < 3) {
            const int tb = w == 0 ? 0 : 1, sb = w == 2 ? 1 : 0;
            f32x4 a = {0.f, 0.f, 0.f, 0.f};
#pragma unroll
            for (int ks = 0; ks < 4; ++ks) { const bf16x8 af = *(const LAS bf16x8*)(L + L_QT + (tb * 16 + r16) * HQ_STRIDE + (ks * 32 + 8 * q4) * 2), bf = *(const LAS bf16x8*)(L + L_KT + (sb * 16 + r16) * HQ_STRIDE + (ks * 32 + 8 * q4) * 2); a = MFMA16(af, bf, a); }
#pragma unroll
            for (int i = 0; i < 4; ++i) { const int t = tb * 16 + 4 * q4 + i, s = sb * 16 + r16; *(LAS unsigned short*)(L + L_SC + t * HK_STRIDE + s * 2) = s <= t ? f2bf(a[i]) : (unsigned short)0; }
        } else if (w == 3) {
#pragma unroll
            for (int i = 0; i < 4; ++i) *(LAS unsigned short*)(L + L_SC + (4 * q4 + i) * HK_STRIDE + (16 + r16) * 2) = (unsigned short)0;
        }
        __syncthreads();
        const bf16x8 vtf = *(const LAS bf16x8*)(L + L_VT + (w * 16 + r16) * HK_STRIDE + 16 * q4);
        bf16x8 stf[4];
#pragma unroll
        for (int ks = 0; ks < 4; ++ks) stf[ks] = *(const LAS bf16x8*)(L + L_ST + (w * 16 + r16) * HQ_STRIDE + (ks * 32 + 8 * q4) * 2);
#pragma unroll
        for (int tb = 0; tb < 2; ++tb) {
            f32x4 o = {0.f, 0.f, 0.f, 0.f};
            { const bf16x8 sf = *(const LAS bf16x8*)(L + L_SC + (tb * 16 + r16) * HK_STRIDE + 16 * q4); o = MFMA16(sf, vtf, o); }
#pragma unroll
            for (int ks = 0; ks < 4; ++ks) { const bf16x8 qf = *(const LAS bf16x8*)(L + L_QIN + (tb * 16 + r16) * HQ_STRIDE + (ks * 32 + 8 * q4) * 2); o = MFMA16(qf, stf[ks], o); }
#pragma unroll
            for (int i = 0; i < 4; ++i) OL[(t0 + tb * 16 + 4 * q4 + i) * HW + h * HD + w * 16 + r16] = o[i];
        }
#pragma unroll
        for (int kb = 0; kb < 8; ++kb) {
            const f32x4 d = *(const LAS f32x4*)(L + L_DEC + (kb * 16 + 4 * q4) * 4);
            const bf16x8 kf = *(const LAS bf16x8*)(L + L_KU + (kb * 16 + r16) * HK_STRIDE + 16 * q4);
            S[kb] = MFMA16(kf, vtf, S[kb] * d);
            *(LAS u32x2*)(L + L_ST + (w * 16 + r16) * HQ_STRIDE + (kb * 16 + 4 * q4) * 2) = (u32x2){pk2(S[kb][0], S[kb][1]), pk2(S[kb][2], S[kb][3])};
        }
    }
    float* USC = (float*)(F.ws + WS_USC) + (size_t)unit * HD * HD; float* DSC = (float*)(F.ws + WS_DSC) + (size_t)unit * HD;
#pragma unroll
    for (int kb = 0; kb < 8; ++kb)
#pragma unroll
        for (int i = 0; i < 4; ++i) USC[(kb * 16 + 4 * q4 + i) * HD + w * 16 + r16] = S[kb][i];
    if (w == 0) { DSC[2 * lane] = fexp(Bp0); DSC[2 * lane + 1] = fexp(Bp1); }
    __syncthreads();
}

DI void hgrn_sample_unit(Frame& F, int unit) {
    const int bs = unit >> 3, h = unit & 7, tid = F.tid, lane = F.lane, w = F.wave;
    LAS float* part = (LAS float*)F.lds;
    const bf16* prow = (const bf16*)(F.ws + WS_PB) + (size_t)(TP + bs) * NIN + h * HD;
    const float* lb = (const float*)(F.ws + WS_LB) + h * HD;
    const int vq = tid & 31, kr = tid >> 5;
    const float* S0 = F.in[I_SH] + ((size_t)bs * NH + h) * HD * HD; float* S1 = F.out + O_HS + ((size_t)bs * NH + h) * HD * HD;
    f32x4 iv; { const u32x2 t = *(const u32x2*)(prow + C_I + 4 * vq); iv = (f32x4){bflo(t.x), bfhi(t.x), bflo(t.y), bfhi(t.y)}; }
    f32x4 o = {0.f, 0.f, 0.f, 0.f};
#pragma unroll
    for (int j = 0; j < 8; ++j) { const int k = kr + 16 * j;
        const float l = lb[k], f = l + (1.f - l) * sigm(bf2f(prow[C_F + k])), q = bf2f(prow[C_Q + k]);
        const f32x4 s = *(const f32x4*)(S0 + (size_t)k * HD + 4 * vq) * f + iv * (1.f - f);
        *(f32x4*)(S1 + (size_t)k * HD + 4 * vq) = s; o += s * q; }
#pragma unroll
    for (int i = 0; i < 4; ++i) o[i] += __shfl_xor(o[i], 32);
    if (lane < 32) *(LAS f32x4*)(part + w * 128 + 4 * vq) = o;
    __syncthreads();
    if (w == 0) {
        float o0 = 0.f, o1 = 0.f;
#pragma unroll
        for (int j = 0; j < 8; ++j) { o0 += part[j * 128 + lane]; o1 += part[j * 128 + 64 + lane]; }
        const float rs = 1.0f / sqrtf(wave_sum(o0 * o0 + o1 * o1) * (1.0f / HD) + RMS_EPS);
        const float* gn = F.in[I_HG] + h * HD; bf16* oa = (bf16*)(F.ws + WS_OAB) + (size_t)(TP + bs) * DM + h * HD;
        const float g0 = bf2f(prow[C_OG + lane]), g1 = bf2f(prow[C_OG + 64 + lane]);
        oa[lane] = f2bf(o0 * rs * gn[lane] * g0 * sigm(g0)); oa[64 + lane] = f2bf(o1 * rs * gn[64 + lane] * g1 * sigm(g1));
    }
    __syncthreads();
}

DI void hgrn_finish_unit(Frame& F, int unit) {
    const int b = unit >> 6, h = (unit >> 3) & 7, sc = unit & 7, lane = F.lane, w = F.wave, r16 = lane & 15, q4 = lane >> 4;
    LAS unsigned char* L = F.lds;
    const bf16* Pb = (const bf16*)(F.ws + WS_PB);
    const float* OL = (const float*)(F.ws + WS_OL);
    const size_t urow0 = (size_t)b * TSEQ + sc * 256;
    f32x4 S[8];
#pragma unroll
    for (int kb = 0; kb < 8; ++kb) S[kb] = (f32x4){0.f, 0.f, 0.f, 0.f};
    const int nprev = sc == 7 ? 8 : sc;
#pragma unroll 1
    for (int j = 0; j < nprev; ++j) {
        if (j == sc) {
#pragma unroll
            for (int kb = 0; kb < 8; ++kb) *(LAS u32x2*)(L + L_ST + (w * 16 + r16) * HQ_STRIDE + (kb * 16 + 4 * q4) * 2) = (u32x2){pk2(S[kb][0], S[kb][1]), pk2(S[kb][2], S[kb][3])};
        }
        const float* USC = (const float*)(F.ws + WS_USC) + (size_t)((unit & ~7) + j) * HD * HD; const float* DSC = (const float*)(F.ws + WS_DSC) + (size_t)((unit & ~7) + j) * HD;
#pragma unroll
        for (int kb = 0; kb < 8; ++kb) { const f32x4 d = *(const f32x4*)(DSC + kb * 16 + 4 * q4);
#pragma unroll
            for (int i = 0; i < 4; ++i) S[kb][i] = S[kb][i] * d[i] + USC[(kb * 16 + 4 * q4 + i) * HD + w * 16 + r16]; }
    }
    if (sc == 7) {
        float* HP = F.out + O_HP + ((size_t)b * NH + h) * HD * HD;
#pragma unroll
        for (int kb = 0; kb < 8; ++kb)
#pragma unroll
            for (int i = 0; i < 4; ++i) HP[(kb * 16 + 4 * q4 + i) * HD + w * 16 + r16] = S[kb][i];
    } else {
#pragma unroll
        for (int kb = 0; kb < 8; ++kb) *(LAS u32x2*)(L + L_ST + (w * 16 + r16) * HQ_STRIDE + (kb * 16 + 4 * q4) * 2) = (u32x2){pk2(S[kb][0], S[kb][1]), pk2(S[kb][2], S[kb][3])};
    }
    __syncthreads();
    const float* gn = F.in[I_HG] + h * HD; bf16* OA = (bf16*)(F.ws + WS_OAB);
#pragma unroll 1
    for (int tbi = 0; tbi < 2; ++tbi) {
        const size_t t0 = urow0 + (2 * w + tbi) * 16;
        bf16x8 qf[4];
#pragma unroll
        for (int ks = 0; ks < 4; ++ks) qf[ks] = *(const bf16x8*)(Pb + (t0 + r16) * NIN + C_Q + h * HD + ks * 32 + 8 * q4);
        f32x4 o[8]; float ssq[4] = {0.f, 0.f, 0.f, 0.f};
        const float* olp = OL + (t0 + 4 * q4) * HW + h * HD + r16;
#pragma unroll
        for (int vb = 0; vb < 8; ++vb) {
            f32x4 a = {0.f, 0.f, 0.f, 0.f};
#pragma unroll
            for (int ks = 0; ks < 4; ++ks) { const bf16x8 sf = *(const LAS bf16x8*)(L + L_ST + (vb * 16 + r16) * HQ_STRIDE + (ks * 32 + 8 * q4) * 2); a = MFMA16(qf[ks], sf, a); }
#pragma unroll
            for (int i = 0; i < 4; ++i) { a[i] += olp[i * HW + vb * 16]; ssq[i] += a[i] * a[i]; }
            o[vb] = a;
            asm volatile("" ::: "memory");
        }
#pragma unroll
        for (int i = 0; i < 4; ++i) { float s = ssq[i]; s += __shfl_xor(s, 1); s += __shfl_xor(s, 2); s += __shfl_xor(s, 4); s += __shfl_xor(s, 8); ssq[i] = 1.0f / sqrtf(s * (1.0f / HD) + RMS_EPS); }
        const bf16* ogp = Pb + (t0 + 4 * q4) * NIN + C_OG + h * HD + r16; bf16* oap = OA + (t0 + 4 * q4) * DM + h * HD + r16;
#pragma unroll
        for (int vb = 0; vb < 8; ++vb) { const float gv = gn[vb * 16 + r16];
#pragma unroll
            for (int i = 0; i < 4; ++i) { const float og = bf2f(ogp[i * NIN + vb * 16]);
                oap[i * DM + vb * 16] = f2bf(o[vb][i] * ssq[i] * gv * og * sigm(og)); }
            asm volatile("" ::: "memory"); }
    }
    __syncthreads();
}


DI f32x4 smm_core(const bf16* ap, const bf16* bp, int klen) {
    f32x4 c0 = {0.f, 0.f, 0.f, 0.f}, c1 = c0, c2 = c0, c3 = c0;
#pragma unroll 2
    for (int k = 0; k < klen; k += 128) {
        const bf16x8 a0 = *(const bf16x8*)(ap + k), a1 = *(const bf16x8*)(ap + k + 32), a2 = *(const bf16x8*)(ap + k + 64), a3 = *(const bf16x8*)(ap + k + 96);
        const bf16x8 b0 = *(const bf16x8*)(bp + k), b1 = *(const bf16x8*)(bp + k + 32), b2 = *(const bf16x8*)(bp + k + 64), b3 = *(const bf16x8*)(bp + k + 96);
        c0 = MFMA16(a0, b0, c0); c1 = MFMA16(a1, b1, c1); c2 = MFMA16(a2, b2, c2); c3 = MFMA16(a3, b3, c3);
    }
    return (c0 + c1) + (c2 + c3);
}
DI void smm_glu(Frame& F) {
    const int lane = F.lane, w = F.wave, r16 = lane & 15, q4 = lane >> 4, rb = w & 3, kh = w >> 2;
    LAS f32x4* X = (LAS f32x4*)F.lds;
    const bf16* Z = (const bf16*)(F.ws + WS_Z); const bf16* Wt = (const bf16*)(F.ws + WS_WGLU); bf16* OAB = (bf16*)(F.ws + WS_OAB);
    for (int it = F.bid; it < 128; it += F.G) {
        const int cb = it >> 1, rh = it & 1, j0 = cb * 16, row0 = TP + rh * 64 + rb * 16;
        const int wrow = (j0 >> 7) * 256 + (j0 & 127);
        const bf16* ap = Z + (size_t)(row0 + r16) * SW + kh * 512 + 8 * q4;
        const f32x4 av = smm_core(ap, Wt + (size_t)(wrow + r16) * SW + kh * 512 + 8 * q4, 512);
        const f32x4 gv = smm_core(ap, Wt + (size_t)(wrow + 128 + r16) * SW + kh * 512 + 8 * q4, 512);
        if (kh == 1) { X[(rb * 2 + 0) * 64 + lane] = av; X[(rb * 2 + 1) * 64 + lane] = gv; }
        __syncthreads();
        if (kh == 0) { const f32x4 a = av + X[(rb * 2 + 0) * 64 + lane], g = gv + X[(rb * 2 + 1) * 64 + lane];
#pragma unroll
            for (int i = 0; i < 4; ++i) OAB[(size_t)(row0 + 4 * q4 + i) * DM + HW + j0 + r16] = f2bf(a[i] * sigm(g[i])); }
        __syncthreads();
    }
}
DI void smm_merge(Frame& F) {
    const int lane = F.lane, w = F.wave, r16 = lane & 15, q4 = lane >> 4, rb = w & 3, kh = w >> 2;
    LAS f32x4* X = (LAS f32x4*)F.lds;
    const bf16* OAB = (const bf16*)(F.ws + WS_OAB); const bf16* Wt = (const bf16*)(F.ws + WS_WCAT); const bf16* Pb = (const bf16*)(F.ws + WS_PB); bf16* MRG = (bf16*)(F.ws + WS_MRG);
    for (int it = F.bid; it < 256; it += F.G) {
        const int cb = it >> 1, rh = it & 1, c0 = cb * 16, row0 = TP + rh * 64 + rb * 16;
        f32x4 v = smm_core(OAB + (size_t)(row0 + r16) * DM + kh * 1024 + 8 * q4, Wt + (size_t)(c0 + r16) * DM + kh * 1024 + 8 * q4, 1024);
#pragma unroll
        for (int i = 0; i < 4; ++i) v[i] *= sigm(bf2f(Pb[(size_t)(row0 + 4 * q4 + i) * NIN + (kh ? C_GB : C_GA) + c0 + r16]));
        if (kh == 1) X[rb * 64 + lane] = v;
        __syncthreads();
        if (kh == 0) { v += X[rb * 64 + lane];
#pragma unroll
            for (int i = 0; i < 4; ++i) MRG[(size_t)(row0 + 4 * q4 + i) * DM + c0 + r16] = f2bf(v[i]); }
        __syncthreads();
    }
}
template <bool WRITE_BF16> DI void smm_res(Frame& F, const bf16* A, const bf16* Wt, int K, const float* base  , float* out  , bf16* ob  , float* ss  ) {
    const int lane = F.lane, w = F.wave, r16 = lane & 15, q4 = lane >> 4, rb = w & 3, kh = w >> 2;
    LAS f32x4* X = (LAS f32x4*)F.lds;
    const int khl = K >> 1;
    for (int it = F.bid; it < 256; it += F.G) {
        const int cb = it >> 1, rh = it & 1, c0 = cb * 16, row0 = rh * 64 + rb * 16;
        f32x4 v = smm_core(A + (size_t)(TP + row0 + r16) * K + kh * khl + 8 * q4, Wt + (size_t)(c0 + r16) * K + kh * khl + 8 * q4, khl);
        if (kh == 1) X[rb * 64 + lane] = v;
        __syncthreads();
        if (kh == 0) { v += X[rb * 64 + lane];
#pragma unroll
            for (int i = 0; i < 4; ++i) { const size_t o = (size_t)(row0 + 4 * q4 + i) * DM + c0 + r16; const float y = base[o] + v[i]; out[o] = y; if (WRITE_BF16) ob[o] = f2bf(y);
                float s = y * y; s += __shfl_xor(s, 1); s += __shfl_xor(s, 2); s += __shfl_xor(s, 4); s += __shfl_xor(s, 8);
                if (r16 == 0) atomicAdd(ss + row0 + 4 * q4 + i, s); } }
        __syncthreads();
    }
}

DI void final_norm(Frame& F) {
    const int gw = F.bid * NWAVES + F.wave, NGW = F.G * NWAVES;
    const float* ss3 = (const float*)(F.ws + WS_SS3); const f32x4* gf = (const f32x4*)F.in[I_NF] + F.lane;
    for (int m = gw; m < MV; m += NGW) {
        const float r = 1.0f / sqrtf(ss3[m] * (1.0f / DM) + RMS_EPS);
        f32x4* x4 = (f32x4*)(F.out + (size_t)m * DM) + F.lane;
#pragma unroll
        for (int j = 0; j < 8; ++j) x4[64 * j] = x4[64 * j] * r * gf[64 * j];
    }
}

#ifndef N_LAUNCHES
#define N_LAUNCHES 1
#endif
constexpr int NPHASE = 9;
__global__ void __launch_bounds__(NTHR, 2) hybrid_fwd(Args args) {
    extern __shared__ __attribute__((aligned(16))) unsigned char lds_raw[];
    cg::grid_group grid = cg::this_grid();
    Frame F;
    F.lds = (LAS unsigned char*)lds_raw; F.tid = threadIdx.x; F.lane = F.tid & 63; F.wave = __builtin_amdgcn_readfirstlane(F.tid >> 6);
    F.G = gridDim.x; F.bid = blockIdx.x; F.out = args.out; F.ws = args.ws;
#pragma unroll
    for (int i = 0; i < 25; ++i) F.in[i] = args.in[i];
    const int lo = args.ph_lo, hi = args.ph_hi;
#ifndef PHMASK
#define PHMASK 0x1ff
#endif
#define IN(k) (((PHMASK >> (k)) & 1) && lo <= (k) && (k) < hi)
#define SEAM(k) do { if (IN(k) && IN((k) + 1)) grid.sync(); } while (0)
    typedef pg8::bf16_t pb;
    if (IN(0)) { p0_prologue(F); } SEAM(0);
    if (IN(1)) {
        pg8::Gemm g{(const pb*)(F.ws + WS_XB), (const pb*)(F.ws + WS_WIN), MP, NIN, DM, DM}; pg8::StaticOrder S; S.init(MP, NIN, F.G, F.bid);
        pg8::EpiIn E{(pb*)(F.ws + WS_PB), (const float*)(F.ws + WS_RS1), NIN};
        pg8::gemm_phase<pg8::EpiIn, pg8::StaticOrder, true, true>(F.lds, g, S, E);
    } SEAM(1);
    if (IN(2)) {
        for (int u = F.bid; u < NB * SG; u += F.G) s5_prompt_unit(F, u);
        for (int u = F.bid; u < NB * NH * 8; u += F.G) hgrn_local_unit(F, u);
        for (int u = F.bid; u < NSMP * NH; u += F.G) hgrn_sample_unit(F, u);
        { const int gw = F.bid * NWAVES + F.wave, NGW = F.G * NWAVES; for (int u = gw; u < NSMP * SG; u += NGW) s5_sample_wave(F, u >> 6, u & 63); }
        __syncthreads();
    } SEAM(2);
    if (IN(3)) {
#ifndef NO_FIN
        for (int u = F.bid; u < NB * NH * 8; u += F.G) hgrn_finish_unit(F, u);
#endif
#ifndef NO_GLU
        pg8::Gemm g{(const pb*)(F.ws + WS_Z), (const pb*)(F.ws + WS_WGLU), TP, 2 * SW, SW, SW}; pg8::StaticOrder S; S.init(TP, 2 * SW, F.G, F.bid);
        pg8::EpiGlu E{(pb*)(F.ws + WS_OAB) + HW, DM};
        pg8::gemm_phase<pg8::EpiGlu, pg8::StaticOrder, true, true>(F.lds, g, S, E);
#endif
        smm_glu(F);
    } SEAM(3);
    if (IN(4)) {
        pg8::Gemm g{(const pb*)(F.ws + WS_OAB), (const pb*)(F.ws + WS_WCAT), TP, DM, DM, MERGE_MID ? DM / 2 : DM}; pg8::HalvedOrder S; S.init(TP, DM, F.G, F.bid);
        pg8::EpiMerge E{(pb*)(F.ws + WS_MRG), (const pb*)(F.ws + WS_PB), NIN, C_GA, C_GB, DM};
        pg8::gemm_phase<pg8::EpiMerge, pg8::HalvedOrder, true, true>(F.lds, g, S, E);
        smm_merge(F);
    } SEAM(4);
    if (IN(5)) {
        pg8::Gemm g{(const pb*)(F.ws + WS_MRG), (const pb*)(F.ws + WS_WOUT), TP, DM, DM, DM}; pg8::StaticOrder S; S.init(TP, DM, F.G, F.bid);
        pg8::EpiRes<true> E{F.in[I_XP], F.in[I_XS], TP, (float*)(F.ws + WS_X1), (pb*)(F.ws + WS_X1B), (float*)(F.ws + WS_SS2), MV, DM};
        pg8::gemm_phase<pg8::EpiRes<true>, pg8::StaticOrder, true, true>(F.lds, g, S, E);
        smm_res<true>(F, (const bf16*)(F.ws + WS_MRG), (const bf16*)(F.ws + WS_WOUT), DM, F.in[I_XS], (float*)(F.ws + WS_X1) + (size_t)TP * DM, (bf16*)(F.ws + WS_X1B) + (size_t)TP * DM, (float*)(F.ws + WS_SS2) + TP);
    } SEAM(5);
    if (IN(6)) {
        pg8::Gemm g{(const pb*)(F.ws + WS_X1B), (const pb*)(F.ws + WS_WUP), MP, 2 * FF, DM, DM}; pg8::StaticOrder S; S.init(MP, 2 * FF, F.G, F.bid);
        pg8::EpiSwiGlu E{(pb*)(F.ws + WS_ACT), (const float*)(F.ws + WS_SS2), FF};
        pg8::gemm_phase<pg8::EpiSwiGlu, pg8::StaticOrder, true, true>(F.lds, g, S, E);
    } SEAM(6);
    if (IN(7)) {
        pg8::Gemm g{(const pb*)(F.ws + WS_ACT), (const pb*)(F.ws + WS_WDN), TP, DM, FF, FF}; pg8::StaticOrder S; S.init(TP, DM, F.G, F.bid);
        pg8::EpiRes<false> E{(const float*)(F.ws + WS_X1), (const float*)(F.ws + WS_X1), MP, F.out, nullptr, (float*)(F.ws + WS_SS3), MV, DM};
        pg8::gemm_phase<pg8::EpiRes<false>, pg8::StaticOrder, true, true>(F.lds, g, S, E);
        smm_res<false>(F, (const bf16*)(F.ws + WS_ACT), (const bf16*)(F.ws + WS_WDN), FF, (const float*)(F.ws + WS_X1) + (size_t)TP * DM, F.out + (size_t)TP * DM, nullptr, (float*)(F.ws + WS_SS3) + TP);
    } SEAM(7);
    if (IN(8)) final_norm(F);
#undef IN
#undef SEAM
}

extern "C" void kernel_launch(void* const* d_in, const int* in_sizes, int n_in, void* d_out, int out_size, void* d_ws, size_t ws_size, hipStream_t stream) {
    static int grid = 0;
    if (grid == 0) {
        if (n_in != 25 || ws_size < WS_END || (size_t)out_size != O_END) { fprintf(stderr, "kernel_launch: unexpected problem: n_in %d ws %zu (need %zu) out %d (expect %zu)\n", n_in, ws_size, (size_t)WS_END, out_size, (size_t)O_END); grid = -1; return; }
        int dev = 0, cus = 0, per_cu = 0;
        hipGetDevice(&dev); hipDeviceGetAttribute(&cus, hipDeviceAttributeMultiprocessorCount, dev);
        hipFuncSetAttribute((const void*)hybrid_fwd, hipFuncAttributeMaxDynamicSharedMemorySize, LDS_BYTES);
        hipOccupancyMaxActiveBlocksPerMultiprocessor(&per_cu, (const void*)hybrid_fwd, NTHR, LDS_BYTES);
        if (per_cu < 1) { fprintf(stderr, "kernel_launch: occupancy query reports %d blocks per CU\n", per_cu); per_cu = 1; }
        (void)hipGetLastError();
        grid = cus;
    }
    if (grid < 0) return;
    Args a{};
    for (int i = 0; i < 25; ++i) a.in[i] = (const float*)d_in[i];
    a.out = (float*)d_out; a.ws = (unsigned char*)d_ws;
#if N_LAUNCHES == 1
    a.ph_lo = 0; a.ph_hi = NPHASE;
    void* params[] = {&a};
    hipError_t e = hipLaunchCooperativeKernel((const void*)hybrid_fwd, dim3(grid), dim3(NTHR), params, LDS_BYTES, stream);
    if (e != hipSuccess) fprintf(stderr, "cooperative launch failed: %s (grid %d)\n", hipGetErrorString(e), grid);
#else
    for (int p = 0; p < NPHASE; ++p) { a.ph_lo = p; a.ph_hi = p + 1; hipLaunchKernelGGL(hybrid_fwd, dim3(grid), dim3(NTHR), LDS_BYTES, stream, a); }
#endif
}
```

```cpp
#include <hip/hip_runtime.h>
#include <hip/hip_cooperative_groups.h>
#include <cstdio>
#include <cstdint>
namespace cg = cooperative_groups;

#define DI __device__ __forceinline__
#define LAS __attribute__((address_space(3)))
typedef float f32x2 __attribute__((ext_vector_type(2)));
typedef __bf16 bf16x2_t __attribute__((ext_vector_type(2)));
typedef unsigned u32x2 __attribute__((ext_vector_type(2)));

constexpr int DM = 2048, TSEQ = 2048, NB = 4, TP = NB * TSEQ  , NSMP = 128, MV = TP + NSMP  , MP = 8448  ;
constexpr int HW = 1024, NH = 8, HD = 128, SW = 1024, SG = 64, SPC = 16, SN = 64, FF = 5632, NIN = 9216;
constexpr int C_Q = 0, C_F = 1024, C_I = 2048, C_OG = 3072, C_U = 4096, C_GA = 5120, C_GB = 7168;
constexpr float RMS_EPS = 1e-6f;
#ifndef MERGE_MID
#define MERGE_MID true
#endif

constexpr size_t MiB = 1u << 20;
constexpr size_t WS_R1 = 2 * MiB;
constexpr size_t WS_WIN = WS_R1, WS_XB = WS_R1 + 36 * MiB;
constexpr size_t WS_OL = WS_R1, WS_Z = WS_R1 + 32 * MiB;
constexpr size_t WS_X1 = WS_R1;
constexpr size_t WS_R2 = WS_R1 + 69 * MiB;
constexpr size_t WS_PB = WS_R2;
constexpr size_t WS_ACT = WS_R2, WS_X1B = WS_R2 + 91 * MiB;
constexpr size_t WS_R3 = WS_R2 + 148 * MiB + MiB / 2;
constexpr size_t WS_WGLU = WS_R3, WS_WCAT = WS_R3 + 4 * MiB, WS_WOUT = WS_R3 + 12 * MiB, WS_WUP = WS_R3 + 20 * MiB, WS_WDN = WS_R3 + 64 * MiB;
constexpr size_t WS_R4 = WS_R3 + 86 * MiB;
constexpr size_t WS_OAB = WS_R4, WS_MRG = WS_R4 + 33 * MiB;
constexpr size_t WS_USC = WS_MRG, WS_DSC = WS_MRG + 16 * MiB;
constexpr size_t WS_END = WS_R4 + 66 * MiB;
constexpr size_t WS_RS1 = 0, WS_SS2 = 64 * 1024, WS_SS3 = 128 * 1024, WS_LB = 192 * 1024, WS_PARA = 256 * 1024  , WS_PARB = 512 * 1024  , WS_PARC = 768 * 1024  ;

constexpr int LDS_BYTES = 147456;

DI float bflo(unsigned u) { return __uint_as_float(u << 16); }
DI float bfhi(unsigned u) { return __uint_as_float(u & 0xffff0000u); }
DI float bf2f(unsigned short b) { return __uint_as_float((unsigned)b << 16); }
DI unsigned pk2(float lo, float hi) { f32x2 v = {lo, hi}; bf16x2_t b = __builtin_convertvector(v, bf16x2_t); return __builtin_bit_cast(unsigned, b); }
DI unsigned short f2bf(float f) { return (unsigned short)(pk2(f, 0.f) & 0xffffu); }
DI float fexp(float x) { return __expf(x); }
DI float sigm(float x) { return __builtin_amdgcn_rcpf(1.f + __expf(-x)); }
DI float wave_sum(float v) {
#pragma unroll
    for (int o = 1; o < 64; o <<= 1) v += __shfl_xor(v, o);
    return v;
}

namespace pg8 {
#define PG8_LAS __attribute__((address_space(3)))
typedef unsigned short bf16_t;
typedef short bf16x8 __attribute__((ext_vector_type(8)));
typedef float f32x4 __attribute__((ext_vector_type(4)));
typedef unsigned u32x4 __attribute__((ext_vector_type(4)));
constexpr int BM = 256, BK = 64, HALF = 128, HTB = HALF * BK * 2  , STAGE_BYTES = 8 * HTB, NXCD = 8, WGM = 8;

__host__ __device__ __forceinline__ int lds_byte(int r, int c) { const int st = (r >> 4) * 2 + (c >> 5), rr = r & 15, cc = c & 31, ob = rr * 64 + cc * 2; return st * 1024 + (ob ^ (((ob >> 9) & 1) << 5)); }
__host__ __device__ __forceinline__ void stage_rc(int b, int& R, int& C) { const int st = b / 1024, sb = b % 1024, swz = sb ^ (((sb >> 9) & 1) << 5); R = (st >> 1) * 16 + swz / 64; C = (st & 1) * 32 + (swz % 64) / 2; }
__host__ __device__ __forceinline__ int perm32(int rho) { const int n = rho >> 4, i = rho & 15; return 8 * (i >> 2) + 4 * n + (i & 3); }

struct Unit { int pm, pn, kh; };
struct Gemm { const bf16_t* A; const bf16_t* Bt; int M, N, K, KL; };

struct StaticOrder {
    int nM, nN, nwg, G, c;
    __host__ __device__ void init(int M, int N, int G_, int c_) { nM = M / BM; nN = N / BM; nwg = nM * nN; G = G_; c = c_; }
    __host__ __device__ bool next(int i, Unit& u) const {
        const long L = (long)i * G + c; if (L >= nwg) return false;
        int wgid = (int)L; { const int q = nwg / NXCD, r = nwg % NXCD, xcd = wgid % NXCD, off = wgid / NXCD; wgid = (xcd < r ? xcd * (q + 1) : r * (q + 1) + (xcd - r) * q) + off; }
        const int nig = WGM * nN, gid = wgid / nig, fm = gid * WGM, gsz = (nM - fm) < WGM ? (nM - fm) : WGM;
        u.pm = fm + ((wgid % nig) % gsz); u.pn = (wgid % nig) / gsz; u.kh = 0; return true;
    }
    __device__ __forceinline__ void a_ready(const Unit&) const {}
    __device__ __forceinline__ void done(const Unit&) const {}
};

struct HalvedOrder {
    StaticOrder so;
    __host__ __device__ void init(int M, int N, int G_, int c_) { so.init(M, N, G_, c_); }
    __host__ __device__ bool next(int i, Unit& u) const { if (!so.next(i >> 1, u)) return false; u.kh = i & 1; return true; }
    __device__ __forceinline__ void a_ready(const Unit&) const {}
    __device__ __forceinline__ void done(const Unit&) const {}
};
__device__ __forceinline__ u32x4 pack8(f32x4 v0, f32x4 v1) { u32x4 w; w.x = ::pk2(v0[0], v0[1]); w.y = ::pk2(v0[2], v0[3]); w.z = ::pk2(v1[0], v1[1]); w.w = ::pk2(v1[2], v1[3]); return w; }
__device__ __forceinline__ void unpack8(u32x4 w, f32x4& v0, f32x4& v1) { v0 = (f32x4){::bflo(w.x), ::bfhi(w.x), ::bflo(w.y), ::bfhi(w.y)}; v1 = (f32x4){::bflo(w.z), ::bfhi(w.z), ::bflo(w.w), ::bfhi(w.w)}; }
__device__ __forceinline__ f32x4 sig4(f32x4 x) { return (f32x4){::sigm(x[0]), ::sigm(x[1]), ::sigm(x[2]), ::sigm(x[3])}; }

struct EpiIn {
    static constexpr bool PERM = true, AFTER_DRAIN = false, HAS_MID = false;
    bf16_t* O; const float* rs; int ldc;
    __device__ __forceinline__ void operator()(const f32x4 (&acc)[2][2][4][2], const Unit& u, int wr, int wc, int fr, int fq) const {
        const int row0 = u.pm * BM + wr * 64 + fr, col0 = u.pn * BM + wc * 32 + 8 * fq;
#pragma unroll
        for (int ai = 0; ai < 2; ++ai)
#pragma unroll
            for (int m = 0; m < 4; ++m) { const int row = row0 + ai * HALF + m * 16; const float s = rs[row]; bf16_t* rowp = O + (size_t)row * ldc + col0;
#pragma unroll
                for (int bj = 0; bj < 2; ++bj) *(u32x4*)(rowp + bj * HALF) = pack8(acc[ai][bj][m][0] * s, acc[ai][bj][m][1] * s); }
    }
};
struct EpiGlu {
    static constexpr bool PERM = true, AFTER_DRAIN = false, HAS_MID = false;
    bf16_t* O; int ldc;
    __device__ __forceinline__ void operator()(const f32x4 (&acc)[2][2][4][2], const Unit& u, int wr, int wc, int fr, int fq) const {
        const int row0 = u.pm * BM + wr * 64 + fr, col0 = u.pn * HALF + wc * 32 + 8 * fq;
#pragma unroll
        for (int ai = 0; ai < 2; ++ai)
#pragma unroll
            for (int m = 0; m < 4; ++m) { const int row = row0 + ai * HALF + m * 16;
                *(u32x4*)(O + (size_t)row * ldc + col0) = pack8(acc[ai][0][m][0] * sig4(acc[ai][1][m][0]), acc[ai][0][m][1] * sig4(acc[ai][1][m][1])); }
    }
};
struct EpiMerge {
    static constexpr bool PERM = true, AFTER_DRAIN = false, HAS_MID = MERGE_MID;
    bf16_t* O; const bf16_t* P; int ldp; int cga, cgb; int ldc;
    __device__ __forceinline__ void mid(f32x4 (&acc)[2][2][4][2], const Unit& u, int wr, int wc, int fr, int fq) const {
        const int row0 = u.pm * BM + wr * 64 + fr, col0 = u.pn * BM + wc * 32 + 8 * fq;
#pragma unroll
        for (int ai = 0; ai < 2; ++ai)
#pragma unroll
            for (int m = 0; m < 4; ++m) { const int row = row0 + ai * HALF + m * 16; const bf16_t* pr = P + (size_t)row * ldp + col0;
#pragma unroll
                for (int bj = 0; bj < 2; ++bj) { f32x4 a0, a1, b0, b1; unpack8(*(const u32x4*)(pr + cga + bj * HALF), a0, a1); unpack8(*(const u32x4*)(pr + cgb + bj * HALF), b0, b1);
#pragma unroll
                    for (int i = 0; i < 4; ++i) { acc[ai][bj][m][0][i] *= (1.f + __expf(-b0[i])) * __builtin_amdgcn_rcpf(1.f + __expf(-a0[i])); acc[ai][bj][m][1][i] *= (1.f + __expf(-b1[i])) * __builtin_amdgcn_rcpf(1.f + __expf(-a1[i])); } }
                asm volatile("" ::: "memory"); }
    }
    __device__ __forceinline__ void operator()(const f32x4 (&acc)[2][2][4][2], const Unit& u, int wr, int wc, int fr, int fq) const {
        const int row0 = u.pm * BM + wr * 64 + fr, col0 = u.pn * BM + wc * 32 + 8 * fq;
#pragma unroll
        for (int ai = 0; ai < 2; ++ai)
#pragma unroll
            for (int m = 0; m < 4; ++m) { const int row = row0 + ai * HALF + m * 16; const bf16_t* pr = P + (size_t)row * ldp + col0 + cgb; bf16_t* rowp = O + (size_t)row * ldc + col0;
#pragma unroll
                for (int bj = 0; bj < 2; ++bj) { f32x4 b0, b1; unpack8(*(const u32x4*)(pr + bj * HALF), b0, b1);
                    *(u32x4*)(rowp + bj * HALF) = pack8(acc[ai][bj][m][0] * sig4(b0), acc[ai][bj][m][1] * sig4(b1)); }
                asm volatile("" ::: "memory"); }
    }
};
template <bool WRITE_BF16> struct EpiRes {
    static constexpr bool PERM = true, AFTER_DRAIN = false, HAS_MID = false;
    const float* base0; const float* base1; int split;
    float* out; bf16_t* ob; float* ss; int nvalid; int ldc;
    __device__ __forceinline__ void operator()(const f32x4 (&acc)[2][2][4][2], const Unit& u, int wr, int wc, int fr, int fq) const {
        const int row0 = u.pm * BM + wr * 64 + fr, col0 = u.pn * BM + wc * 32 + 8 * fq;
#pragma unroll
        for (int ai = 0; ai < 2; ++ai)
#pragma unroll
            for (int m = 0; m < 4; ++m) { const int row = row0 + ai * HALF + m * 16;
                if (row < nvalid) {
                    const float* bp = (row < split ? base0 + (size_t)row * ldc : base1 + (size_t)(row - split) * ldc) + col0; float* op = out + (size_t)row * ldc + col0; float s = 0.f;
#pragma unroll
                    for (int bj = 0; bj < 2; ++bj) { const f32x4 x0 = *(const f32x4*)(bp + bj * HALF), x1 = *(const f32x4*)(bp + bj * HALF + 4);
                        const f32x4 y0 = x0 + acc[ai][bj][m][0], y1 = x1 + acc[ai][bj][m][1];
                        *(f32x4*)(op + bj * HALF) = y0; *(f32x4*)(op + bj * HALF + 4) = y1;
                        if (WRITE_BF16) *(u32x4*)(ob + (size_t)row * ldc + col0 + bj * HALF) = pack8(y0, y1);
                        s += (y0[0] * y0[0] + y0[1] * y0[1]) + (y0[2] * y0[2] + y0[3] * y0[3]) + (y1[0] * y1[0] + y1[1] * y1[1]) + (y1[2] * y1[2] + y1[3] * y1[3]); }
                    s += __shfl_xor(s, 16); s += __shfl_xor(s, 32);
                    if (fq == 0) atomicAdd(ss + row, s);
                } }
    }
};
struct EpiSwiGlu {
    static constexpr bool PERM = true, AFTER_DRAIN = false, HAS_MID = false;
    bf16_t* O; const float* ss; int ldc;
    __device__ __forceinline__ void operator()(const f32x4 (&acc)[2][2][4][2], const Unit& u, int wr, int wc, int fr, int fq) const {
        const int row0 = u.pm * BM + wr * 64 + fr, col0 = u.pn * HALF + wc * 32 + 8 * fq;
#pragma unroll
        for (int ai = 0; ai < 2; ++ai)
#pragma unroll
            for (int m = 0; m < 4; ++m) { const int row = row0 + ai * HALF + m * 16; const float r = __builtin_amdgcn_rsqf(ss[row] * (1.0f / 2048.0f) + 1e-6f);
                const f32x4 a0 = acc[ai][0][m][0] * r, a1 = acc[ai][0][m][1] * r, b0 = acc[ai][1][m][0] * r, b1 = acc[ai][1][m][1] * r;
                *(u32x4*)(O + (size_t)row * ldc + col0) = pack8(a0 * sig4(a0) * b0, a1 * sig4(a1) * b1); }
    }
};
template <class Epi, class Sched, bool ALIGN_EPI = false, bool SP2 = false>
__device__ __forceinline__ void gemm_phase(PG8_LAS unsigned char* lds, const Gemm g, const Sched& S, const Epi& E) {
    const int tid = threadIdx.x, wid = __builtin_amdgcn_readfirstlane(tid >> 6), lane = tid & 63, wr = wid >> 2, wc = wid & 3, fr = lane & 15, fq = lane >> 4;
    const int K = g.K, nt = g.KL / BK; const size_t khb = (size_t)g.KL * 2;
    unsigned voffA[2], voffB[2];
#pragma unroll
    for (int i = 0; i < 2; ++i) { int R, C; stage_rc(tid * 16 + i * 8192, R, C); const int Rb = Epi::PERM ? ((R & ~31) + perm32(R & 31)) : R;
        voffA[i] = (unsigned)(R * K + C) * 2u; voffB[i] = (unsigned)(Rb * K + C) * 2u; }
    const size_t kstep = (size_t)(BK * 2);
    const size_t hstep = (size_t)HALF * K * 2;
    const size_t tstep = 2 * hstep;
    const unsigned ldsw = (unsigned)wid * 1024u;
    const int aoff = lds_byte(wr * 64 + fr, fq * 8), boff = lds_byte(wc * 32 + fr, fq * 8);
#define PG8_SA(b, h) (((b) * 2 + (h)) * HTB)
#define PG8_SB(b, h) ((4 + (b) * 2 + (h)) * HTB)
#define PG8_STAGE(bufoff, gbase, voff) do { _Pragma("unroll") for (int _i = 0; _i < 2; ++_i) \
        __builtin_amdgcn_global_load_lds((const unsigned*)((const char*)(gbase) + (voff)[_i]), (PG8_LAS unsigned*)(lds + (bufoff) + ldsw + _i * 8192), 16, 0, 0); } while (0)
#define PG8_LDA(dst, b, h) do { _Pragma("unroll") for (int m = 0; m < 4; ++m) _Pragma("unroll") for (int k = 0; k < 2; ++k) dst[m][k] = *(const PG8_LAS bf16x8*)(lds + PG8_SA(b, h) + aoff + m * 2048 + k * 1024); } while (0)
#define PG8_LDB(dst, b, h) do { _Pragma("unroll") for (int n = 0; n < 2; ++n) _Pragma("unroll") for (int k = 0; k < 2; ++k) dst[n][k] = *(const PG8_LAS bf16x8*)(lds + PG8_SB(b, h) + boff + n * 2048 + k * 1024); } while (0)
#define PG8_MMA(ai, bj, At, Bt) do { __builtin_amdgcn_s_setprio(1); _Pragma("unroll") for (int m = 0; m < 4; ++m) _Pragma("unroll") for (int n = 0; n < 2; ++n) _Pragma("unroll") for (int k = 0; k < 2; ++k) \
        acc[ai][bj][m][n] = __builtin_amdgcn_mfma_f32_16x16x32_bf16(Bt[n][k], At[m][k], acc[ai][bj][m][n], 0, 0, 0); __builtin_amdgcn_s_setprio(0); } while (0)
#define PG8_WAIT_V(n) asm volatile("s_waitcnt vmcnt(" #n ")" ::: "memory")
#define PG8_WAIT_L(n) asm volatile("s_waitcnt lgkmcnt(" #n ")" ::: "memory")
#define PG8_BAR __builtin_amdgcn_s_barrier()
#define PG8_SCHED __builtin_amdgcn_sched_barrier(0)
    Unit cur, nxt; int ui = 0;
    if (!S.next(0, cur)) return;
    f32x4 acc[2][2][4][2];
#pragma unroll
    for (int a = 0; a < 2; ++a)
#pragma unroll
        for (int b = 0; b < 2; ++b)
#pragma unroll
            for (int m = 0; m < 4; ++m)
#pragma unroll
                for (int n = 0; n < 2; ++n) acc[a][b][m][n] = (f32x4){0.f, 0.f, 0.f, 0.f};
    bf16x8 At[4][2], B0[2][2], B1[2][2];
    const char* cA = (const char*)g.A + (size_t)cur.pm * tstep + cur.kh * khb; const char* cB = (const char*)g.Bt + (size_t)cur.pn * tstep + cur.kh * khb;
    S.a_ready(cur);
    if constexpr (SP2) {
        PG8_STAGE(PG8_SB(0, 0), cB, voffB); PG8_STAGE(PG8_SB(0, 1), cB + hstep, voffB); PG8_STAGE(PG8_SA(0, 0), cA, voffA); PG8_STAGE(PG8_SA(0, 1), cA + hstep, voffA);
        if (wr == 1) PG8_BAR;
        PG8_WAIT_V(2); PG8_BAR;
        PG8_STAGE(PG8_SB(1, 0), cB + kstep, voffB); PG8_STAGE(PG8_SA(1, 0), cA + kstep, voffA); PG8_STAGE(PG8_SB(1, 1), cB + hstep + kstep, voffB);
        PG8_WAIT_V(6); PG8_BAR;
    } else {
        PG8_STAGE(PG8_SB(0, 0), cB, voffB); PG8_STAGE(PG8_SA(0, 0), cA, voffA); PG8_STAGE(PG8_SB(0, 1), cB + hstep, voffB); PG8_STAGE(PG8_SA(0, 1), cA + hstep, voffA);
        if (wr == 1) PG8_BAR;
        PG8_WAIT_V(4); PG8_BAR;
        PG8_STAGE(PG8_SB(1, 0), cB + kstep, voffB); PG8_STAGE(PG8_SA(1, 0), cA + kstep, voffA); PG8_STAGE(PG8_SB(1, 1), cB + hstep + kstep, voffB);
        PG8_WAIT_V(6); PG8_BAR;
    }
    for (;;) {
        const bool has_next = S.next(ui + 1, nxt);
        const char* nA = has_next ? (const char*)g.A + (size_t)nxt.pm * tstep + nxt.kh * khb : cA; const char* nB = has_next ? (const char*)g.Bt + (size_t)nxt.pn * tstep + nxt.kh * khb : cB;
        for (int t = 0; t < nt; t += 2) {
            const bool last = (t == nt - 2);
            const char* a1 = cA + (size_t)(t + 1) * kstep;
            const char* a2 = last ? nA : cA + (size_t)(t + 2) * kstep; const char* b2 = last ? nB : cB + (size_t)(t + 2) * kstep;
            const char* a3 = a2 + kstep; const char* b3 = b2 + kstep;
            if (last && has_next) S.a_ready(nxt);
            if constexpr (SP2) {
            PG8_LDB(B0, 0, 0); PG8_LDB(B1, 0, 1); PG8_SCHED; PG8_LDA(At, 0, 0); PG8_STAGE(PG8_SA(1, 1), a1 + hstep, voffA);
            PG8_WAIT_V(8); PG8_WAIT_L(0); PG8_BAR; PG8_MMA(0, 0, At, B0); PG8_MMA(0, 1, At, B1); PG8_BAR; PG8_SCHED;
            PG8_LDA(At, 0, 1); PG8_STAGE(PG8_SB(0, 0), b2, voffB); PG8_STAGE(PG8_SB(0, 1), b2 + hstep, voffB); PG8_STAGE(PG8_SA(0, 0), a2, voffA);
            PG8_WAIT_V(8); PG8_WAIT_L(0); PG8_BAR; PG8_MMA(1, 0, At, B0); PG8_MMA(1, 1, At, B1); PG8_BAR; PG8_SCHED;
            PG8_LDB(B0, 1, 0); PG8_LDB(B1, 1, 1); PG8_SCHED; PG8_LDA(At, 1, 0); PG8_STAGE(PG8_SA(0, 1), a2 + hstep, voffA);
            PG8_WAIT_V(8); PG8_WAIT_L(0); PG8_BAR; PG8_MMA(0, 0, At, B0); PG8_MMA(0, 1, At, B1); PG8_BAR; PG8_SCHED;
            PG8_LDA(At, 1, 1); PG8_STAGE(PG8_SB(1, 0), b3, voffB); PG8_STAGE(PG8_SB(1, 1), b3 + hstep, voffB); PG8_STAGE(PG8_SA(1, 0), a3, voffA);
            PG8_WAIT_V(8); PG8_WAIT_L(0); PG8_BAR; PG8_MMA(1, 0, At, B0); PG8_MMA(1, 1, At, B1); PG8_BAR; PG8_SCHED;
            } else {
            PG8_LDB(B0, 0, 0); PG8_SCHED; PG8_LDA(At, 0, 0); PG8_STAGE(PG8_SA(1, 1), a1 + hstep, voffA);
            PG8_WAIT_L(8); PG8_BAR; PG8_WAIT_L(0); PG8_MMA(0, 0, At, B0); PG8_BAR; PG8_SCHED;
            PG8_LDB(B1, 0, 1); PG8_STAGE(PG8_SB(0, 0), b2, voffB);
            PG8_BAR; PG8_WAIT_L(0); PG8_MMA(0, 1, At, B1); PG8_BAR;
            PG8_LDA(At, 0, 1); PG8_STAGE(PG8_SA(0, 0), a2, voffA);
            PG8_BAR; PG8_WAIT_L(0); PG8_MMA(1, 0, At, B0); PG8_BAR; PG8_SCHED;
            PG8_STAGE(PG8_SB(0, 1), b2 + hstep, voffB);
            PG8_WAIT_V(6); PG8_BAR; PG8_MMA(1, 1, At, B1); PG8_BAR;
            PG8_LDB(B0, 1, 0); PG8_SCHED; PG8_LDA(At, 1, 0); PG8_STAGE(PG8_SA(0, 1), a2 + hstep, voffA);
            PG8_WAIT_L(8); PG8_BAR; PG8_WAIT_L(0); PG8_MMA(0, 0, At, B0); PG8_BAR; PG8_SCHED;
            PG8_LDB(B1, 1, 1); PG8_STAGE(PG8_SB(1, 0), b3, voffB);
            PG8_BAR; PG8_WAIT_L(0); PG8_MMA(0, 1, At, B1); PG8_BAR;
            PG8_LDA(At, 1, 1); PG8_STAGE(PG8_SA(1, 0), a3, voffA);
            PG8_BAR; PG8_WAIT_L(0); PG8_MMA(1, 0, At, B0); PG8_BAR; PG8_SCHED;
            PG8_STAGE(PG8_SB(1, 1), b3 + hstep, voffB);
            PG8_WAIT_V(6); PG8_BAR; PG8_MMA(1, 1, At, B1); PG8_BAR;
            }
        }
        if constexpr (ALIGN_EPI) { if (wr == 0) PG8_BAR; }
        bool keep = false;
        if constexpr (Epi::HAS_MID) { if (cur.kh == 0) { E.mid(acc, cur, wr, wc, fr, fq); keep = true; } }
        if (!keep) { if constexpr (!Epi::AFTER_DRAIN) { E(acc, cur, wr, wc, fr, fq); S.done(cur); } }
        if (!has_next) break;
        if (!keep) {
#pragma unroll
        for (int a = 0; a < 2; ++a)
#pragma unroll
            for (int b = 0; b < 2; ++b)
#pragma unroll
                for (int m = 0; m < 4; ++m)
#pragma unroll
                    for (int n = 0; n < 2; ++n) acc[a][b][m][n] = (f32x4){0.f, 0.f, 0.f, 0.f};
        }
        cur = nxt; cA = nA; cB = nB; ++ui;
        if constexpr (ALIGN_EPI) { if (wr == 1) PG8_BAR; }
    }
    PG8_WAIT_V(0);
    if constexpr (!ALIGN_EPI) { if (wr == 0) PG8_BAR; }
    PG8_BAR;
    if constexpr (Epi::AFTER_DRAIN) { E.fused(acc, cur, wr, wc, fr, fq, lds, wid, lane); S.done(cur); }
#undef PG8_SA
#undef PG8_SB
#undef PG8_STAGE
#undef PG8_LDA
#undef PG8_LDB
#undef PG8_MMA
#undef PG8_WAIT_V
#undef PG8_WAIT_L
#undef PG8_BAR
#undef PG8_SCHED
}
}

typedef unsigned short bf16;
typedef unsigned v4u __attribute__((ext_vector_type(4)));
typedef float f32x4 __attribute__((ext_vector_type(4)));
typedef short bf16x8 __attribute__((ext_vector_type(8)));
constexpr int NWAVES = 8, NTHR = 512;
#define MFMA16(a, b, c) __builtin_amdgcn_mfma_f32_16x16x32_bf16((a), (b), (c), 0, 0, 0)
#define LDS_FENCE() asm volatile("s_waitcnt lgkmcnt(0)" ::: "memory")

struct Args {
    const float* in[25]; float* out; unsigned char* ws; int ph_lo, ph_hi;
};
struct Frame {
    LAS unsigned char* lds; int tid, lane, wave, G, bid;
    const float* in[25]; float* out; unsigned char* ws;
};
constexpr size_t O_YP = 0, O_YS = (size_t)TP * DM, O_HP = O_YS + (size_t)NSMP * DM, O_S5RP = O_HP + (size_t)NB * NH * HD * HD, O_S5IP = O_S5RP + NB * SG * SN,
                 O_HS = O_S5IP + NB * SG * SN, O_S5RS = O_HS + (size_t)NSMP * NH * HD * HD, O_S5IS = O_S5RS + (size_t)NSMP * SG * SN, O_END = O_S5IS + (size_t)NSMP * SG * SN;
enum { I_XP = 0, I_XS, I_SH, I_SRE, I_SIM, I_LB, I_N1, I_WIN, I_HG, I_LRE, I_LIM, I_LDT, I_BRE, I_BIM, I_CRE, I_CIM, I_D, I_WGLU, I_WPA, I_WPB, I_WOUT, I_N2, I_WUP, I_WDN, I_NF };

DI void p0_transpose_item(const float* W, int K, int N, bf16* WT, int ldk, int koff, int glu_half, const float* gk, LAS float* scr, int item, int lane) {
    const int nblk = N / 32, kb = item / nblk, nb = item % nblk, k0 = 64 * kb, n0 = 32 * nb;
    int d0 = n0;
    if (glu_half) { const int hf = n0 >= glu_half ? 1 : 0, nn = n0 - hf * glu_half; d0 = (nn / 128) * 256 + hf * 128 + (nn % 128); }
    f32x4 v[8];
#pragma unroll
    for (int i = 0; i < 8; ++i) v[i] = *(const f32x4*)(W + (size_t)(k0 + i * 8 + (lane >> 3)) * N + n0 + 4 * (lane & 7));
#pragma unroll
    for (int i = 0; i < 8; ++i) { const int kk = i * 8 + (lane >> 3); const float gs = gk ? gk[k0 + kk] : 1.0f; LAS float* d = scr + kk * 33 + 4 * (lane & 7);
        d[0] = v[i].x * gs; d[1] = v[i].y * gs; d[2] = v[i].z * gs; d[3] = v[i].w * gs; }
    LDS_FENCE();
    const int c = lane & 7;
#pragma unroll
    for (int j = 0; j < 4; ++j) { const int n = (lane >> 3) + 8 * j; const LAS float* s = scr + (8 * c) * 33 + n;
        v4u o; o.x = pk2(s[0 * 33], s[1 * 33]); o.y = pk2(s[2 * 33], s[3 * 33]); o.z = pk2(s[4 * 33], s[5 * 33]); o.w = pk2(s[6 * 33], s[7 * 33]);
        *(v4u*)(WT + (size_t)(d0 + n) * ldk + koff + k0 + 8 * c) = o; }
    LDS_FENCE();
}
DI double exp_d(double x) {
    const double k = __builtin_rint(x * 1.4426950408889634); const double r = (x - k * 0.693147180369123816490e+00) - k * 1.90821492927058770002e-10;
    double p = 1.0 / 6227020800.0;
    p = p * r + 1.0 / 479001600.0; p = p * r + 1.0 / 39916800.0; p = p * r + 1.0 / 3628800.0; p = p * r + 1.0 / 362880.0; p = p * r + 1.0 / 40320.0; p = p * r + 1.0 / 5040.0;
    p = p * r + 1.0 / 720.0; p = p * r + 1.0 / 120.0; p = p * r + 1.0 / 24.0; p = p * r + 1.0 / 6.0; p = p * r + 0.5; p = p * r + 1.0; p = p * r + 1.0;
    const long long ki = (long long)k; const double sc = __builtin_bit_cast(double, (unsigned long long)(1023 + ki) << 52);
    return p * sc;
}
DI void sincos_d(double x, double& s, double& c) {
    const double k = __builtin_rint(x * 0.15915494309189535); double r = (x - k * 6.28318530717958623200e+00) - k * 2.44929359829470635445e-16;
    const double q = r * 0.25, q2 = q * q;
    double sp = -1.0 / 1307674368000.0; sp = sp * q2 + 1.0 / 6227020800.0; sp = sp * q2 - 1.0 / 39916800.0; sp = sp * q2 + 1.0 / 362880.0; sp = sp * q2 - 1.0 / 5040.0; sp = sp * q2 + 1.0 / 120.0; sp = sp * q2 - 1.0 / 6.0; sp = sp * q2 + 1.0;
    double cp = 1.0 / 20922789888000.0; cp = cp * q2 - 1.0 / 87178291200.0; cp = cp * q2 + 1.0 / 479001600.0; cp = cp * q2 - 1.0 / 3628800.0; cp = cp * q2 + 1.0 / 40320.0; cp = cp * q2 - 1.0 / 720.0; cp = cp * q2 + 1.0 / 24.0; cp = cp * q2 - 0.5; cp = cp * q2 + 1.0;
    double s1 = sp * q, c1 = cp;
    double s2 = 2.0 * s1 * c1, c2 = c1 * c1 - s1 * s1;
    s = 2.0 * s2 * c2; c = c2 * c2 - s2 * s2;
}
DI void p0_prologue(Frame& F) {
    LAS float* scr = (LAS float*)(F.lds + F.wave * 16384);
    const int gw = F.bid * NWAVES + F.wave, NGW = F.G * NWAVES;
    bf16* Win_t = (bf16*)(F.ws + WS_WIN); bf16* Wglu_t = (bf16*)(F.ws + WS_WGLU); bf16* Wcat_t = (bf16*)(F.ws + WS_WCAT); bf16* Wout_t = (bf16*)(F.ws + WS_WOUT);
    bf16* Wup_t = (bf16*)(F.ws + WS_WUP); bf16* Wdn_t = (bf16*)(F.ws + WS_WDN);
    constexpr int IT_IN = (DM / 64) * (NIN / 32), IT_GLU = (SW / 64) * (2 * SW / 32), IT_PA = (HW / 64) * (DM / 32), IT_PB = (SW / 64) * (DM / 32), IT_OUT = (DM / 64) * (DM / 32),
                  IT_UP = (DM / 64) * (2 * FF / 32), IT_DN = (FF / 64) * (DM / 32), NITEMS = IT_IN + IT_GLU + IT_PA + IT_PB + IT_OUT + IT_UP + IT_DN;
    for (int it = gw; it < NITEMS; it += NGW) {
        int r = it;
        if (r < IT_UP) { p0_transpose_item(F.in[I_WUP], DM, 2 * FF, Wup_t, DM, 0, FF, F.in[I_N2], scr, r, F.lane); continue; } r -= IT_UP;
        if (r < IT_IN) { p0_transpose_item(F.in[I_WIN], DM, NIN, Win_t, DM, 0, 0, F.in[I_N1], scr, r, F.lane); continue; } r -= IT_IN;
        if (r < IT_DN) { p0_transpose_item(F.in[I_WDN], FF, DM, Wdn_t, FF, 0, 0, nullptr, scr, r, F.lane); continue; } r -= IT_DN;
        if (r < IT_OUT) { p0_transpose_item(F.in[I_WOUT], DM, DM, Wout_t, DM, 0, 0, nullptr, scr, r, F.lane); continue; } r -= IT_OUT;
        if (r < IT_GLU) { p0_transpose_item(F.in[I_WGLU], SW, 2 * SW, Wglu_t, SW, 0, SW, nullptr, scr, r, F.lane); continue; } r -= IT_GLU;
        if (r < IT_PA) { p0_transpose_item(F.in[I_WPA], HW, DM, Wcat_t, 2048, 0, 0, nullptr, scr, r, F.lane); continue; } r -= IT_PA;
        p0_transpose_item(F.in[I_WPB], SW, DM, Wcat_t, 2048, 1024, 0, nullptr, scr, r, F.lane);
    }
    bf16* xb = (bf16*)(F.ws + WS_XB); float* rs1 = (float*)(F.ws + WS_RS1);
    for (int m = gw; m < MP; m += NGW) {
        unsigned long long* o8 = (unsigned long long*)(xb + (size_t)m * DM) + F.lane;
        if (m < MV) {
            const float* xr = m < TP ? F.in[I_XP] + (size_t)m * DM : F.in[I_XS] + (size_t)(m - TP) * DM;
            const f32x4* x4 = (const f32x4*)xr + F.lane; f32x4 v[8]; float s = 0.f;
#pragma unroll
            for (int j = 0; j < 8; ++j) { v[j] = x4[64 * j]; s += (v[j].x * v[j].x + v[j].y * v[j].y) + (v[j].z * v[j].z + v[j].w * v[j].w); }
            s = wave_sum(s);
            if (F.lane == 0) rs1[m] = 1.0f / sqrtf(s * (1.0f / DM) + RMS_EPS);
#pragma unroll
            for (int j = 0; j < 8; ++j) o8[64 * j] = (unsigned long long)pk2(v[j].x, v[j].y) | ((unsigned long long)pk2(v[j].z, v[j].w) << 32);
        } else {
            if (F.lane == 0) rs1[m] = 0.f;
#pragma unroll
            for (int j = 0; j < 8; ++j) o8[64 * j] = 0ull;
        }
    }
    { float* ss2 = (float*)(F.ws + WS_SS2); float* ss3 = (float*)(F.ws + WS_SS3); float* lb = (float*)(F.ws + WS_LB);
      for (int i = F.bid * NTHR + F.tid; i < MP; i += F.G * NTHR) { ss2[i] = 0.f; ss3[i] = 0.f; }
      for (int i = F.bid * NTHR + F.tid; i < HW; i += F.G * NTHR) { const float l0 = F.in[I_LB][i], l1 = F.in[I_LB][HW + i]; lb[i] = 1.0f / (1.0f + expf(l1 - l0)); } }
    for (int g = gw; g < SG; g += NGW) {
        const int n = F.lane;
        const double dt = exp_d((double)F.in[I_LDT][g]);
        const double lr = (double)F.in[I_LRE][g * SN + n], li = (double)F.in[I_LIM][g * SN + n];
        const double mag = exp_d(lr * dt); double sn, cs; sincos_d(li * dt, sn, cs);
        const double are = mag * cs, aim = mag * sn, den = lr * lr + li * li, nr = are - 1.0, ni = aim;
        const double zre = (nr * lr + ni * li) / den, zim = (ni * lr - nr * li) / den;
        double pr = are, pi = aim;
#pragma unroll 1
        for (int i = 0; i < 8; ++i) { const double t = pr * pr - pi * pi; pi = 2.0 * pr * pi; pr = t; }
        float* pa = (float*)(F.ws + WS_PARA) + (size_t)g * 256;
        pa[n] = (float)are; pa[64 + n] = (float)aim; pa[128 + n] = (float)pr; pa[192 + n] = (float)pi;
        bf16* pb = (bf16*)(F.ws + WS_PARB) + (size_t)g * 2048;
        const float* Bre = F.in[I_BRE] + ((size_t)g * SN + n) * SPC; const float* Bim = F.in[I_BIM] + ((size_t)g * SN + n) * SPC;
#pragma unroll
        for (int p = 0; p < SPC; ++p) { const double br = (double)Bre[p], bi = (double)Bim[p];
            pb[n * 16 + p] = f2bf((float)(zre * br - zim * bi)); pb[(64 + n) * 16 + p] = f2bf((float)(zre * bi + zim * br)); }
        bf16* pc = (bf16*)(F.ws + WS_PARC) + (size_t)g * 2048;
#pragma unroll
        for (int p = 0; p < SPC; ++p) { pc[p * 128 + n] = f2bf(F.in[I_CRE][((size_t)g * SPC + p) * SN + n]); pc[p * 128 + 64 + n] = f2bf(-F.in[I_CIM][((size_t)g * SPC + p) * SN + n]); }
    }
}

DI float gelu1(float v) {
    const float av = fabsf(v), t = __builtin_amdgcn_rcpf(av * 0.2316418882f + 1.0f);
    float q = t * 0.5307027145f + (-0.7265760135f); q = q * t + 0.7107068705f; q = q * t + (-0.142248368f); q = q * t + 0.127414796f; q = q * t;
    const float e = __builtin_amdgcn_exp2f((v * v) * (-0.72134752044f));
    const float m = v * (q * e);
    return v < 0.f ? m : v - m;
}

constexpr int S5_BU_STRIDE = 132  , S5_H_STRIDE = 272  , S5_WAVE_BYTES = 16 * S5_BU_STRIDE * 4 + 16 * S5_H_STRIDE  , S5_HE_OFF = 8 * S5_WAVE_BYTES;
DI void s5_prompt_unit(Frame& F, int unit) {
    const int b = unit >> 6, g = unit & 63, lane = F.lane, w = F.wave, r16 = lane & 15, q4 = lane >> 4;
    LAS float* BU = (LAS float*)(F.lds + w * S5_WAVE_BYTES);
    LAS unsigned char* Hb = F.lds + w * S5_WAVE_BYTES + 16 * S5_BU_STRIDE * 4;
    LAS float* HE = (LAS float*)(F.lds + S5_HE_OFF);
    const bf16* Pb = (const bf16*)(F.ws + WS_PB);
    const float* pa = (const float*)(F.ws + WS_PARA) + (size_t)g * 256;
    const float ar = pa[lane], ai = pa[64 + lane], a256r = pa[128 + lane], a256i = pa[192 + lane];
    const bf16* pb = (const bf16*)(F.ws + WS_PARB) + (size_t)g * 2048; const bf16* pc = (const bf16*)(F.ws + WS_PARC) + (size_t)g * 2048;
    bf16x8 Bf[8], Cf[4];
    const bf16x8 zero8 = {0, 0, 0, 0, 0, 0, 0, 0};
#pragma unroll
    for (int nb = 0; nb < 8; ++nb) Bf[nb] = q4 < 2 ? *(const bf16x8*)(pb + (nb * 16 + r16) * 16 + 8 * q4) : zero8;
#pragma unroll
    for (int ks = 0; ks < 4; ++ks) Cf[ks] = *(const bf16x8*)(pc + r16 * 128 + ks * 32 + 8 * q4);
    const float dsk = F.in[I_D][g * 16 + r16];
    const size_t row0 = (size_t)b * TSEQ + w * 256;
    const bf16* ucol = Pb + C_U + g * 16;
    float hr = 0.f, hi = 0.f;
#pragma unroll 1
    for (int pass = 0; pass < 2; ++pass) {
        if (pass == 1) {
            HE[w * 128 + lane] = hr; HE[w * 128 + 64 + lane] = hi;
            __syncthreads();
            float cr = 0.f, ci = 0.f;
            for (int j = 0; j < w; ++j) { const float er = HE[j * 128 + lane], ei = HE[j * 128 + 64 + lane]; const float t = a256r * cr - a256i * ci + er; ci = a256r * ci + a256i * cr + ei; cr = t; }
            if (w == 7) { const float fr_ = a256r * cr - a256i * ci + hr, fi_ = a256r * ci + a256i * cr + hi;
                F.out[O_S5RP + ((size_t)b * SG + g) * SN + lane] = fr_; F.out[O_S5IP + ((size_t)b * SG + g) * SN + lane] = fi_; }
            hr = cr; hi = ci;
        }
#pragma unroll 1
        for (int tile = 0; tile < 16; ++tile) {
            const size_t trow = row0 + tile * 16;
            const bf16x8 uf = q4 < 2 ? *(const bf16x8*)(ucol + (trow + r16) * NIN + 8 * q4) : zero8;
#pragma unroll
            for (int nb = 0; nb < 8; ++nb) { f32x4 a = {0.f, 0.f, 0.f, 0.f}; a = MFMA16(uf, Bf[nb], a);
#pragma unroll
                for (int i = 0; i < 4; ++i) BU[(4 * q4 + i) * S5_BU_STRIDE + nb * 16 + r16] = a[i]; }
            LDS_FENCE();
            if (pass == 0) {
#pragma unroll
                for (int tt = 0; tt < 16; ++tt) { const float br = BU[tt * S5_BU_STRIDE + lane], bi = BU[tt * S5_BU_STRIDE + 64 + lane];
                    const float t = ar * hr - ai * hi + br; hi = ar * hi + ai * hr + bi; hr = t; }
                LDS_FENCE();
            } else {
#pragma unroll
                for (int tt = 0; tt < 16; ++tt) { const float br = BU[tt * S5_BU_STRIDE + lane], bi = BU[tt * S5_BU_STRIDE + 64 + lane];
                    const float t = ar * hr - ai * hi + br; hi = ar * hi + ai * hr + bi; hr = t;
                    *(LAS unsigned short*)(Hb + tt * S5_H_STRIDE + lane * 2) = f2bf(hr); *(LAS unsigned short*)(Hb + tt * S5_H_STRIDE + 128 + lane * 2) = f2bf(hi); }
                LDS_FENCE();
                f32x4 y = {0.f, 0.f, 0.f, 0.f};
#pragma unroll
                for (int ks = 0; ks < 4; ++ks) { const bf16x8 hf = *(const LAS bf16x8*)(Hb + r16 * S5_H_STRIDE + (ks * 32 + 8 * q4) * 2); y = MFMA16(hf, Cf[ks], y); }
                bf16* Z = (bf16*)(F.ws + WS_Z);
#pragma unroll
                for (int i = 0; i < 4; ++i) { const size_t rr = trow + 4 * q4 + i; const float uv = bf2f(ucol[rr * NIN + r16]);
                    Z[rr * SW + g * 16 + r16] = f2bf(gelu1(y[i] + dsk * uv)); }
                LDS_FENCE();
            }
        }
    }
    __syncthreads();
}
DI void s5_sample_wave(Frame& F, int bs, int g) {
    const int lane = F.lane, r16 = lane & 15, q4 = lane >> 4;
    LAS float* hv = (LAS float*)(F.lds + F.wave * 512);
    const float* pa = (const float*)(F.ws + WS_PARA) + (size_t)g * 256; const float ar = pa[lane], ai = pa[64 + lane];
    const bf16* pb = (const bf16*)(F.ws + WS_PARB) + (size_t)g * 2048;
    const bf16* urow = (const bf16*)(F.ws + WS_PB) + (size_t)(TP + bs) * NIN + C_U + g * 16;
    const v4u u0 = *(const v4u*)urow, u1 = *(const v4u*)(urow + 8);
    const v4u bre0 = *(const v4u*)(pb + lane * 16), bre1 = *(const v4u*)(pb + lane * 16 + 8), bim0 = *(const v4u*)(pb + (64 + lane) * 16), bim1 = *(const v4u*)(pb + (64 + lane) * 16 + 8);
    float br = 0.f, bi = 0.f;
#define S5ACC(uw, rw, iw) { br += bflo(uw) * bflo(rw) + bfhi(uw) * bfhi(rw); bi += bflo(uw) * bflo(iw) + bfhi(uw) * bfhi(iw); }
    S5ACC(u0.x, bre0.x, bim0.x) S5ACC(u0.y, bre0.y, bim0.y) S5ACC(u0.z, bre0.z, bim0.z) S5ACC(u0.w, bre0.w, bim0.w)
    S5ACC(u1.x, bre1.x, bim1.x) S5ACC(u1.y, bre1.y, bim1.y) S5ACC(u1.z, bre1.z, bim1.z) S5ACC(u1.w, bre1.w, bim1.w)
#undef S5ACC
    const size_t so = ((size_t)bs * SG + g) * SN + lane;
    const float h0r = F.in[I_SRE][so], h0i = F.in[I_SIM][so];
    const float hr = ar * h0r - ai * h0i + br, hi = ar * h0i + ai * h0r + bi;
    F.out[O_S5RS + so] = hr; F.out[O_S5IS + so] = hi;
    hv[lane] = hr; hv[64 + lane] = hi;
    LDS_FENCE();
    const float* cre = F.in[I_CRE] + ((size_t)g * SPC + r16) * SN + 16 * q4; const float* cim = F.in[I_CIM] + ((size_t)g * SPC + r16) * SN + 16 * q4;
    float y = 0.f;
#pragma unroll
    for (int j = 0; j < 16; ++j) y += cre[j] * hv[16 * q4 + j] - cim[j] * hv[64 + 16 * q4 + j];
    y += __shfl_xor(y, 16); y += __shfl_xor(y, 32);
    const float uv = bf2f(urow[r16]);
    if (q4 == 0) ((bf16*)(F.ws + WS_Z))[(size_t)(TP + bs) * SW + g * 16 + r16] = f2bf(gelu1(y + F.in[I_D][g * 16 + r16] * uv));
    LDS_FENCE();
}

constexpr int HQ_STRIDE = 272, HK_STRIDE = 80;
constexpr int L_QT = 0, L_KT = 8704, L_QIN = 17408, L_KU = 26112, L_VT = 36352, L_ST = 46592, L_SC = 81408, L_PT = 83968, L_G16 = 88064, L_DEC = 88576, L_HG_END = 89088;
template <bool dry> DI void hgrn_local_unit(Frame& F, int unit) {
    const int b = unit >> 6, h = (unit >> 3) & 7, sc = unit & 7, lane = F.lane, w = F.wave, r16 = lane & 15, q4 = lane >> 4;
    LAS unsigned char* L = F.lds;
    bf16* Pb = (bf16*)(F.ws + WS_PB);
    float* OL = (float*)(F.ws + WS_OL);
    const float* lbp = (const float*)(F.ws + WS_LB) + h * HD + 2 * lane;
    const float lb0 = lbp[0], lb1 = lbp[1];
    const size_t urow0 = (size_t)b * TSEQ + sc * 256;
    f32x4 S[8];
#pragma unroll
    for (int kb = 0; kb < 8; ++kb) S[kb] = (f32x4){0.f, 0.f, 0.f, 0.f};
#pragma unroll
    for (int kb = 0; kb < 8; ++kb) *(LAS u32x2*)(L + L_ST + (w * 16 + r16) * HQ_STRIDE + (kb * 16 + 4 * q4) * 2) = (u32x2){0u, 0u};
    float Bp0 = 0.f, Bp1 = 0.f;
    unsigned qn[4], fn[4], vn[4];
#pragma unroll
    for (int j = 0; j < 4; ++j) { const bf16* rp = Pb + (urow0 + 4 * w + j) * NIN + h * HD + 2 * lane; qn[j] = *(const unsigned*)(rp + C_Q); fn[j] = *(const unsigned*)(rp + C_F); vn[j] = *(const unsigned*)(rp + C_I); }
#pragma unroll 1
    for (int c = 0; c < 8; ++c) {
        const size_t t0 = urow0 + c * 32;
        unsigned qc[4], fc[4], vc[4];
#pragma unroll
        for (int j = 0; j < 4; ++j) { qc[j] = qn[j]; fc[j] = fn[j]; vc[j] = vn[j]; }
        if (c < 7) {
#pragma unroll
            for (int j = 0; j < 4; ++j) { const bf16* rp = Pb + (t0 + 32 + 4 * w + j) * NIN + h * HD + 2 * lane; qn[j] = *(const unsigned*)(rp + C_Q); fn[j] = *(const unsigned*)(rp + C_F); vn[j] = *(const unsigned*)(rp + C_I); }
        }
        float kk0[4], kk1[4], cu0[4], cu1[4]; float g16a = 0.f, g16b = 0.f;
        { float c0 = 0.f, c1 = 0.f;
#pragma unroll
          for (int j = 0; j < 4; ++j) { const float f0 = lb0 + (1.f - lb0) * sigm(bflo(fc[j])), f1 = lb1 + (1.f - lb1) * sigm(bfhi(fc[j]));
              const float g0 = __logf(f0), g1 = __logf(f1); kk0[j] = 1.f - f0; kk1[j] = 1.f - f1; c0 += g0; c1 += g1; cu0[j] = c0; cu1[j] = c1; if (j == 0) { g16a = g0; g16b = g1; } } }
        *(LAS f32x2*)(L + L_PT + (w * 128 + 2 * lane) * 4) = (f32x2){cu0[3], cu1[3]};
        if (w == 4) *(LAS f32x2*)(L + L_G16 + 2 * lane * 4) = (f32x2){g16a, g16b};
        __syncthreads();
        float pre0 = 0.f, pre1 = 0.f, tot0 = 0.f, tot1 = 0.f, mid0 = 0.f, mid1 = 0.f;
#pragma unroll
        for (int j = 0; j < 8; ++j) { const f32x2 p = *(const LAS f32x2*)(L + L_PT + (j * 128 + 2 * lane) * 4); tot0 += p.x; tot1 += p.y; if (j < w) { pre0 += p.x; pre1 += p.y; } if (j < 4) { mid0 += p.x; mid1 += p.y; } }
        { const f32x2 p = *(const LAS f32x2*)(L + L_G16 + 2 * lane * 4); mid0 += p.x; mid1 += p.y; }
        unsigned ku0[2], ku1[2], vt0[2], vt1[2];
        { float kuA[4], kuB[4];
#pragma unroll
          for (int j = 0; j < 4; ++j) {
              const float b0 = pre0 + cu0[j], b1 = pre1 + cu1[j]; const float q0 = bflo(qc[j]), q1 = bfhi(qc[j]);
              const int trow = 4 * w + j;
              *(LAS unsigned*)(L + L_QT + trow * HQ_STRIDE + lane * 4) = pk2(q0 * fexp(b0 - mid0), q1 * fexp(b1 - mid1));
              *(LAS unsigned*)(L + L_KT + trow * HQ_STRIDE + lane * 4) = pk2(kk0[j] * fexp(mid0 - b0), kk1[j] * fexp(mid1 - b1));
              *(LAS unsigned*)(L + L_QIN + trow * HQ_STRIDE + lane * 4) = pk2(q0 * fexp(b0), q1 * fexp(b1));
              kuA[j] = kk0[j] * fexp(tot0 - b0); kuB[j] = kk1[j] * fexp(tot1 - b1);
              if (!dry) *(unsigned*)(Pb + (t0 + trow) * NIN + C_Q + h * HD + 2 * lane) = pk2(q0 * fexp(Bp0 + b0), q1 * fexp(Bp1 + b1));
          }
          ku0[0] = pk2(kuA[0], kuA[1]); ku0[1] = pk2(kuA[2], kuA[3]); ku1[0] = pk2(kuB[0], kuB[1]); ku1[1] = pk2(kuB[2], kuB[3]); }
        vt0[0] = (vc[0] & 0xffffu) | (vc[1] << 16); vt0[1] = (vc[2] & 0xffffu) | (vc[3] << 16);
        vt1[0] = (vc[0] >> 16) | (vc[1] & 0xffff0000u); vt1[1] = (vc[2] >> 16) | (vc[3] & 0xffff0000u);
        *(LAS u32x2*)(L + L_KU + (2 * lane) * HK_STRIDE + 8 * w) = (u32x2){ku0[0], ku0[1]};
        *(LAS u32x2*)(L + L_KU + (2 * lane + 1) * HK_STRIDE + 8 * w) = (u32x2){ku1[0], ku1[1]};
        *(LAS u32x2*)(L + L_VT + (2 * lane) * HK_STRIDE + 8 * w) = (u32x2){vt0[0], vt0[1]};
        *(LAS u32x2*)(L + L_VT + (2 * lane + 1) * HK_STRIDE + 8 * w) = (u32x2){vt1[0], vt1[1]};
        if (w == 0) *(LAS f32x2*)(L + L_DEC + 2 * lane * 4) = (f32x2){fexp(tot0), fexp(tot1)};
        Bp0 += tot0; Bp1 += tot1;
        __syncthreads();
        if (w < 3) {
            const int tb = w == 0 ? 0 : 1, sb = w == 2 ? 1 : 0;
            f32x4 a = {0.f, 0.f, 0.f, 0.f};
#pragma unroll
            for (int ks = 0; ks < 4; ++ks) { const bf16x8 af = *(const LAS bf16x8*)(L + L_QT + (tb * 16 + r16) * HQ_STRIDE + (ks * 32 + 8 * q4) * 2), bf = *(const LAS bf16x8*)(L + L_KT + (sb * 16 + r16) * HQ_STRIDE + (ks * 32 + 8 * q4) * 2); a = MFMA16(af, bf, a); }
#pragma unroll
            for (int i = 0; i < 4; ++i) { const int t = tb * 16 + 4 * q4 + i, s = sb * 16 + r16; *(LAS unsigned short*)(L + L_SC + t * HK_STRIDE + s * 2) = s <= t ? f2bf(a[i]) : (unsigned short)0; }
        } else if (w == 3) {
#pragma unroll
            for (int i = 0; i < 4; ++i) *(LAS unsigned short*)(L + L_SC + (4 * q4 + i) * HK_STRIDE + (16 + r16) * 2) = (unsigned short)0;
        }
        __syncthreads();
        const bf16x8 vtf = *(const LAS bf16x8*)(L + L_VT + (w * 16 + r16) * HK_STRIDE + 16 * q4);
        bf16x8 stf[4];
#pragma unroll
        for (int ks = 0; ks < 4; ++ks) stf[ks] = *(const LAS bf16x8*)(L + L_ST + (w * 16 + r16) * HQ_STRIDE + (ks * 32 + 8 * q4) * 2);
#pragma unroll
        for (int tb = 0; tb < 2; ++tb) {
            f32x4 o = {0.f, 0.f, 0.f, 0.f};
            { const bf16x8 sf = *(const LAS bf16x8*)(L + L_SC + (tb * 16 + r16) * HK_STRIDE + 16 * q4); o = MFMA16(sf, vtf, o); }
#pragma unroll
            for (int ks = 0; ks < 4; ++ks) { const bf16x8 qf = *(const LAS bf16x8*)(L + L_QIN + (tb * 16 + r16) * HQ_STRIDE + (ks * 32 + 8 * q4) * 2); o = MFMA16(qf, stf[ks], o); }
#pragma unroll
            for (int i = 0; i < 4; ++i) OL[(t0 + tb * 16 + 4 * q4 + i) * HW + h * HD + w * 16 + r16] = o[i];
        }
#pragma unroll
        for (int kb = 0; kb < 8; ++kb) {
            const f32x4 d = *(const LAS f32x4*)(L + L_DEC + (kb * 16 + 4 * q4) * 4);
            const bf16x8 kf = *(const LAS bf16x8*)(L + L_KU + (kb * 16 + r16) * HK_STRIDE + 16 * q4);
            S[kb] = MFMA16(kf, vtf, S[kb] * d);
            *(LAS u32x2*)(L + L_ST + (w * 16 + r16) * HQ_STRIDE + (kb * 16 + 4 * q4) * 2) = (u32x2){pk2(S[kb][0], S[kb][1]), pk2(S[kb][2], S[kb][3])};
        }
    }
    float* USC = (float*)(F.ws + WS_USC) + (size_t)unit * HD * HD; float* DSC = (float*)(F.ws + WS_DSC) + (size_t)unit * HD;
#pragma unroll
    for (int kb = 0; kb < 8; ++kb)
#pragma unroll
        for (int i = 0; i < 4; ++i) USC[(kb * 16 + 4 * q4 + i) * HD + w * 16 + r16] = S[kb][i];
    if (w == 0) { DSC[2 * lane] = fexp(Bp0); DSC[2 * lane + 1] = fexp(Bp1); }
    __syncthreads();
}

DI void hgrn_sample_unit(Frame& F, int unit) {
    const int bs = unit >> 3, h = unit & 7, tid = F.tid, lane = F.lane, w = F.wave;
    LAS float* part = (LAS float*)F.lds;
    const bf16* prow = (const bf16*)(F.ws + WS_PB) + (size_t)(TP + bs) * NIN + h * HD;
    const float* lb = (const float*)(F.ws + WS_LB) + h * HD;
    const int vq = tid & 31, kr = tid >> 5;
    const float* S0 = F.in[I_SH] + ((size_t)bs * NH + h) * HD * HD; float* S1 = F.out + O_HS + ((size_t)bs * NH + h) * HD * HD;
    f32x4 iv; { const u32x2 t = *(const u32x2*)(prow + C_I + 4 * vq); iv = (f32x4){bflo(t.x), bfhi(t.x), bflo(t.y), bfhi(t.y)}; }
    f32x4 o = {0.f, 0.f, 0.f, 0.f};
#pragma unroll
    for (int j = 0; j < 8; ++j) { const int k = kr + 16 * j;
        const float l = lb[k], f = l + (1.f - l) * sigm(bf2f(prow[C_F + k])), q = bf2f(prow[C_Q + k]);
        const f32x4 s = *(const f32x4*)(S0 + (size_t)k * HD + 4 * vq) * f + iv * (1.f - f);
        *(f32x4*)(S1 + (size_t)k * HD + 4 * vq) = s; o += s * q; }
#pragma unroll
    for (int i = 0; i < 4; ++i) o[i] += __shfl_xor(o[i], 32);
    if (lane < 32) *(LAS f32x4*)(part + w * 128 + 4 * vq) = o;
    __syncthreads();
    if (w == 0) {
        float o0 = 0.f, o1 = 0.f;
#pragma unroll
        for (int j = 0; j < 8; ++j) { o0 += part[j * 128 + lane]; o1 += part[j * 128 + 64 + lane]; }
        const float rs = 1.0f / sqrtf(wave_sum(o0 * o0 + o1 * o1) * (1.0f / HD) + RMS_EPS);
        const float* gn = F.in[I_HG] + h * HD; bf16* oa = (bf16*)(F.ws + WS_OAB) + (size_t)(TP + bs) * DM + h * HD;
        const float g0 = bf2f(prow[C_OG + lane]), g1 = bf2f(prow[C_OG + 64 + lane]);
        oa[lane] = f2bf(o0 * rs * gn[lane] * g0 * sigm(g0)); oa[64 + lane] = f2bf(o1 * rs * gn[64 + lane] * g1 * sigm(g1));
    }
    __syncthreads();
}

DI void hgrn_finish_unit(Frame& F, int unit) {
    const int b = unit >> 6, h = (unit >> 3) & 7, sc = unit & 7, lane = F.lane, w = F.wave, r16 = lane & 15, q4 = lane >> 4;
    LAS unsigned char* L = F.lds;
    const bf16* Pb = (const bf16*)(F.ws + WS_PB);
    const float* OL = (const float*)(F.ws + WS_OL);
    const size_t urow0 = (size_t)b * TSEQ + sc * 256;
    f32x4 S[8];
#pragma unroll
    for (int kb = 0; kb < 8; ++kb) S[kb] = (f32x4){0.f, 0.f, 0.f, 0.f};
    const int nprev = sc == 7 ? 8 : sc;
#pragma unroll 1
    for (int j = 0; j < nprev; ++j) {
        if (j == sc) {
#pragma unroll
            for (int kb = 0; kb < 8; ++kb) *(LAS u32x2*)(L + L_ST + (w * 16 + r16) * HQ_STRIDE + (kb * 16 + 4 * q4) * 2) = (u32x2){pk2(S[kb][0], S[kb][1]), pk2(S[kb][2], S[kb][3])};
        }
        const float* USC = (const float*)(F.ws + WS_USC) + (size_t)((unit & ~7) + j) * HD * HD; const float* DSC = (const float*)(F.ws + WS_DSC) + (size_t)((unit & ~7) + j) * HD;
#pragma unroll
        for (int kb = 0; kb < 8; ++kb) { const f32x4 d = *(const f32x4*)(DSC + kb * 16 + 4 * q4);
#pragma unroll
            for (int i = 0; i < 4; ++i) S[kb][i] = S[kb][i] * d[i] + USC[(kb * 16 + 4 * q4 + i) * HD + w * 16 + r16]; }
    }
    if (sc == 7) {
        float* HP = F.out + O_HP + ((size_t)b * NH + h) * HD * HD;
#pragma unroll
        for (int kb = 0; kb < 8; ++kb)
#pragma unroll
            for (int i = 0; i < 4; ++i) HP[(kb * 16 + 4 * q4 + i) * HD + w * 16 + r16] = S[kb][i];
    } else {
#pragma unroll
        for (int kb = 0; kb < 8; ++kb) *(LAS u32x2*)(L + L_ST + (w * 16 + r16) * HQ_STRIDE + (kb * 16 + 4 * q4) * 2) = (u32x2){pk2(S[kb][0], S[kb][1]), pk2(S[kb][2], S[kb][3])};
    }
    __syncthreads();
    const float* gn = F.in[I_HG] + h * HD; bf16* OA = (bf16*)(F.ws + WS_OAB);
#pragma unroll 1
    for (int tbi = 0; tbi < 2; ++tbi) {
        const size_t t0 = urow0 + (2 * w + tbi) * 16;
        bf16x8 qf[4];
#pragma unroll
        for (int ks = 0; ks < 4; ++ks) qf[ks] = *(const bf16x8*)(Pb + (t0 + r16) * NIN + C_Q + h * HD + ks * 32 + 8 * q4);
        f32x4 o[8]; float ssq[4] = {0.f, 0.f, 0.f, 0.f};
        const float* olp = OL + (t0 + 4 * q4) * HW + h * HD + r16;
#pragma unroll
        for (int vb = 0; vb < 8; ++vb) {
            f32x4 a = {0.f, 0.f, 0.f, 0.f};
#pragma unroll
            for (int ks = 0; ks < 4; ++ks) { const bf16x8 sf = *(const LAS bf16x8*)(L + L_ST + (vb * 16 + r16) * HQ_STRIDE + (ks * 32 + 8 * q4) * 2); a = MFMA16(qf[ks], sf, a); }
#pragma unroll
            for (int i = 0; i < 4; ++i) { a[i] += olp[i * HW + vb * 16]; ssq[i] += a[i] * a[i]; }
            o[vb] = a;
            asm volatile("" ::: "memory");
        }
#pragma unroll
        for (int i = 0; i < 4; ++i) { float s = ssq[i]; s += __shfl_xor(s, 1); s += __shfl_xor(s, 2); s += __shfl_xor(s, 4); s += __shfl_xor(s, 8); ssq[i] = 1.0f / sqrtf(s * (1.0f / HD) + RMS_EPS); }
        const bf16* ogp = Pb + (t0 + 4 * q4) * NIN + C_OG + h * HD + r16; bf16* oap = OA + (t0 + 4 * q4) * DM + h * HD + r16;
#pragma unroll
        for (int vb = 0; vb < 8; ++vb) { const float gv = gn[vb * 16 + r16];
#pragma unroll
            for (int i = 0; i < 4; ++i) { const float og = bf2f(ogp[i * NIN + vb * 16]);
                oap[i * DM + vb * 16] = f2bf(o[vb][i] * ssq[i] * gv * og * sigm(og)); }
            asm volatile("" ::: "memory"); }
    }
    __syncthreads();
}


DI f32x4 smm_core(const bf16* ap, const bf16* bp, int klen) {
    f32x4 c0 = {0.f, 0.f, 0.f, 0.f}, c1 = c0, c2 = c0, c3 = c0;
#pragma unroll 2
    for (int k = 0; k < klen; k += 128) {
        const bf16x8 a0 = *(const bf16x8*)(ap + k), a1 = *(const bf16x8*)(ap + k + 32), a2 = *(const bf16x8*)(ap + k + 64), a3 = *(const bf16x8*)(ap + k + 96);
        const bf16x8 b0 = *(const bf16x8*)(bp + k), b1 = *(const bf16x8*)(bp + k + 32), b2 = *(const bf16x8*)(bp + k + 64), b3 = *(const bf16x8*)(bp + k + 96);
        c0 = MFMA16(a0, b0, c0); c1 = MFMA16(a1, b1, c1); c2 = MFMA16(a2, b2, c2); c3 = MFMA16(a3, b3, c3);
    }
    return (c0 + c1) + (c2 + c3);
}
DI void smm_glu(Frame& F) {
    const int lane = F.lane, w = F.wave, r16 = lane & 15, q4 = lane >> 4, rb = w & 3, kh = w >> 2;
    LAS f32x4* X = (LAS f32x4*)F.lds;
    const bf16* Z = (const bf16*)(F.ws + WS_Z); const bf16* Wt = (const bf16*)(F.ws + WS_WGLU); bf16* OAB = (bf16*)(F.ws + WS_OAB);
    for (int it = F.bid; it < 128; it += F.G) {
        const int cb = it >> 1, rh = it & 1, j0 = cb * 16, row0 = TP + rh * 64 + rb * 16;
        const int wrow = (j0 >> 7) * 256 + (j0 & 127);
        const bf16* ap = Z + (size_t)(row0 + r16) * SW + kh * 512 + 8 * q4;
        const f32x4 av = smm_core(ap, Wt + (size_t)(wrow + r16) * SW + kh * 512 + 8 * q4, 512);
        const f32x4 gv = smm_core(ap, Wt + (size_t)(wrow + 128 + r16) * SW + kh * 512 + 8 * q4, 512);
        if (kh == 1) { X[(rb * 2 + 0) * 64 + lane] = av; X[(rb * 2 + 1) * 64 + lane] = gv; }
        __syncthreads();
        if (kh == 0) { const f32x4 a = av + X[(rb * 2 + 0) * 64 + lane], g = gv + X[(rb * 2 + 1) * 64 + lane];
#pragma unroll
            for (int i = 0; i < 4; ++i) OAB[(size_t)(row0 + 4 * q4 + i) * DM + HW + j0 + r16] = f2bf(a[i] * sigm(g[i])); }
        __syncthreads();
    }
}
DI void smm_merge(Frame& F) {
    const int lane = F.lane, w = F.wave, r16 = lane & 15, q4 = lane >> 4, rb = w & 3, kh = w >> 2;
    LAS f32x4* X = (LAS f32x4*)F.lds;
    const bf16* OAB = (const bf16*)(F.ws + WS_OAB); const bf16* Wt = (const bf16*)(F.ws + WS_WCAT); const bf16* Pb = (const bf16*)(F.ws + WS_PB); bf16* MRG = (bf16*)(F.ws + WS_MRG);
    for (int it = F.bid; it < 256; it += F.G) {
        const int cb = it >> 1, rh = it & 1, c0 = cb * 16, row0 = TP + rh * 64 + rb * 16;
        f32x4 v = smm_core(OAB + (size_t)(row0 + r16) * DM + kh * 1024 + 8 * q4, Wt + (size_t)(c0 + r16) * DM + kh * 1024 + 8 * q4, 1024);
#pragma unroll
        for (int i = 0; i < 4; ++i) v[i] *= sigm(bf2f(Pb[(size_t)(row0 + 4 * q4 + i) * NIN + (kh ? C_GB : C_GA) + c0 + r16]));
        if (kh == 1) X[rb * 64 + lane] = v;
        __syncthreads();
        if (kh == 0) { v += X[rb * 64 + lane];
#pragma unroll
            for (int i = 0; i < 4; ++i) MRG[(size_t)(row0 + 4 * q4 + i) * DM + c0 + r16] = f2bf(v[i]); }
        __syncthreads();
    }
}
template <bool WRITE_BF16> DI void smm_res(Frame& F, const bf16* A, const bf16* Wt, int K, const float* base  , float* out  , bf16* ob  , float* ss  ) {
    const int lane = F.lane, w = F.wave, r16 = lane & 15, q4 = lane >> 4, rb = w & 3, kh = w >> 2;
    LAS f32x4* X = (LAS f32x4*)F.lds;
    const int khl = K >> 1;
    for (int it = F.bid; it < 256; it += F.G) {
        const int cb = it >> 1, rh = it & 1, c0 = cb * 16, row0 = rh * 64 + rb * 16;
        f32x4 v = smm_core(A + (size_t)(TP + row0 + r16) * K + kh * khl + 8 * q4, Wt + (size_t)(c0 + r16) * K + kh * khl + 8 * q4, khl);
        if (kh == 1) X[rb * 64 + lane] = v;
        __syncthreads();
        if (kh == 0) { v += X[rb * 64 + lane];
#pragma unroll
            for (int i = 0; i < 4; ++i) { const size_t o = (size_t)(row0 + 4 * q4 + i) * DM + c0 + r16; const float y = base[o] + v[i]; out[o] = y; if (WRITE_BF16) ob[o] = f2bf(y);
                float s = y * y; s += __shfl_xor(s, 1); s += __shfl_xor(s, 2); s += __shfl_xor(s, 4); s += __shfl_xor(s, 8);
                if (r16 == 0) atomicAdd(ss + row0 + 4 * q4 + i, s); } }
        __syncthreads();
    }
}

DI void final_norm(Frame& F) {
    const int gw = F.bid * NWAVES + F.wave, NGW = F.G * NWAVES;
    const float* ss3 = (const float*)(F.ws + WS_SS3); const f32x4* gf = (const f32x4*)F.in[I_NF] + F.lane;
    for (int m = gw; m < MV; m += NGW) {
        const float r = 1.0f / sqrtf(ss3[m] * (1.0f / DM) + RMS_EPS);
        f32x4* x4 = (f32x4*)(F.out + (size_t)m * DM) + F.lane;
#pragma unroll
        for (int j = 0; j < 8; ++j) x4[64 * j] = x4[64 * j] * r * gf[64 * j];
    }
}

#ifndef N_LAUNCHES
#define N_LAUNCHES 1
#endif
constexpr int NPHASE = 9;
__global__ void __launch_bounds__(NTHR, 2) hybrid_fwd(Args args) {
    extern __shared__ __attribute__((aligned(16))) unsigned char lds_raw[];
    cg::grid_group grid = cg::this_grid();
    Frame F;
    F.lds = (LAS unsigned char*)lds_raw; F.tid = threadIdx.x; F.lane = F.tid & 63; F.wave = __builtin_amdgcn_readfirstlane(F.tid >> 6);
    F.G = gridDim.x; F.bid = blockIdx.x; F.out = args.out; F.ws = args.ws;
#pragma unroll
    for (int i = 0; i < 25; ++i) F.in[i] = args.in[i];
    const int lo = args.ph_lo, hi = args.ph_hi;
#ifndef REPMASK
#define REPMASK 0
#endif
#ifndef SKIPMASK
#define SKIPMASK 0
#endif
#ifndef PHMASK
#define PHMASK 0x1ff
#endif
#define IN(k) (((PHMASK >> (k)) & 1) && lo <= (k) && (k) < hi)
#define SEAM(k) do { if (IN(k) && IN((k) + 1)) grid.sync(); } while (0)
    typedef pg8::bf16_t pb;
    if (IN(0)) { p0_prologue(F); if ((REPMASK >> 0) & 1) { __syncthreads(); p0_prologue(F); } } SEAM(0);
    if (IN(1)) {
        pg8::Gemm g{(const pb*)(F.ws + WS_XB), (const pb*)(F.ws + WS_WIN), MP, NIN, DM, DM}; pg8::StaticOrder S; S.init(MP, NIN, F.G, F.bid);
        pg8::EpiIn E{(pb*)(F.ws + WS_PB), (const float*)(F.ws + WS_RS1), NIN};
        pg8::gemm_phase<pg8::EpiIn, pg8::StaticOrder, true, true>(F.lds, g, S, E);
#if (REPMASK >> 1) & 1
        pg8::gemm_phase<pg8::EpiIn, pg8::StaticOrder, true, true>(F.lds, g, S, E);
#endif
    } SEAM(1);
    if (IN(2)) {
#define P2_BODY(DRY) do { \
        if (!((SKIPMASK >> 0) & 1)) for (int u = F.bid; u < NB * SG; u += F.G) s5_prompt_unit(F, u); \
        if (!((SKIPMASK >> 1) & 1)) for (int u = F.bid; u < NB * NH * 8; u += F.G) hgrn_local_unit<DRY>(F, u); \
        for (int u = F.bid; u < NSMP * NH; u += F.G) hgrn_sample_unit(F, u); \
        { const int gw = F.bid * NWAVES + F.wave, NGW = F.G * NWAVES; for (int u = gw; u < NSMP * SG; u += NGW) s5_sample_wave(F, u >> 6, u & 63); } \
        __syncthreads(); } while (0)
#if (REPMASK >> 2) & 1
        P2_BODY(true);
#endif
        P2_BODY(false);
    } SEAM(2);
    if (IN(3)) {
#pragma unroll 1
        for (int rep = ((REPMASK >> 9) & 1) ? 0 : 1; rep < 2; ++rep)
        for (int u = F.bid; u < NB * NH * 8; u += F.G) hgrn_finish_unit(F, u);
#ifndef NO_GLU
        pg8::Gemm g{(const pb*)(F.ws + WS_Z), (const pb*)(F.ws + WS_WGLU), TP, 2 * SW, SW, SW}; pg8::StaticOrder S; S.init(TP, 2 * SW, F.G, F.bid);
        pg8::EpiGlu E{(pb*)(F.ws + WS_OAB) + HW, DM};
        pg8::gemm_phase<pg8::EpiGlu, pg8::StaticOrder, true, true>(F.lds, g, S, E);
#endif
        smm_glu(F);
    } SEAM(3);
    if (IN(4)) {
        pg8::Gemm g{(const pb*)(F.ws + WS_OAB), (const pb*)(F.ws + WS_WCAT), TP, DM, DM, MERGE_MID ? DM / 2 : DM}; pg8::HalvedOrder S; S.init(TP, DM, F.G, F.bid);
        pg8::EpiMerge E{(pb*)(F.ws + WS_MRG), (const pb*)(F.ws + WS_PB), NIN, C_GA, C_GB, DM};
        pg8::gemm_phase<pg8::EpiMerge, pg8::HalvedOrder, true, true>(F.lds, g, S, E);
#if (REPMASK >> 4) & 1
        pg8::gemm_phase<pg8::EpiMerge, pg8::HalvedOrder, true, true>(F.lds, g, S, E);
#endif
        smm_merge(F);
    } SEAM(4);
    if (IN(5)) {
        pg8::Gemm g{(const pb*)(F.ws + WS_MRG), (const pb*)(F.ws + WS_WOUT), TP, DM, DM, DM}; pg8::StaticOrder S; S.init(TP, DM, F.G, F.bid);
        pg8::EpiRes<true> E{F.in[I_XP], F.in[I_XS], TP, (float*)(F.ws + WS_X1), (pb*)(F.ws + WS_X1B), (float*)(F.ws + WS_SS2), MV, DM};
        pg8::gemm_phase<pg8::EpiRes<true>, pg8::StaticOrder, true, true>(F.lds, g, S, E);
        smm_res<true>(F, (const bf16*)(F.ws + WS_MRG), (const bf16*)(F.ws + WS_WOUT), DM, F.in[I_XS], (float*)(F.ws + WS_X1) + (size_t)TP * DM, (bf16*)(F.ws + WS_X1B) + (size_t)TP * DM, (float*)(F.ws + WS_SS2) + TP);
    } SEAM(5);
    if (IN(6)) {
        pg8::Gemm g{(const pb*)(F.ws + WS_X1B), (const pb*)(F.ws + WS_WUP), MP, 2 * FF, DM, DM}; pg8::StaticOrder S; S.init(MP, 2 * FF, F.G, F.bid);
        pg8::EpiSwiGlu E{(pb*)(F.ws + WS_ACT), (const float*)(F.ws + WS_SS2), FF};
        pg8::gemm_phase<pg8::EpiSwiGlu, pg8::StaticOrder, true, true>(F.lds, g, S, E);
#if (REPMASK >> 6) & 1
        pg8::gemm_phase<pg8::EpiSwiGlu, pg8::StaticOrder, true, true>(F.lds, g, S, E);
#endif
    } SEAM(6);
    if (IN(7)) {
        pg8::Gemm g{(const pb*)(F.ws + WS_ACT), (const pb*)(F.ws + WS_WDN), TP, DM, FF, FF}; pg8::StaticOrder S; S.init(TP, DM, F.G, F.bid);
        pg8::EpiRes<false> E{(const float*)(F.ws + WS_X1), (const float*)(F.ws + WS_X1), MP, F.out, nullptr, (float*)(F.ws + WS_SS3), MV, DM};
        pg8::gemm_phase<pg8::EpiRes<false>, pg8::StaticOrder, true, true>(F.lds, g, S, E);
        smm_res<false>(F, (const bf16*)(F.ws + WS_ACT), (const bf16*)(F.ws + WS_WDN), FF, (const float*)(F.ws + WS_X1) + (size_t)TP * DM, F.out + (size_t)TP * DM, nullptr, (float*)(F.ws + WS_SS3) + TP);
    } SEAM(7);
    if (IN(8)) final_norm(F);
#undef IN
#undef SEAM
}

extern "C" void kernel_launch(void* const* d_in, const int* in_sizes, int n_in, void* d_out, int out_size, void* d_ws, size_t ws_size, hipStream_t stream) {
    static int grid = 0;
    if (grid == 0) {
        if (n_in != 25 || ws_size < WS_END || (size_t)out_size != O_END) { fprintf(stderr, "kernel_launch: unexpected problem: n_in %d ws %zu (need %zu) out %d (expect %zu)\n", n_in, ws_size, (size_t)WS_END, out_size, (size_t)O_END); grid = -1; return; }
        int dev = 0, cus = 0, per_cu = 0;
        hipGetDevice(&dev); hipDeviceGetAttribute(&cus, hipDeviceAttributeMultiprocessorCount, dev);
        hipFuncSetAttribute((const void*)hybrid_fwd, hipFuncAttributeMaxDynamicSharedMemorySize, LDS_BYTES);
        hipOccupancyMaxActiveBlocksPerMultiprocessor(&per_cu, (const void*)hybrid_fwd, NTHR, LDS_BYTES);
        if (per_cu < 1) { fprintf(stderr, "kernel_launch: occupancy query reports %d blocks per CU\n", per_cu); per_cu = 1; }
        (void)hipGetLastError();
        grid = cus;
    }
    if (grid < 0) return;
    Args a{};
    for (int i = 0; i < 25; ++i) a.in[i] = (const float*)d_in[i];
    a.out = (float*)d_out; a.ws = (unsigned char*)d_ws;
#if N_LAUNCHES == 1
    a.ph_lo = 0; a.ph_hi = NPHASE;
    void* params[] = {&a};
    hipError_t e = hipLaunchCooperativeKernel((const void*)hybrid_fwd, dim3(grid), dim3(NTHR), params, LDS_BYTES, stream);
    if (e != hipSuccess) fprintf(stderr, "cooperative launch failed: %s (grid %d)\n", hipGetErrorString(e), grid);
#else
    for (int p = 0; p < NPHASE; ++p) { a.ph_lo = p; a.ph_hi = p + 1; hipLaunchKernelGGL(hybrid_fwd, dim3(grid), dim3(NTHR), LDS_BYTES, stream, a); }
#endif
}
```

```cpp
#include <hip/hip_runtime.h>
#include <hip/hip_cooperative_groups.h>
#include <cstdio>
#include <cstdint>
namespace cg = cooperative_groups;

#define DI __device__ __forceinline__
#define LAS __attribute__((address_space(3)))
typedef float f32x2 __attribute__((ext_vector_type(2)));
typedef __bf16 bf16x2_t __attribute__((ext_vector_type(2)));
typedef unsigned u32x2 __attribute__((ext_vector_type(2)));

constexpr int DM = 2048, TSEQ = 2048, NB = 4, TP = NB * TSEQ  , NSMP = 128, MV = TP + NSMP  , MP = 8448  ;
constexpr int HW = 1024, NH = 8, HD = 128, SW = 1024, SG = 64, SPC = 16, SN = 64, FF = 5632, NIN = 9216;
constexpr int C_Q = 0, C_F = 1024, C_I = 2048, C_OG = 3072, C_U = 4096, C_GA = 5120, C_GB = 7168;
constexpr float RMS_EPS = 1e-6f;
#ifndef MERGE_MID
#define MERGE_MID true
#endif

constexpr size_t MiB = 1u << 20;
constexpr size_t WS_R1 = 2 * MiB;
constexpr size_t WS_WIN = WS_R1, WS_XB = WS_R1 + 36 * MiB;
constexpr size_t WS_OL = WS_R1, WS_Z = WS_R1 + 32 * MiB;
constexpr size_t WS_X1 = WS_R1;
constexpr size_t WS_R2 = WS_R1 + 69 * MiB;
constexpr size_t WS_PB = WS_R2;
constexpr size_t WS_ACT = WS_R2, WS_X1B = WS_R2 + 91 * MiB;
constexpr size_t WS_R3 = WS_R2 + 148 * MiB + MiB / 2;
constexpr size_t WS_WGLU = WS_R3, WS_WCAT = WS_R3 + 4 * MiB, WS_WOUT = WS_R3 + 12 * MiB, WS_WUP = WS_R3 + 20 * MiB, WS_WDN = WS_R3 + 64 * MiB;
constexpr size_t WS_R4 = WS_R3 + 86 * MiB;
constexpr size_t WS_OAB = WS_R4, WS_MRG = WS_R4 + 33 * MiB;
constexpr size_t WS_USC = WS_MRG, WS_DSC = WS_MRG + 16 * MiB;
constexpr size_t WS_END = WS_R4 + 66 * MiB;
constexpr size_t WS_RS1 = 0, WS_SS2 = 64 * 1024, WS_SS3 = 128 * 1024, WS_LB = 192 * 1024, WS_PARA = 256 * 1024  , WS_PARB = 512 * 1024  , WS_PARC = 768 * 1024  ;

constexpr size_t WS_BAR = 1 * MiB, WS_BAR_BYTES = 16384;
constexpr int LDS_BAR_OFF = 131072 + 64;
constexpr int LDS_BYTES = 147456;

DI float bflo(unsigned u) { return __uint_as_float(u << 16); }
DI float bfhi(unsigned u) { return __uint_as_float(u & 0xffff0000u); }
DI float bf2f(unsigned short b) { return __uint_as_float((unsigned)b << 16); }
DI unsigned pk2(float lo, float hi) { f32x2 v = {lo, hi}; bf16x2_t b = __builtin_convertvector(v, bf16x2_t); return __builtin_bit_cast(unsigned, b); }
DI unsigned short f2bf(float f) { return (unsigned short)(pk2(f, 0.f) & 0xffffu); }
DI float fexp(float x) { return __expf(x); }
DI float sigm(float x) { return __builtin_amdgcn_rcpf(1.f + __expf(-x)); }
DI float wave_sum(float v) {
#pragma unroll
    for (int o = 1; o < 64; o <<= 1) v += __shfl_xor(v, o);
    return v;
}

namespace pg8 {
#define PG8_LAS __attribute__((address_space(3)))
typedef unsigned short bf16_t;
typedef short bf16x8 __attribute__((ext_vector_type(8)));
typedef float f32x4 __attribute__((ext_vector_type(4)));
typedef unsigned u32x4 __attribute__((ext_vector_type(4)));
constexpr int BM = 256, BK = 64, HALF = 128, HTB = HALF * BK * 2  , STAGE_BYTES = 8 * HTB, NXCD = 8, WGM = 8;

__host__ __device__ __forceinline__ int lds_byte(int r, int c) { const int st = (r >> 4) * 2 + (c >> 5), rr = r & 15, cc = c & 31, ob = rr * 64 + cc * 2; return st * 1024 + (ob ^ (((ob >> 9) & 1) << 5)); }
__host__ __device__ __forceinline__ void stage_rc(int b, int& R, int& C) { const int st = b / 1024, sb = b % 1024, swz = sb ^ (((sb >> 9) & 1) << 5); R = (st >> 1) * 16 + swz / 64; C = (st & 1) * 32 + (swz % 64) / 2; }
__host__ __device__ __forceinline__ int perm32(int rho) { const int n = rho >> 4, i = rho & 15; return 8 * (i >> 2) + 4 * n + (i & 3); }

struct Unit { int pm, pn, kh; };
struct Gemm { const bf16_t* A; const bf16_t* Bt; int M, N, K, KL; };

struct StaticOrder {
    int nM, nN, nwg, G, c;
    __host__ __device__ void init(int M, int N, int G_, int c_) { nM = M / BM; nN = N / BM; nwg = nM * nN; G = G_; c = c_; }
    __host__ __device__ bool next(int i, Unit& u) const {
        const long L = (long)i * G + c; if (L >= nwg) return false;
        int wgid = (int)L; { const int q = nwg / NXCD, r = nwg % NXCD, xcd = wgid % NXCD, off = wgid / NXCD; wgid = (xcd < r ? xcd * (q + 1) : r * (q + 1) + (xcd - r) * q) + off; }
        const int nig = WGM * nN, gid = wgid / nig, fm = gid * WGM, gsz = (nM - fm) < WGM ? (nM - fm) : WGM;
        u.pm = fm + ((wgid % nig) % gsz); u.pn = (wgid % nig) / gsz; u.kh = 0; return true;
    }
    __device__ __forceinline__ void a_ready(const Unit&) const {}
    __device__ __forceinline__ void done(const Unit&) const {}
};

struct HalvedOrder {
    StaticOrder so;
    __host__ __device__ void init(int M, int N, int G_, int c_) { so.init(M, N, G_, c_); }
    __host__ __device__ bool next(int i, Unit& u) const { if (!so.next(i >> 1, u)) return false; u.kh = i & 1; return true; }
    __device__ __forceinline__ void a_ready(const Unit&) const {}
    __device__ __forceinline__ void done(const Unit&) const {}
};
__device__ __forceinline__ u32x4 pack8(f32x4 v0, f32x4 v1) { u32x4 w; w.x = ::pk2(v0[0], v0[1]); w.y = ::pk2(v0[2], v0[3]); w.z = ::pk2(v1[0], v1[1]); w.w = ::pk2(v1[2], v1[3]); return w; }
__device__ __forceinline__ void unpack8(u32x4 w, f32x4& v0, f32x4& v1) { v0 = (f32x4){::bflo(w.x), ::bfhi(w.x), ::bflo(w.y), ::bfhi(w.y)}; v1 = (f32x4){::bflo(w.z), ::bfhi(w.z), ::bflo(w.w), ::bfhi(w.w)}; }
__device__ __forceinline__ f32x4 sig4(f32x4 x) { return (f32x4){::sigm(x[0]), ::sigm(x[1]), ::sigm(x[2]), ::sigm(x[3])}; }

struct EpiIn {
    static constexpr bool PERM = true, AFTER_DRAIN = false, HAS_MID = false;
    bf16_t* O; const float* rs; int ldc;
    __device__ __forceinline__ void operator()(const f32x4 (&acc)[2][2][4][2], const Unit& u, int wr, int wc, int fr, int fq) const {
        const int row0 = u.pm * BM + wr * 64 + fr, col0 = u.pn * BM + wc * 32 + 8 * fq;
#pragma unroll
        for (int ai = 0; ai < 2; ++ai)
#pragma unroll
            for (int m = 0; m < 4; ++m) { const int row = row0 + ai * HALF + m * 16; const float s = rs[row]; bf16_t* rowp = O + (size_t)row * ldc + col0;
#pragma unroll
                for (int bj = 0; bj < 2; ++bj) *(u32x4*)(rowp + bj * HALF) = pack8(acc[ai][bj][m][0] * s, acc[ai][bj][m][1] * s); }
    }
};
struct EpiGlu {
    static constexpr bool PERM = true, AFTER_DRAIN = false, HAS_MID = false;
    bf16_t* O; int ldc;
    __device__ __forceinline__ void operator()(const f32x4 (&acc)[2][2][4][2], const Unit& u, int wr, int wc, int fr, int fq) const {
        const int row0 = u.pm * BM + wr * 64 + fr, col0 = u.pn * HALF + wc * 32 + 8 * fq;
#pragma unroll
        for (int ai = 0; ai < 2; ++ai)
#pragma unroll
            for (int m = 0; m < 4; ++m) { const int row = row0 + ai * HALF + m * 16;
                *(u32x4*)(O + (size_t)row * ldc + col0) = pack8(acc[ai][0][m][0] * sig4(acc[ai][1][m][0]), acc[ai][0][m][1] * sig4(acc[ai][1][m][1])); }
    }
};
struct EpiMerge {
    static constexpr bool PERM = true, AFTER_DRAIN = false, HAS_MID = MERGE_MID;
    bf16_t* O; const bf16_t* P; int ldp; int cga, cgb; int ldc;
    __device__ __forceinline__ void mid(f32x4 (&acc)[2][2][4][2], const Unit& u, int wr, int wc, int fr, int fq) const {
        const int row0 = u.pm * BM + wr * 64 + fr, col0 = u.pn * BM + wc * 32 + 8 * fq;
#pragma unroll
        for (int ai = 0; ai < 2; ++ai)
#pragma unroll
            for (int m = 0; m < 4; ++m) { const int row = row0 + ai * HALF + m * 16; const bf16_t* pr = P + (size_t)row * ldp + col0;
#pragma unroll
                for (int bj = 0; bj < 2; ++bj) { f32x4 a0, a1, b0, b1; unpack8(*(const u32x4*)(pr + cga + bj * HALF), a0, a1); unpack8(*(const u32x4*)(pr + cgb + bj * HALF), b0, b1);
#pragma unroll
                    for (int i = 0; i < 4; ++i) { acc[ai][bj][m][0][i] *= (1.f + __expf(-b0[i])) * __builtin_amdgcn_rcpf(1.f + __expf(-a0[i])); acc[ai][bj][m][1][i] *= (1.f + __expf(-b1[i])) * __builtin_amdgcn_rcpf(1.f + __expf(-a1[i])); } }
                asm volatile("" ::: "memory"); }
    }
    __device__ __forceinline__ void operator()(const f32x4 (&acc)[2][2][4][2], const Unit& u, int wr, int wc, int fr, int fq) const {
        const int row0 = u.pm * BM + wr * 64 + fr, col0 = u.pn * BM + wc * 32 + 8 * fq;
#pragma unroll
        for (int ai = 0; ai < 2; ++ai)
#pragma unroll
            for (int m = 0; m < 4; ++m) { const int row = row0 + ai * HALF + m * 16; const bf16_t* pr = P + (size_t)row * ldp + col0 + cgb; bf16_t* rowp = O + (size_t)row * ldc + col0;
#pragma unroll
                for (int bj = 0; bj < 2; ++bj) { f32x4 b0, b1; unpack8(*(const u32x4*)(pr + bj * HALF), b0, b1);
                    *(u32x4*)(rowp + bj * HALF) = pack8(acc[ai][bj][m][0] * sig4(b0), acc[ai][bj][m][1] * sig4(b1)); }
                asm volatile("" ::: "memory"); }
    }
};
template <bool WRITE_BF16> struct EpiRes {
    static constexpr bool PERM = true, AFTER_DRAIN = false, HAS_MID = false;
    const float* base0; const float* base1; int split;
    float* out; bf16_t* ob; float* ss; int nvalid; int ldc;
    __device__ __forceinline__ void operator()(const f32x4 (&acc)[2][2][4][2], const Unit& u, int wr, int wc, int fr, int fq) const {
        const int row0 = u.pm * BM + wr * 64 + fr, col0 = u.pn * BM + wc * 32 + 8 * fq;
#pragma unroll
        for (int ai = 0; ai < 2; ++ai)
#pragma unroll
            for (int m = 0; m < 4; ++m) { const int row = row0 + ai * HALF + m * 16;
                if (row < nvalid) {
                    const float* bp = (row < split ? base0 + (size_t)row * ldc : base1 + (size_t)(row - split) * ldc) + col0; float* op = out + (size_t)row * ldc + col0; float s = 0.f;
#pragma unroll
                    for (int bj = 0; bj < 2; ++bj) { const f32x4 x0 = *(const f32x4*)(bp + bj * HALF), x1 = *(const f32x4*)(bp + bj * HALF + 4);
                        const f32x4 y0 = x0 + acc[ai][bj][m][0], y1 = x1 + acc[ai][bj][m][1];
                        *(f32x4*)(op + bj * HALF) = y0; *(f32x4*)(op + bj * HALF + 4) = y1;
                        if (WRITE_BF16) *(u32x4*)(ob + (size_t)row * ldc + col0 + bj * HALF) = pack8(y0, y1);
                        s += (y0[0] * y0[0] + y0[1] * y0[1]) + (y0[2] * y0[2] + y0[3] * y0[3]) + (y1[0] * y1[0] + y1[1] * y1[1]) + (y1[2] * y1[2] + y1[3] * y1[3]); }
                    s += __shfl_xor(s, 16); s += __shfl_xor(s, 32);
                    if (fq == 0) atomicAdd(ss + row, s);
                } }
    }
};
struct EpiSwiGlu {
    static constexpr bool PERM = true, AFTER_DRAIN = false, HAS_MID = false;
    bf16_t* O; const float* ss; int ldc;
    __device__ __forceinline__ void operator()(const f32x4 (&acc)[2][2][4][2], const Unit& u, int wr, int wc, int fr, int fq) const {
        const int row0 = u.pm * BM + wr * 64 + fr, col0 = u.pn * HALF + wc * 32 + 8 * fq;
#pragma unroll
        for (int ai = 0; ai < 2; ++ai)
#pragma unroll
            for (int m = 0; m < 4; ++m) { const int row = row0 + ai * HALF + m * 16; const float r = __builtin_amdgcn_rsqf(ss[row] * (1.0f / 2048.0f) + 1e-6f);
                const f32x4 a0 = acc[ai][0][m][0] * r, a1 = acc[ai][0][m][1] * r, b0 = acc[ai][1][m][0] * r, b1 = acc[ai][1][m][1] * r;
                *(u32x4*)(O + (size_t)row * ldc + col0) = pack8(a0 * sig4(a0) * b0, a1 * sig4(a1) * b1); }
    }
};
template <class Epi, class Sched, bool ALIGN_EPI = false, bool SP2 = false>
__device__ __forceinline__ void gemm_phase(PG8_LAS unsigned char* lds, const Gemm g, const Sched& S, const Epi& E) {
    const int tid = threadIdx.x, wid = __builtin_amdgcn_readfirstlane(tid >> 6), lane = tid & 63, wr = wid >> 2, wc = wid & 3, fr = lane & 15, fq = lane >> 4;
    const int K = g.K, nt = g.KL / BK; const size_t khb = (size_t)g.KL * 2;
    unsigned voffA[2], voffB[2];
#pragma unroll
    for (int i = 0; i < 2; ++i) { int R, C; stage_rc(tid * 16 + i * 8192, R, C); const int Rb = Epi::PERM ? ((R & ~31) + perm32(R & 31)) : R;
        voffA[i] = (unsigned)(R * K + C) * 2u; voffB[i] = (unsigned)(Rb * K + C) * 2u; }
    const size_t kstep = (size_t)(BK * 2);
    const size_t hstep = (size_t)HALF * K * 2;
    const size_t tstep = 2 * hstep;
    const unsigned ldsw = (unsigned)wid * 1024u;
    const int aoff = lds_byte(wr * 64 + fr, fq * 8), boff = lds_byte(wc * 32 + fr, fq * 8);
#define PG8_SA(b, h) (((b) * 2 + (h)) * HTB)
#define PG8_SB(b, h) ((4 + (b) * 2 + (h)) * HTB)
#define PG8_STAGE(bufoff, gbase, voff) do { _Pragma("unroll") for (int _i = 0; _i < 2; ++_i) \
        __builtin_amdgcn_global_load_lds((const unsigned*)((const char*)(gbase) + (voff)[_i]), (PG8_LAS unsigned*)(lds + (bufoff) + ldsw + _i * 8192), 16, 0, 0); } while (0)
#define PG8_LDA(dst, b, h) do { _Pragma("unroll") for (int m = 0; m < 4; ++m) _Pragma("unroll") for (int k = 0; k < 2; ++k) dst[m][k] = *(const PG8_LAS bf16x8*)(lds + PG8_SA(b, h) + aoff + m * 2048 + k * 1024); } while (0)
#define PG8_LDB(dst, b, h) do { _Pragma("unroll") for (int n = 0; n < 2; ++n) _Pragma("unroll") for (int k = 0; k < 2; ++k) dst[n][k] = *(const PG8_LAS bf16x8*)(lds + PG8_SB(b, h) + boff + n * 2048 + k * 1024); } while (0)
#define PG8_MMA(ai, bj, At, Bt) do { __builtin_amdgcn_s_setprio(1); _Pragma("unroll") for (int m = 0; m < 4; ++m) _Pragma("unroll") for (int n = 0; n < 2; ++n) _Pragma("unroll") for (int k = 0; k < 2; ++k) \
        acc[ai][bj][m][n] = __builtin_amdgcn_mfma_f32_16x16x32_bf16(Bt[n][k], At[m][k], acc[ai][bj][m][n], 0, 0, 0); __builtin_amdgcn_s_setprio(0); } while (0)
#define PG8_WAIT_V(n) asm volatile("s_waitcnt vmcnt(" #n ")" ::: "memory")
#define PG8_WAIT_L(n) asm volatile("s_waitcnt lgkmcnt(" #n ")" ::: "memory")
#define PG8_BAR __builtin_amdgcn_s_barrier()
#define PG8_SCHED __builtin_amdgcn_sched_barrier(0)
    Unit cur, nxt; int ui = 0;
    if (!S.next(0, cur)) return;
    f32x4 acc[2][2][4][2];
#pragma unroll
    for (int a = 0; a < 2; ++a)
#pragma unroll
        for (int b = 0; b < 2; ++b)
#pragma unroll
            for (int m = 0; m < 4; ++m)
#pragma unroll
                for (int n = 0; n < 2; ++n) acc[a][b][m][n] = (f32x4){0.f, 0.f, 0.f, 0.f};
    bf16x8 At[4][2], B0[2][2], B1[2][2];
    const char* cA = (const char*)g.A + (size_t)cur.pm * tstep + cur.kh * khb; const char* cB = (const char*)g.Bt + (size_t)cur.pn * tstep + cur.kh * khb;
    S.a_ready(cur);
    if constexpr (SP2) {
        PG8_STAGE(PG8_SB(0, 0), cB, voffB); PG8_STAGE(PG8_SB(0, 1), cB + hstep, voffB); PG8_STAGE(PG8_SA(0, 0), cA, voffA); PG8_STAGE(PG8_SA(0, 1), cA + hstep, voffA);
        if (wr == 1) PG8_BAR;
        PG8_WAIT_V(2); PG8_BAR;
        PG8_STAGE(PG8_SB(1, 0), cB + kstep, voffB); PG8_STAGE(PG8_SA(1, 0), cA + kstep, voffA); PG8_STAGE(PG8_SB(1, 1), cB + hstep + kstep, voffB);
        PG8_WAIT_V(6); PG8_BAR;
    } else {
        PG8_STAGE(PG8_SB(0, 0), cB, voffB); PG8_STAGE(PG8_SA(0, 0), cA, voffA); PG8_STAGE(PG8_SB(0, 1), cB + hstep, voffB); PG8_STAGE(PG8_SA(0, 1), cA + hstep, voffA);
        if (wr == 1) PG8_BAR;
        PG8_WAIT_V(4); PG8_BAR;
        PG8_STAGE(PG8_SB(1, 0), cB + kstep, voffB); PG8_STAGE(PG8_SA(1, 0), cA + kstep, voffA); PG8_STAGE(PG8_SB(1, 1), cB + hstep + kstep, voffB);
        PG8_WAIT_V(6); PG8_BAR;
    }
    for (;;) {
        const bool has_next = S.next(ui + 1, nxt);
        const char* nA = has_next ? (const char*)g.A + (size_t)nxt.pm * tstep + nxt.kh * khb : cA; const char* nB = has_next ? (const char*)g.Bt + (size_t)nxt.pn * tstep + nxt.kh * khb : cB;
        for (int t = 0; t < nt; t += 2) {
            const bool last = (t == nt - 2);
            const char* a1 = cA + (size_t)(t + 1) * kstep;
            const char* a2 = last ? nA : cA + (size_t)(t + 2) * kstep; const char* b2 = last ? nB : cB + (size_t)(t + 2) * kstep;
            const char* a3 = a2 + kstep; const char* b3 = b2 + kstep;
            if (last && has_next) S.a_ready(nxt);
            if constexpr (SP2) {
            PG8_LDB(B0, 0, 0); PG8_LDB(B1, 0, 1); PG8_SCHED; PG8_LDA(At, 0, 0); PG8_STAGE(PG8_SA(1, 1), a1 + hstep, voffA);
            PG8_WAIT_V(8); PG8_WAIT_L(0); PG8_BAR; PG8_MMA(0, 0, At, B0); PG8_MMA(0, 1, At, B1); PG8_BAR; PG8_SCHED;
            PG8_LDA(At, 0, 1); PG8_STAGE(PG8_SB(0, 0), b2, voffB); PG8_STAGE(PG8_SB(0, 1), b2 + hstep, voffB); PG8_STAGE(PG8_SA(0, 0), a2, voffA);
            PG8_WAIT_V(8); PG8_WAIT_L(0); PG8_BAR; PG8_MMA(1, 0, At, B0); PG8_MMA(1, 1, At, B1); PG8_BAR; PG8_SCHED;
            PG8_LDB(B0, 1, 0); PG8_LDB(B1, 1, 1); PG8_SCHED; PG8_LDA(At, 1, 0); PG8_STAGE(PG8_SA(0, 1), a2 + hstep, voffA);
            PG8_WAIT_V(8); PG8_WAIT_L(0); PG8_BAR; PG8_MMA(0, 0, At, B0); PG8_MMA(0, 1, At, B1); PG8_BAR; PG8_SCHED;
            PG8_LDA(At, 1, 1); PG8_STAGE(PG8_SB(1, 0), b3, voffB); PG8_STAGE(PG8_SB(1, 1), b3 + hstep, voffB); PG8_STAGE(PG8_SA(1, 0), a3, voffA);
            PG8_WAIT_V(8); PG8_WAIT_L(0); PG8_BAR; PG8_MMA(1, 0, At, B0); PG8_MMA(1, 1, At, B1); PG8_BAR; PG8_SCHED;
            } else {
            PG8_LDB(B0, 0, 0); PG8_SCHED; PG8_LDA(At, 0, 0); PG8_STAGE(PG8_SA(1, 1), a1 + hstep, voffA);
            PG8_WAIT_L(8); PG8_BAR; PG8_WAIT_L(0); PG8_MMA(0, 0, At, B0); PG8_BAR; PG8_SCHED;
            PG8_LDB(B1, 0, 1); PG8_STAGE(PG8_SB(0, 0), b2, voffB);
            PG8_BAR; PG8_WAIT_L(0); PG8_MMA(0, 1, At, B1); PG8_BAR;
            PG8_LDA(At, 0, 1); PG8_STAGE(PG8_SA(0, 0), a2, voffA);
            PG8_BAR; PG8_WAIT_L(0); PG8_MMA(1, 0, At, B0); PG8_BAR; PG8_SCHED;
            PG8_STAGE(PG8_SB(0, 1), b2 + hstep, voffB);
            PG8_WAIT_V(6); PG8_BAR; PG8_MMA(1, 1, At, B1); PG8_BAR;
            PG8_LDB(B0, 1, 0); PG8_SCHED; PG8_LDA(At, 1, 0); PG8_STAGE(PG8_SA(0, 1), a2 + hstep, voffA);
            PG8_WAIT_L(8); PG8_BAR; PG8_WAIT_L(0); PG8_MMA(0, 0, At, B0); PG8_BAR; PG8_SCHED;
            PG8_LDB(B1, 1, 1); PG8_STAGE(PG8_SB(1, 0), b3, voffB);
            PG8_BAR; PG8_WAIT_L(0); PG8_MMA(0, 1, At, B1); PG8_BAR;
            PG8_LDA(At, 1, 1); PG8_STAGE(PG8_SA(1, 0), a3, voffA);
            PG8_BAR; PG8_WAIT_L(0); PG8_MMA(1, 0, At, B0); PG8_BAR; PG8_SCHED;
            PG8_STAGE(PG8_SB(1, 1), b3 + hstep, voffB);
            PG8_WAIT_V(6); PG8_BAR; PG8_MMA(1, 1, At, B1); PG8_BAR;
            }
        }
        if constexpr (ALIGN_EPI) { if (wr == 0) PG8_BAR; }
        bool keep = false;
        if constexpr (Epi::HAS_MID) { if (cur.kh == 0) { E.mid(acc, cur, wr, wc, fr, fq); keep = true; } }
        if (!keep) { if constexpr (!Epi::AFTER_DRAIN) { E(acc, cur, wr, wc, fr, fq); S.done(cur); } }
        if (!has_next) break;
        if (!keep) {
#pragma unroll
        for (int a = 0; a < 2; ++a)
#pragma unroll
            for (int b = 0; b < 2; ++b)
#pragma unroll
                for (int m = 0; m < 4; ++m)
#pragma unroll
                    for (int n = 0; n < 2; ++n) acc[a][b][m][n] = (f32x4){0.f, 0.f, 0.f, 0.f};
        }
        cur = nxt; cA = nA; cB = nB; ++ui;
        if constexpr (ALIGN_EPI) { if (wr == 1) PG8_BAR; }
    }
    PG8_WAIT_V(0);
    if constexpr (!ALIGN_EPI) { if (wr == 0) PG8_BAR; }
    PG8_BAR;
    if constexpr (Epi::AFTER_DRAIN) { E.fused(acc, cur, wr, wc, fr, fq, lds, wid, lane); S.done(cur); }
#undef PG8_SA
#undef PG8_SB
#undef PG8_STAGE
#undef PG8_LDA
#undef PG8_LDB
#undef PG8_MMA
#undef PG8_WAIT_V
#undef PG8_WAIT_L
#undef PG8_BAR
#undef PG8_SCHED
}
}

typedef unsigned short bf16;
typedef unsigned v4u __attribute__((ext_vector_type(4)));
typedef float f32x4 __attribute__((ext_vector_type(4)));
typedef short bf16x8 __attribute__((ext_vector_type(8)));
constexpr int NWAVES = 8, NTHR = 512;
#define MFMA16(a, b, c) __builtin_amdgcn_mfma_f32_16x16x32_bf16((a), (b), (c), 0, 0, 0)
#define LDS_FENCE() asm volatile("s_waitcnt lgkmcnt(0)" ::: "memory")

struct Args {
    const float* in[25]; float* out; unsigned char* ws; int ph_lo, ph_hi;
};
struct Frame {
    LAS unsigned char* lds; int tid, lane, wave, G, bid;
    const float* in[25]; float* out; unsigned char* ws;
};
constexpr size_t O_YP = 0, O_YS = (size_t)TP * DM, O_HP = O_YS + (size_t)NSMP * DM, O_S5RP = O_HP + (size_t)NB * NH * HD * HD, O_S5IP = O_S5RP + NB * SG * SN,
                 O_HS = O_S5IP + NB * SG * SN, O_S5RS = O_HS + (size_t)NSMP * NH * HD * HD, O_S5IS = O_S5RS + (size_t)NSMP * SG * SN, O_END = O_S5IS + (size_t)NSMP * SG * SN;
enum { I_XP = 0, I_XS, I_SH, I_SRE, I_SIM, I_LB, I_N1, I_WIN, I_HG, I_LRE, I_LIM, I_LDT, I_BRE, I_BIM, I_CRE, I_CIM, I_D, I_WGLU, I_WPA, I_WPB, I_WOUT, I_N2, I_WUP, I_WDN, I_NF };

DI void p0_transpose_item(const float* W, int K, int N, bf16* WT, int ldk, int koff, int glu_half, const float* gk, LAS float* scr, int item, int lane) {
    const int nblk = N / 32, kb = item / nblk, nb = item % nblk, k0 = 64 * kb, n0 = 32 * nb;
    int d0 = n0;
    if (glu_half) { const int hf = n0 >= glu_half ? 1 : 0, nn = n0 - hf * glu_half; d0 = (nn / 128) * 256 + hf * 128 + (nn % 128); }
    f32x4 v[8];
#pragma unroll
    for (int i = 0; i < 8; ++i) v[i] = *(const f32x4*)(W + (size_t)(k0 + i * 8 + (lane >> 3)) * N + n0 + 4 * (lane & 7));
#pragma unroll
    for (int i = 0; i < 8; ++i) { const int kk = i * 8 + (lane >> 3); const float gs = gk ? gk[k0 + kk] : 1.0f; LAS float* d = scr + kk * 33 + 4 * (lane & 7);
        d[0] = v[i].x * gs; d[1] = v[i].y * gs; d[2] = v[i].z * gs; d[3] = v[i].w * gs; }
    LDS_FENCE();
    const int c = lane & 7;
#pragma unroll
    for (int j = 0; j < 4; ++j) { const int n = (lane >> 3) + 8 * j; const LAS float* s = scr + (8 * c) * 33 + n;
        v4u o; o.x = pk2(s[0 * 33], s[1 * 33]); o.y = pk2(s[2 * 33], s[3 * 33]); o.z = pk2(s[4 * 33], s[5 * 33]); o.w = pk2(s[6 * 33], s[7 * 33]);
        *(v4u*)(WT + (size_t)(d0 + n) * ldk + koff + k0 + 8 * c) = o; }
    LDS_FENCE();
}
DI double exp_d(double x) {
    const double k = __builtin_rint(x * 1.4426950408889634); const double r = (x - k * 0.693147180369123816490e+00) - k * 1.90821492927058770002e-10;
    double p = 1.0 / 6227020800.0;
    p = p * r + 1.0 / 479001600.0; p = p * r + 1.0 / 39916800.0; p = p * r + 1.0 / 3628800.0; p = p * r + 1.0 / 362880.0; p = p * r + 1.0 / 40320.0; p = p * r + 1.0 / 5040.0;
    p = p * r + 1.0 / 720.0; p = p * r + 1.0 / 120.0; p = p * r + 1.0 / 24.0; p = p * r + 1.0 / 6.0; p = p * r + 0.5; p = p * r + 1.0; p = p * r + 1.0;
    const long long ki = (long long)k; const double sc = __builtin_bit_cast(double, (unsigned long long)(1023 + ki) << 52);
    return p * sc;
}
DI void sincos_d(double x, double& s, double& c) {
    const double k = __builtin_rint(x * 0.15915494309189535); double r = (x - k * 6.28318530717958623200e+00) - k * 2.44929359829470635445e-16;
    const double q = r * 0.25, q2 = q * q;
    double sp = -1.0 / 1307674368000.0; sp = sp * q2 + 1.0 / 6227020800.0; sp = sp * q2 - 1.0 / 39916800.0; sp = sp * q2 + 1.0 / 362880.0; sp = sp * q2 - 1.0 / 5040.0; sp = sp * q2 + 1.0 / 120.0; sp = sp * q2 - 1.0 / 6.0; sp = sp * q2 + 1.0;
    double cp = 1.0 / 20922789888000.0; cp = cp * q2 - 1.0 / 87178291200.0; cp = cp * q2 + 1.0 / 479001600.0; cp = cp * q2 - 1.0 / 3628800.0; cp = cp * q2 + 1.0 / 40320.0; cp = cp * q2 - 1.0 / 720.0; cp = cp * q2 + 1.0 / 24.0; cp = cp * q2 - 0.5; cp = cp * q2 + 1.0;
    double s1 = sp * q, c1 = cp;
    double s2 = 2.0 * s1 * c1, c2 = c1 * c1 - s1 * s1;
    s = 2.0 * s2 * c2; c = c2 * c2 - s2 * s2;
}
DI void p0_prologue(Frame& F) {
    LAS float* scr = (LAS float*)(F.lds + F.wave * 16384);
    const int gw = F.bid * NWAVES + F.wave, NGW = F.G * NWAVES;
    bf16* Win_t = (bf16*)(F.ws + WS_WIN); bf16* Wglu_t = (bf16*)(F.ws + WS_WGLU); bf16* Wcat_t = (bf16*)(F.ws + WS_WCAT); bf16* Wout_t = (bf16*)(F.ws + WS_WOUT);
    bf16* Wup_t = (bf16*)(F.ws + WS_WUP); bf16* Wdn_t = (bf16*)(F.ws + WS_WDN);
    constexpr int IT_IN = (DM / 64) * (NIN / 32), IT_GLU = (SW / 64) * (2 * SW / 32), IT_PA = (HW / 64) * (DM / 32), IT_PB = (SW / 64) * (DM / 32), IT_OUT = (DM / 64) * (DM / 32),
                  IT_UP = (DM / 64) * (2 * FF / 32), IT_DN = (FF / 64) * (DM / 32), NITEMS = IT_IN + IT_GLU + IT_PA + IT_PB + IT_OUT + IT_UP + IT_DN;
    for (int it = gw; it < NITEMS; it += NGW) {
        int r = it;
        if (r < IT_UP) { p0_transpose_item(F.in[I_WUP], DM, 2 * FF, Wup_t, DM, 0, FF, F.in[I_N2], scr, r, F.lane); continue; } r -= IT_UP;
        if (r < IT_IN) { p0_transpose_item(F.in[I_WIN], DM, NIN, Win_t, DM, 0, 0, F.in[I_N1], scr, r, F.lane); continue; } r -= IT_IN;
        if (r < IT_DN) { p0_transpose_item(F.in[I_WDN], FF, DM, Wdn_t, FF, 0, 0, nullptr, scr, r, F.lane); continue; } r -= IT_DN;
        if (r < IT_OUT) { p0_transpose_item(F.in[I_WOUT], DM, DM, Wout_t, DM, 0, 0, nullptr, scr, r, F.lane); continue; } r -= IT_OUT;
        if (r < IT_GLU) { p0_transpose_item(F.in[I_WGLU], SW, 2 * SW, Wglu_t, SW, 0, SW, nullptr, scr, r, F.lane); continue; } r -= IT_GLU;
        if (r < IT_PA) { p0_transpose_item(F.in[I_WPA], HW, DM, Wcat_t, 2048, 0, 0, nullptr, scr, r, F.lane); continue; } r -= IT_PA;
        p0_transpose_item(F.in[I_WPB], SW, DM, Wcat_t, 2048, 1024, 0, nullptr, scr, r, F.lane);
    }
    bf16* xb = (bf16*)(F.ws + WS_XB); float* rs1 = (float*)(F.ws + WS_RS1);
    for (int m = gw; m < MP; m += NGW) {
        unsigned long long* o8 = (unsigned long long*)(xb + (size_t)m * DM) + F.lane;
        if (m < MV) {
            const float* xr = m < TP ? F.in[I_XP] + (size_t)m * DM : F.in[I_XS] + (size_t)(m - TP) * DM;
            const f32x4* x4 = (const f32x4*)xr + F.lane; f32x4 v[8]; float s = 0.f;
#pragma unroll
            for (int j = 0; j < 8; ++j) { v[j] = x4[64 * j]; s += (v[j].x * v[j].x + v[j].y * v[j].y) + (v[j].z * v[j].z + v[j].w * v[j].w); }
            s = wave_sum(s);
            if (F.lane == 0) rs1[m] = 1.0f / sqrtf(s * (1.0f / DM) + RMS_EPS);
#pragma unroll
            for (int j = 0; j < 8; ++j) o8[64 * j] = (unsigned long long)pk2(v[j].x, v[j].y) | ((unsigned long long)pk2(v[j].z, v[j].w) << 32);
        } else {
            if (F.lane == 0) rs1[m] = 0.f;
#pragma unroll
            for (int j = 0; j < 8; ++j) o8[64 * j] = 0ull;
        }
    }
    { float* ss2 = (float*)(F.ws + WS_SS2); float* ss3 = (float*)(F.ws + WS_SS3); float* lb = (float*)(F.ws + WS_LB);
      for (int i = F.bid * NTHR + F.tid; i < MP; i += F.G * NTHR) { ss2[i] = 0.f; ss3[i] = 0.f; }
      for (int i = F.bid * NTHR + F.tid; i < HW; i += F.G * NTHR) { const float l0 = F.in[I_LB][i], l1 = F.in[I_LB][HW + i]; lb[i] = 1.0f / (1.0f + expf(l1 - l0)); } }
    for (int g = gw; g < SG; g += NGW) {
        const int n = F.lane;
        const double dt = exp_d((double)F.in[I_LDT][g]);
        const double lr = (double)F.in[I_LRE][g * SN + n], li = (double)F.in[I_LIM][g * SN + n];
        const double mag = exp_d(lr * dt); double sn, cs; sincos_d(li * dt, sn, cs);
        const double are = mag * cs, aim = mag * sn, den = lr * lr + li * li, nr = are - 1.0, ni = aim;
        const double zre = (nr * lr + ni * li) / den, zim = (ni * lr - nr * li) / den;
        double pr = are, pi = aim;
#pragma unroll 1
        for (int i = 0; i < 8; ++i) { const double t = pr * pr - pi * pi; pi = 2.0 * pr * pi; pr = t; }
        float* pa = (float*)(F.ws + WS_PARA) + (size_t)g * 256;
        pa[n] = (float)are; pa[64 + n] = (float)aim; pa[128 + n] = (float)pr; pa[192 + n] = (float)pi;
        bf16* pb = (bf16*)(F.ws + WS_PARB) + (size_t)g * 2048;
        const float* Bre = F.in[I_BRE] + ((size_t)g * SN + n) * SPC; const float* Bim = F.in[I_BIM] + ((size_t)g * SN + n) * SPC;
#pragma unroll
        for (int p = 0; p < SPC; ++p) { const double br = (double)Bre[p], bi = (double)Bim[p];
            pb[n * 16 + p] = f2bf((float)(zre * br - zim * bi)); pb[(64 + n) * 16 + p] = f2bf((float)(zre * bi + zim * br)); }
        bf16* pc = (bf16*)(F.ws + WS_PARC) + (size_t)g * 2048;
#pragma unroll
        for (int p = 0; p < SPC; ++p) { pc[p * 128 + n] = f2bf(F.in[I_CRE][((size_t)g * SPC + p) * SN + n]); pc[p * 128 + 64 + n] = f2bf(-F.in[I_CIM][((size_t)g * SPC + p) * SN + n]); }
    }
}

DI float gelu1(float v) {
    const float av = fabsf(v), t = __builtin_amdgcn_rcpf(av * 0.2316418882f + 1.0f);
    float q = t * 0.5307027145f + (-0.7265760135f); q = q * t + 0.7107068705f; q = q * t + (-0.142248368f); q = q * t + 0.127414796f; q = q * t;
    const float e = __builtin_amdgcn_exp2f((v * v) * (-0.72134752044f));
    const float m = v * (q * e);
    return v < 0.f ? m : v - m;
}

constexpr int S5_BU_STRIDE = 132  , S5_H_STRIDE = 272  , S5_WAVE_BYTES = 16 * S5_BU_STRIDE * 4 + 16 * S5_H_STRIDE  , S5_HE_OFF = 8 * S5_WAVE_BYTES;
DI void s5_prompt_unit(Frame& F, int unit) {
    const int b = unit >> 6, g = unit & 63, lane = F.lane, w = F.wave, r16 = lane & 15, q4 = lane >> 4;
    LAS float* BU = (LAS float*)(F.lds + w * S5_WAVE_BYTES);
    LAS unsigned char* Hb = F.lds + w * S5_WAVE_BYTES + 16 * S5_BU_STRIDE * 4;
    LAS float* HE = (LAS float*)(F.lds + S5_HE_OFF);
    const bf16* Pb = (const bf16*)(F.ws + WS_PB);
    const float* pa = (const float*)(F.ws + WS_PARA) + (size_t)g * 256;
    const float ar = pa[lane], ai = pa[64 + lane], a256r = pa[128 + lane], a256i = pa[192 + lane];
    const bf16* pb = (const bf16*)(F.ws + WS_PARB) + (size_t)g * 2048; const bf16* pc = (const bf16*)(F.ws + WS_PARC) + (size_t)g * 2048;
    bf16x8 Bf[8], Cf[4];
    const bf16x8 zero8 = {0, 0, 0, 0, 0, 0, 0, 0};
#pragma unroll
    for (int nb = 0; nb < 8; ++nb) Bf[nb] = q4 < 2 ? *(const bf16x8*)(pb + (nb * 16 + r16) * 16 + 8 * q4) : zero8;
#pragma unroll
    for (int ks = 0; ks < 4; ++ks) Cf[ks] = *(const bf16x8*)(pc + r16 * 128 + ks * 32 + 8 * q4);
    const float dsk = F.in[I_D][g * 16 + r16];
    const size_t row0 = (size_t)b * TSEQ + w * 256;
    const bf16* ucol = Pb + C_U + g * 16;
    float hr = 0.f, hi = 0.f;
#pragma unroll 1
    for (int pass = 0; pass < 2; ++pass) {
        if (pass == 1) {
            HE[w * 128 + lane] = hr; HE[w * 128 + 64 + lane] = hi;
            __syncthreads();
            float cr = 0.f, ci = 0.f;
            for (int j = 0; j < w; ++j) { const float er = HE[j * 128 + lane], ei = HE[j * 128 + 64 + lane]; const float t = a256r * cr - a256i * ci + er; ci = a256r * ci + a256i * cr + ei; cr = t; }
            if (w == 7) { const float fr_ = a256r * cr - a256i * ci + hr, fi_ = a256r * ci + a256i * cr + hi;
                F.out[O_S5RP + ((size_t)b * SG + g) * SN + lane] = fr_; F.out[O_S5IP + ((size_t)b * SG + g) * SN + lane] = fi_; }
            hr = cr; hi = ci;
        }
#pragma unroll 1
        for (int tile = 0; tile < 16; ++tile) {
            const size_t trow = row0 + tile * 16;
            const bf16x8 uf = q4 < 2 ? *(const bf16x8*)(ucol + (trow + r16) * NIN + 8 * q4) : zero8;
#pragma unroll
            for (int nb = 0; nb < 8; ++nb) { f32x4 a = {0.f, 0.f, 0.f, 0.f}; a = MFMA16(uf, Bf[nb], a);
#pragma unroll
                for (int i = 0; i < 4; ++i) BU[(4 * q4 + i) * S5_BU_STRIDE + nb * 16 + r16] = a[i]; }
            LDS_FENCE();
            if (pass == 0) {
#pragma unroll
                for (int tt = 0; tt < 16; ++tt) { const float br = BU[tt * S5_BU_STRIDE + lane], bi = BU[tt * S5_BU_STRIDE + 64 + lane];
                    const float t = ar * hr - ai * hi + br; hi = ar * hi + ai * hr + bi; hr = t; }
                LDS_FENCE();
            } else {
#pragma unroll
                for (int tt = 0; tt < 16; ++tt) { const float br = BU[tt * S5_BU_STRIDE + lane], bi = BU[tt * S5_BU_STRIDE + 64 + lane];
                    const float t = ar * hr - ai * hi + br; hi = ar * hi + ai * hr + bi; hr = t;
                    *(LAS unsigned short*)(Hb + tt * S5_H_STRIDE + lane * 2) = f2bf(hr); *(LAS unsigned short*)(Hb + tt * S5_H_STRIDE + 128 + lane * 2) = f2bf(hi); }
                LDS_FENCE();
                f32x4 y = {0.f, 0.f, 0.f, 0.f};
#pragma unroll
                for (int ks = 0; ks < 4; ++ks) { const bf16x8 hf = *(const LAS bf16x8*)(Hb + r16 * S5_H_STRIDE + (ks * 32 + 8 * q4) * 2); y = MFMA16(hf, Cf[ks], y); }
                bf16* Z = (bf16*)(F.ws + WS_Z);
#pragma unroll
                for (int i = 0; i < 4; ++i) { const size_t rr = trow + 4 * q4 + i; const float uv = bf2f(ucol[rr * NIN + r16]);
                    Z[rr * SW + g * 16 + r16] = f2bf(gelu1(y[i] + dsk * uv)); }
                LDS_FENCE();
            }
        }
    }
    __syncthreads();
}
DI void s5_sample_wave(Frame& F, int bs, int g) {
    const int lane = F.lane, r16 = lane & 15, q4 = lane >> 4;
    LAS float* hv = (LAS float*)(F.lds + F.wave * 512);
    const float* pa = (const float*)(F.ws + WS_PARA) + (size_t)g * 256; const float ar = pa[lane], ai = pa[64 + lane];
    const bf16* pb = (const bf16*)(F.ws + WS_PARB) + (size_t)g * 2048;
    const bf16* urow = (const bf16*)(F.ws + WS_PB) + (size_t)(TP + bs) * NIN + C_U + g * 16;
    const v4u u0 = *(const v4u*)urow, u1 = *(const v4u*)(urow + 8);
    const v4u bre0 = *(const v4u*)(pb + lane * 16), bre1 = *(const v4u*)(pb + lane * 16 + 8), bim0 = *(const v4u*)(pb + (64 + lane) * 16), bim1 = *(const v4u*)(pb + (64 + lane) * 16 + 8);
    float br = 0.f, bi = 0.f;
#define S5ACC(uw, rw, iw) { br += bflo(uw) * bflo(rw) + bfhi(uw) * bfhi(rw); bi += bflo(uw) * bflo(iw) + bfhi(uw) * bfhi(iw); }
    S5ACC(u0.x, bre0.x, bim0.x) S5ACC(u0.y, bre0.y, bim0.y) S5ACC(u0.z, bre0.z, bim0.z) S5ACC(u0.w, bre0.w, bim0.w)
    S5ACC(u1.x, bre1.x, bim1.x) S5ACC(u1.y, bre1.y, bim1.y) S5ACC(u1.z, bre1.z, bim1.z) S5ACC(u1.w, bre1.w, bim1.w)
#undef S5ACC
    const size_t so = ((size_t)bs * SG + g) * SN + lane;
    const float h0r = F.in[I_SRE][so], h0i = F.in[I_SIM][so];
    const float hr = ar * h0r - ai * h0i + br, hi = ar * h0i + ai * h0r + bi;
    F.out[O_S5RS + so] = hr; F.out[O_S5IS + so] = hi;
    hv[lane] = hr; hv[64 + lane] = hi;
    LDS_FENCE();
    const float* cre = F.in[I_CRE] + ((size_t)g * SPC + r16) * SN + 16 * q4; const float* cim = F.in[I_CIM] + ((size_t)g * SPC + r16) * SN + 16 * q4;
    float y = 0.f;
#pragma unroll
    for (int j = 0; j < 16; ++j) y += cre[j] * hv[16 * q4 + j] - cim[j] * hv[64 + 16 * q4 + j];
    y += __shfl_xor(y, 16); y += __shfl_xor(y, 32);
    const float uv = bf2f(urow[r16]);
    if (q4 == 0) ((bf16*)(F.ws + WS_Z))[(size_t)(TP + bs) * SW + g * 16 + r16] = f2bf(gelu1(y + F.in[I_D][g * 16 + r16] * uv));
    LDS_FENCE();
}

constexpr int HQ_STRIDE = 272, HK_STRIDE = 80;
constexpr int L_QT = 0, L_KT = 8704, L_QIN = 17408, L_KU = 26112, L_VT = 36352, L_ST = 46592, L_SC = 81408, L_PT = 83968, L_G16 = 88064, L_DEC = 88576, L_HG_END = 89088;
template <bool dry> DI void hgrn_local_unit(Frame& F, int unit) {
    const int b = unit >> 6, h = (unit >> 3) & 7, sc = unit & 7, lane = F.lane, w = F.wave, r16 = lane & 15, q4 = lane >> 4;
    LAS unsigned char* L = F.lds;
    bf16* Pb = (bf16*)(F.ws + WS_PB);
    float* OL = (float*)(F.ws + WS_OL);
    const float* lbp = (const float*)(F.ws + WS_LB) + h * HD + 2 * lane;
    const float lb0 = lbp[0], lb1 = lbp[1];
    const size_t urow0 = (size_t)b * TSEQ + sc * 256;
    f32x4 S[8];
#pragma unroll
    for (int kb = 0; kb < 8; ++kb) S[kb] = (f32x4){0.f, 0.f, 0.f, 0.f};
#pragma unroll
    for (int kb = 0; kb < 8; ++kb) *(LAS u32x2*)(L + L_ST + (w * 16 + r16) * HQ_STRIDE + (kb * 16 + 4 * q4) * 2) = (u32x2){0u, 0u};
    float Bp0 = 0.f, Bp1 = 0.f;
    unsigned qn[4], fn[4], vn[4];
#pragma unroll
    for (int j = 0; j < 4; ++j) { const bf16* rp = Pb + (urow0 + 4 * w + j) * NIN + h * HD + 2 * lane; qn[j] = *(const unsigned*)(rp + C_Q); fn[j] = *(const unsigned*)(rp + C_F); vn[j] = *(const unsigned*)(rp + C_I); }
#pragma unroll 1
    for (int c = 0; c < 8; ++c) {
        const size_t t0 = urow0 + c * 32;
        unsigned qc[4], fc[4], vc[4];
#pragma unroll
        for (int j = 0; j < 4; ++j) { qc[j] = qn[j]; fc[j] = fn[j]; vc[j] = vn[j]; }
        if (c < 7) {
#pragma unroll
            for (int j = 0; j < 4; ++j) { const bf16* rp = Pb + (t0 + 32 + 4 * w + j) * NIN + h * HD + 2 * lane; qn[j] = *(const unsigned*)(rp + C_Q); fn[j] = *(const unsigned*)(rp + C_F); vn[j] = *(const unsigned*)(rp + C_I); }
        }
        float kk0[4], kk1[4], cu0[4], cu1[4]; float g16a = 0.f, g16b = 0.f;
        { float c0 = 0.f, c1 = 0.f;
#pragma unroll
          for (int j = 0; j < 4; ++j) { const float f0 = lb0 + (1.f - lb0) * sigm(bflo(fc[j])), f1 = lb1 + (1.f - lb1) * sigm(bfhi(fc[j]));
              const float g0 = __logf(f0), g1 = __logf(f1); kk0[j] = 1.f - f0; kk1[j] = 1.f - f1; c0 += g0; c1 += g1; cu0[j] = c0; cu1[j] = c1; if (j == 0) { g16a = g0; g16b = g1; } } }
        *(LAS f32x2*)(L + L_PT + (w * 128 + 2 * lane) * 4) = (f32x2){cu0[3], cu1[3]};
        if (w == 4) *(LAS f32x2*)(L + L_G16 + 2 * lane * 4) = (f32x2){g16a, g16b};
        __syncthreads();
        float pre0 = 0.f, pre1 = 0.f, tot0 = 0.f, tot1 = 0.f, mid0 = 0.f, mid1 = 0.f;
#pragma unroll
        for (int j = 0; j < 8; ++j) { const f32x2 p = *(const LAS f32x2*)(L + L_PT + (j * 128 + 2 * lane) * 4); tot0 += p.x; tot1 += p.y; if (j < w) { pre0 += p.x; pre1 += p.y; } if (j < 4) { mid0 += p.x; mid1 += p.y; } }
        { const f32x2 p = *(const LAS f32x2*)(L + L_G16 + 2 * lane * 4); mid0 += p.x; mid1 += p.y; }
        unsigned ku0[2], ku1[2], vt0[2], vt1[2];
        { float kuA[4], kuB[4];
#pragma unroll
          for (int j = 0; j < 4; ++j) {
              const float b0 = pre0 + cu0[j], b1 = pre1 + cu1[j]; const float q0 = bflo(qc[j]), q1 = bfhi(qc[j]);
              const int trow = 4 * w + j;
              *(LAS unsigned*)(L + L_QT + trow * HQ_STRIDE + lane * 4) = pk2(q0 * fexp(b0 - mid0), q1 * fexp(b1 - mid1));
              *(LAS unsigned*)(L + L_KT + trow * HQ_STRIDE + lane * 4) = pk2(kk0[j] * fexp(mid0 - b0), kk1[j] * fexp(mid1 - b1));
              *(LAS unsigned*)(L + L_QIN + trow * HQ_STRIDE + lane * 4) = pk2(q0 * fexp(b0), q1 * fexp(b1));
              kuA[j] = kk0[j] * fexp(tot0 - b0); kuB[j] = kk1[j] * fexp(tot1 - b1);
              if (!dry) *(unsigned*)(Pb + (t0 + trow) * NIN + C_Q + h * HD + 2 * lane) = pk2(q0 * fexp(Bp0 + b0), q1 * fexp(Bp1 + b1));
          }
          ku0[0] = pk2(kuA[0], kuA[1]); ku0[1] = pk2(kuA[2], kuA[3]); ku1[0] = pk2(kuB[0], kuB[1]); ku1[1] = pk2(kuB[2], kuB[3]); }
        vt0[0] = (vc[0] & 0xffffu) | (vc[1] << 16); vt0[1] = (vc[2] & 0xffffu) | (vc[3] << 16);
        vt1[0] = (vc[0] >> 16) | (vc[1] & 0xffff0000u); vt1[1] = (vc[2] >> 16) | (vc[3] & 0xffff0000u);
        *(LAS u32x2*)(L + L_KU + (2 * lane) * HK_STRIDE + 8 * w) = (u32x2){ku0[0], ku0[1]};
        *(LAS u32x2*)(L + L_KU + (2 * lane + 1) * HK_STRIDE + 8 * w) = (u32x2){ku1[0], ku1[1]};
        *(LAS u32x2*)(L + L_VT + (2 * lane) * HK_STRIDE + 8 * w) = (u32x2){vt0[0], vt0[1]};
        *(LAS u32x2*)(L + L_VT + (2 * lane + 1) * HK_STRIDE + 8 * w) = (u32x2){vt1[0], vt1[1]};
        if (w == 0) *(LAS f32x2*)(L + L_DEC + 2 * lane * 4) = (f32x2){fexp(tot0), fexp(tot1)};
        Bp0 += tot0; Bp1 += tot1;
        __syncthreads();
        if (w < 3) {
            const int tb = w == 0 ? 0 : 1, sb = w == 2 ? 1 : 0;
            f32x4 a = {0.f, 0.f, 0.f, 0.f};
#pragma unroll
            for (int ks = 0; ks < 4; ++ks) { const bf16x8 af = *(const LAS bf16x8*)(L + L_QT + (tb * 16 + r16) * HQ_STRIDE + (ks * 32 + 8 * q4) * 2), bf = *(const LAS bf16x8*)(L + L_KT + (sb * 16 + r16) * HQ_STRIDE + (ks * 32 + 8 * q4) * 2); a = MFMA16(af, bf, a); }
#pragma unroll
            for (int i = 0; i < 4; ++i) { const int t = tb * 16 + 4 * q4 + i, s = sb * 16 + r16; *(LAS unsigned short*)(L + L_SC + t * HK_STRIDE + s * 2) = s <= t ? f2bf(a[i]) : (unsigned short)0; }
        } else if (w == 3) {
#pragma unroll
            for (int i = 0; i < 4; ++i) *(LAS unsigned short*)(L + L_SC + (4 * q4 + i) * HK_STRIDE + (16 + r16) * 2) = (unsigned short)0;
        }
        __syncthreads();
        const bf16x8 vtf = *(const LAS bf16x8*)(L + L_VT + (w * 16 + r16) * HK_STRIDE + 16 * q4);
        bf16x8 stf[4];
#pragma unroll
        for (int ks = 0; ks < 4; ++ks) stf[ks] = *(const LAS bf16x8*)(L + L_ST + (w * 16 + r16) * HQ_STRIDE + (ks * 32 + 8 * q4) * 2);
#pragma unroll
        for (int tb = 0; tb < 2; ++tb) {
            f32x4 o = {0.f, 0.f, 0.f, 0.f};
            { const bf16x8 sf = *(const LAS bf16x8*)(L + L_SC + (tb * 16 + r16) * HK_STRIDE + 16 * q4); o = MFMA16(sf, vtf, o); }
#pragma unroll
            for (int ks = 0; ks < 4; ++ks) { const bf16x8 qf = *(const LAS bf16x8*)(L + L_QIN + (tb * 16 + r16) * HQ_STRIDE + (ks * 32 + 8 * q4) * 2); o = MFMA16(qf, stf[ks], o); }
#pragma unroll
            for (int i = 0; i < 4; ++i) OL[(t0 + tb * 16 + 4 * q4 + i) * HW + h * HD + w * 16 + r16] = o[i];
        }
#pragma unroll
        for (int kb = 0; kb < 8; ++kb) {
            const f32x4 d = *(const LAS f32x4*)(L + L_DEC + (kb * 16 + 4 * q4) * 4);
            const bf16x8 kf = *(const LAS bf16x8*)(L + L_KU + (kb * 16 + r16) * HK_STRIDE + 16 * q4);
            S[kb] = MFMA16(kf, vtf, S[kb] * d);
            *(LAS u32x2*)(L + L_ST + (w * 16 + r16) * HQ_STRIDE + (kb * 16 + 4 * q4) * 2) = (u32x2){pk2(S[kb][0], S[kb][1]), pk2(S[kb][2], S[kb][3])};
        }
    }
    float* USC = (float*)(F.ws + WS_USC) + (size_t)unit * HD * HD; float* DSC = (float*)(F.ws + WS_DSC) + (size_t)unit * HD;
#pragma unroll
    for (int kb = 0; kb < 8; ++kb)
#pragma unroll
        for (int i = 0; i < 4; ++i) USC[(kb * 16 + 4 * q4 + i) * HD + w * 16 + r16] = S[kb][i];
    if (w == 0) { DSC[2 * lane] = fexp(Bp0); DSC[2 * lane + 1] = fexp(Bp1); }
    __syncthreads();
}

DI void hgrn_sample_unit(Frame& F, int unit) {
    const int bs = unit >> 3, h = unit & 7, tid = F.tid, lane = F.lane, w = F.wave;
    LAS float* part = (LAS float*)F.lds;
    const bf16* prow = (const bf16*)(F.ws + WS_PB) + (size_t)(TP + bs) * NIN + h * HD;
    const float* lb = (const float*)(F.ws + WS_LB) + h * HD;
    const int vq = tid & 31, kr = tid >> 5;
    const float* S0 = F.in[I_SH] + ((size_t)bs * NH + h) * HD * HD; float* S1 = F.out + O_HS + ((size_t)bs * NH + h) * HD * HD;
    f32x4 iv; { const u32x2 t = *(const u32x2*)(prow + C_I + 4 * vq); iv = (f32x4){bflo(t.x), bfhi(t.x), bflo(t.y), bfhi(t.y)}; }
    f32x4 o = {0.f, 0.f, 0.f, 0.f};
#pragma unroll
    for (int j = 0; j < 8; ++j) { const int k = kr + 16 * j;
        const float l = lb[k], f = l + (1.f - l) * sigm(bf2f(prow[C_F + k])), q = bf2f(prow[C_Q + k]);
        const f32x4 s = *(const f32x4*)(S0 + (size_t)k * HD + 4 * vq) * f + iv * (1.f - f);
        *(f32x4*)(S1 + (size_t)k * HD + 4 * vq) = s; o += s * q; }
#pragma unroll
    for (int i = 0; i < 4; ++i) o[i] += __shfl_xor(o[i], 32);
    if (lane < 32) *(LAS f32x4*)(part + w * 128 + 4 * vq) = o;
    __syncthreads();
    if (w == 0) {
        float o0 = 0.f, o1 = 0.f;
#pragma unroll
        for (int j = 0; j < 8; ++j) { o0 += part[j * 128 + lane]; o1 += part[j * 128 + 64 + lane]; }
        const float rs = 1.0f / sqrtf(wave_sum(o0 * o0 + o1 * o1) * (1.0f / HD) + RMS_EPS);
        const float* gn = F.in[I_HG] + h * HD; bf16* oa = (bf16*)(F.ws + WS_OAB) + (size_t)(TP + bs) * DM + h * HD;
        const float g0 = bf2f(prow[C_OG + lane]), g1 = bf2f(prow[C_OG + 64 + lane]);
        oa[lane] = f2bf(o0 * rs * gn[lane] * g0 * sigm(g0)); oa[64 + lane] = f2bf(o1 * rs * gn[64 + lane] * g1 * sigm(g1));
    }
    __syncthreads();
}

DI void hgrn_finish_unit(Frame& F, int unit) {
    const int b = unit >> 6, h = (unit >> 3) & 7, sc = unit & 7, lane = F.lane, w = F.wave, r16 = lane & 15, q4 = lane >> 4;
    LAS unsigned char* L = F.lds;
    const bf16* Pb = (const bf16*)(F.ws + WS_PB);
    const float* OL = (const float*)(F.ws + WS_OL);
    const size_t urow0 = (size_t)b * TSEQ + sc * 256;
    f32x4 S[8];
#pragma unroll
    for (int kb = 0; kb < 8; ++kb) S[kb] = (f32x4){0.f, 0.f, 0.f, 0.f};
    const int nprev = sc == 7 ? 8 : sc;
#pragma unroll 1
    for (int j = 0; j < nprev; ++j) {
        if (j == sc) {
#pragma unroll
            for (int kb = 0; kb < 8; ++kb) *(LAS u32x2*)(L + L_ST + (w * 16 + r16) * HQ_STRIDE + (kb * 16 + 4 * q4) * 2) = (u32x2){pk2(S[kb][0], S[kb][1]), pk2(S[kb][2], S[kb][3])};
        }
        const float* USC = (const float*)(F.ws + WS_USC) + (size_t)((unit & ~7) + j) * HD * HD; const float* DSC = (const float*)(F.ws + WS_DSC) + (size_t)((unit & ~7) + j) * HD;
#pragma unroll
        for (int kb = 0; kb < 8; ++kb) { const f32x4 d = *(const f32x4*)(DSC + kb * 16 + 4 * q4);
#pragma unroll
            for (int i = 0; i < 4; ++i) S[kb][i] = S[kb][i] * d[i] + USC[(kb * 16 + 4 * q4 + i) * HD + w * 16 + r16]; }
    }
    if (sc == 7) {
        float* HP = F.out + O_HP + ((size_t)b * NH + h) * HD * HD;
#pragma unroll
        for (int kb = 0; kb < 8; ++kb)
#pragma unroll
            for (int i = 0; i < 4; ++i) HP[(kb * 16 + 4 * q4 + i) * HD + w * 16 + r16] = S[kb][i];
    } else {
#pragma unroll
        for (int kb = 0; kb < 8; ++kb) *(LAS u32x2*)(L + L_ST + (w * 16 + r16) * HQ_STRIDE + (kb * 16 + 4 * q4) * 2) = (u32x2){pk2(S[kb][0], S[kb][1]), pk2(S[kb][2], S[kb][3])};
    }
    __syncthreads();
    const float* gn = F.in[I_HG] + h * HD; bf16* OA = (bf16*)(F.ws + WS_OAB);
#pragma unroll 1
    for (int tbi = 0; tbi < 2; ++tbi) {
        const size_t t0 = urow0 + (2 * w + tbi) * 16;
        bf16x8 qf[4];
#pragma unroll
        for (int ks = 0; ks < 4; ++ks) qf[ks] = *(const bf16x8*)(Pb + (t0 + r16) * NIN + C_Q + h * HD + ks * 32 + 8 * q4);
        f32x4 o[8]; float ssq[4] = {0.f, 0.f, 0.f, 0.f};
        const float* olp = OL + (t0 + 4 * q4) * HW + h * HD + r16;
#pragma unroll
        for (int vb = 0; vb < 8; ++vb) {
            f32x4 a = {0.f, 0.f, 0.f, 0.f};
#pragma unroll
            for (int ks = 0; ks < 4; ++ks) { const bf16x8 sf = *(const LAS bf16x8*)(L + L_ST + (vb * 16 + r16) * HQ_STRIDE + (ks * 32 + 8 * q4) * 2); a = MFMA16(qf[ks], sf, a); }
#pragma unroll
            for (int i = 0; i < 4; ++i) { a[i] += olp[i * HW + vb * 16]; ssq[i] += a[i] * a[i]; }
            o[vb] = a;
            asm volatile("" ::: "memory");
        }
#pragma unroll
        for (int i = 0; i < 4; ++i) { float s = ssq[i]; s += __shfl_xor(s, 1); s += __shfl_xor(s, 2); s += __shfl_xor(s, 4); s += __shfl_xor(s, 8); ssq[i] = 1.0f / sqrtf(s * (1.0f / HD) + RMS_EPS); }
        const bf16* ogp = Pb + (t0 + 4 * q4) * NIN + C_OG + h * HD + r16; bf16* oap = OA + (t0 + 4 * q4) * DM + h * HD + r16;
#pragma unroll
        for (int vb = 0; vb < 8; ++vb) { const float gv = gn[vb * 16 + r16];
#pragma unroll
            for (int i = 0; i < 4; ++i) { const float og = bf2f(ogp[i * NIN + vb * 16]);
                oap[i * DM + vb * 16] = f2bf(o[vb][i] * ssq[i] * gv * og * sigm(og)); }
            asm volatile("" ::: "memory"); }
    }
    __syncthreads();
}


DI f32x4 smm_core(const bf16* ap, const bf16* bp, int klen) {
    f32x4 c0 = {0.f, 0.f, 0.f, 0.f}, c1 = c0, c2 = c0, c3 = c0;
#pragma unroll 2
    for (int k = 0; k < klen; k += 128) {
        const bf16x8 a0 = *(const bf16x8*)(ap + k), a1 = *(const bf16x8*)(ap + k + 32), a2 = *(const bf16x8*)(ap + k + 64), a3 = *(const bf16x8*)(ap + k + 96);
        const bf16x8 b0 = *(const bf16x8*)(bp + k), b1 = *(const bf16x8*)(bp + k + 32), b2 = *(const bf16x8*)(bp + k + 64), b3 = *(const bf16x8*)(bp + k + 96);
        c0 = MFMA16(a0, b0, c0); c1 = MFMA16(a1, b1, c1); c2 = MFMA16(a2, b2, c2); c3 = MFMA16(a3, b3, c3);
    }
    return (c0 + c1) + (c2 + c3);
}
DI void smm_glu(Frame& F) {
    const int lane = F.lane, w = F.wave, r16 = lane & 15, q4 = lane >> 4, rb = w & 3, kh = w >> 2;
    LAS f32x4* X = (LAS f32x4*)F.lds;
    const bf16* Z = (const bf16*)(F.ws + WS_Z); const bf16* Wt = (const bf16*)(F.ws + WS_WGLU); bf16* OAB = (bf16*)(F.ws + WS_OAB);
    for (int it = F.bid; it < 128; it += F.G) {
        const int cb = it >> 1, rh = it & 1, j0 = cb * 16, row0 = TP + rh * 64 + rb * 16;
        const int wrow = (j0 >> 7) * 256 + (j0 & 127);
        const bf16* ap = Z + (size_t)(row0 + r16) * SW + kh * 512 + 8 * q4;
        const f32x4 av = smm_core(ap, Wt + (size_t)(wrow + r16) * SW + kh * 512 + 8 * q4, 512);
        const f32x4 gv = smm_core(ap, Wt + (size_t)(wrow + 128 + r16) * SW + kh * 512 + 8 * q4, 512);
        if (kh == 1) { X[(rb * 2 + 0) * 64 + lane] = av; X[(rb * 2 + 1) * 64 + lane] = gv; }
        __syncthreads();
        if (kh == 0) { const f32x4 a = av + X[(rb * 2 + 0) * 64 + lane], g = gv + X[(rb * 2 + 1) * 64 + lane];
#pragma unroll
            for (int i = 0; i < 4; ++i) OAB[(size_t)(row0 + 4 * q4 + i) * DM + HW + j0 + r16] = f2bf(a[i] * sigm(g[i])); }
        __syncthreads();
    }
}
DI void smm_merge(Frame& F) {
    const int lane = F.lane, w = F.wave, r16 = lane & 15, q4 = lane >> 4, rb = w & 3, kh = w >> 2;
    LAS f32x4* X = (LAS f32x4*)F.lds;
    const bf16* OAB = (const bf16*)(F.ws + WS_OAB); const bf16* Wt = (const bf16*)(F.ws + WS_WCAT); const bf16* Pb = (const bf16*)(F.ws + WS_PB); bf16* MRG = (bf16*)(F.ws + WS_MRG);
    for (int it = F.bid; it < 256; it += F.G) {
        const int cb = it >> 1, rh = it & 1, c0 = cb * 16, row0 = TP + rh * 64 + rb * 16;
        f32x4 v = smm_core(OAB + (size_t)(row0 + r16) * DM + kh * 1024 + 8 * q4, Wt + (size_t)(c0 + r16) * DM + kh * 1024 + 8 * q4, 1024);
#pragma unroll
        for (int i = 0; i < 4; ++i) v[i] *= sigm(bf2f(Pb[(size_t)(row0 + 4 * q4 + i) * NIN + (kh ? C_GB : C_GA) + c0 + r16]));
        if (kh == 1) X[rb * 64 + lane] = v;
        __syncthreads();
        if (kh == 0) { v += X[rb * 64 + lane];
#pragma unroll
            for (int i = 0; i < 4; ++i) MRG[(size_t)(row0 + 4 * q4 + i) * DM + c0 + r16] = f2bf(v[i]); }
        __syncthreads();
    }
}
template <bool WRITE_BF16> DI void smm_res(Frame& F, const bf16* A, const bf16* Wt, int K, const float* base  , float* out  , bf16* ob  , float* ss  ) {
    const int lane = F.lane, w = F.wave, r16 = lane & 15, q4 = lane >> 4, rb = w & 3, kh = w >> 2;
    LAS f32x4* X = (LAS f32x4*)F.lds;
    const int khl = K >> 1;
    for (int it = F.bid; it < 256; it += F.G) {
        const int cb = it >> 1, rh = it & 1, c0 = cb * 16, row0 = rh * 64 + rb * 16;
        f32x4 v = smm_core(A + (size_t)(TP + row0 + r16) * K + kh * khl + 8 * q4, Wt + (size_t)(c0 + r16) * K + kh * khl + 8 * q4, khl);
        if (kh == 1) X[rb * 64 + lane] = v;
        __syncthreads();
        if (kh == 0) { v += X[rb * 64 + lane];
#pragma unroll
            for (int i = 0; i < 4; ++i) { const size_t o = (size_t)(row0 + 4 * q4 + i) * DM + c0 + r16; const float y = base[o] + v[i]; out[o] = y; if (WRITE_BF16) ob[o] = f2bf(y);
                float s = y * y; s += __shfl_xor(s, 1); s += __shfl_xor(s, 2); s += __shfl_xor(s, 4); s += __shfl_xor(s, 8);
                if (r16 == 0) atomicAdd(ss + row0 + 4 * q4 + i, s); } }
        __syncthreads();
    }
}

DI void final_norm(Frame& F) {
    const int gw = F.bid * NWAVES + F.wave, NGW = F.G * NWAVES;
    const float* ss3 = (const float*)(F.ws + WS_SS3); const f32x4* gf = (const f32x4*)F.in[I_NF] + F.lane;
    for (int m = gw; m < MV; m += NGW) {
        const float r = 1.0f / sqrtf(ss3[m] * (1.0f / DM) + RMS_EPS);
        f32x4* x4 = (f32x4*)(F.out + (size_t)m * DM) + F.lane;
#pragma unroll
        for (int j = 0; j < 8; ++j) x4[64 * j] = x4[64 * j] * r * gf[64 * j];
    }
}

#define XB_TMO      128
#define XB_XCNT(j)  (256  + 64 * (j))
#define XB_XSUB(j)  (1280 + 64 * (j))
#define XB_XGEN(j)  (2304 + 64 * (j))
#define XB_TOP      3328
#define XB_TOPGEN   3392
#define XCD_BAR_WORDS 3456
#define XB_SPIN_CAP (1u << 18)

__device__ __forceinline__ unsigned xb_ld(unsigned* p)              { return __hip_atomic_load(p, __ATOMIC_RELAXED, __HIP_MEMORY_SCOPE_AGENT); }
__device__ __forceinline__ unsigned xb_add(unsigned* p, unsigned v) { return __hip_atomic_fetch_add(p, v, __ATOMIC_RELAXED, __HIP_MEMORY_SCOPE_AGENT); }
__device__ __forceinline__ unsigned xb_xcc_id() { return (unsigned)__builtin_amdgcn_s_getreg((3 << 11) | 20) & 0xFu; }
#define XB_SPIN(cond, bar) do { unsigned _sp = 0; while (cond) { __builtin_amdgcn_s_sleep(1); \
    if ((++_sp & 255u) == 0u) { if (xb_ld(&(bar)[XB_TMO])) break; if (_sp > XB_SPIN_CAP) { atomicAdd(&(bar)[XB_TMO], 1u); break; } } } } while (0)

struct XcdBarrier {
    unsigned* bar; unsigned x;
    volatile LAS unsigned* st;
};

__device__ __forceinline__ XcdBarrier xcd_barrier_post(unsigned* bar, volatile LAS unsigned* st) {
    XcdBarrier b; b.bar = bar; b.x = xb_xcc_id(); b.st = st;
    if (threadIdx.x == 0) (void)xb_add(&bar[XB_XCNT(b.x)], 1u);
    return b;
}
__device__ __forceinline__ void xcd_barrier_complete(unsigned* bar, unsigned x, unsigned& nloc, unsigned& nx) {
    const unsigned G = gridDim.x * gridDim.y * gridDim.z;
    unsigned sum, cnt, mine, sp = 0u;
    for (;;) {
        sum = 0u; cnt = 0u; mine = 0u;
#pragma unroll
        for (unsigned j = 0; j < 16; ++j) { const unsigned c = xb_ld(&bar[XB_XCNT(j)]); sum += c; cnt += (c > 0u) ? 1u : 0u; mine = (j == x) ? c : mine; }
        if (sum == G) break;
        __builtin_amdgcn_s_sleep(1);
        if ((++sp & 255u) == 0u) { if (xb_ld(&bar[XB_TMO])) break; if (sp > XB_SPIN_CAP) { atomicAdd(&bar[XB_TMO], 1u); break; } }
    }
    nloc = mine > 0u ? mine : 1u; nx = cnt > 0u ? cnt : 1u;
}

__device__ __forceinline__ void xcd_barrier(const XcdBarrier& b) {
    asm volatile("s_waitcnt vmcnt(0)" ::: "memory");
    __syncthreads();
    if (threadIdx.x == 0) {
        unsigned* bar = b.bar;
        __builtin_amdgcn_s_waitcnt(0);
        unsigned nloc = b.st[0], nx = b.st[1];
        if (nloc == 0u) { xcd_barrier_complete(bar, b.x, nloc, nx); b.st[0] = nloc; b.st[1] = nx; }
        const unsigned old = xb_add(&bar[XB_XSUB(b.x)], 1u);
        const unsigned gen = old / nloc;
        if (old + 1u == (gen + 1u) * nloc) {
            __builtin_amdgcn_fence(__ATOMIC_RELEASE, "agent");
            asm volatile("s_waitcnt vmcnt(0)" ::: "memory");
            const unsigned og = xb_add(&bar[XB_TOP], 1u);
            const unsigned tg = og / nx;
            if (og + 1u == (tg + 1u) * nx) xb_add(&bar[XB_TOPGEN], 1u);
            else XB_SPIN(xb_ld(&bar[XB_TOPGEN]) == tg, bar);
            __builtin_amdgcn_fence(__ATOMIC_ACQUIRE, "agent");
            xb_add(&bar[XB_XGEN(b.x)], 1u);
            asm volatile("s_waitcnt vmcnt(0)" ::: "memory");
        } else {
            XB_SPIN(xb_ld(&bar[XB_XGEN(b.x)]) == gen, bar);
            __builtin_amdgcn_fence(__ATOMIC_ACQUIRE, "agent");
            asm volatile("s_waitcnt vmcnt(0)" ::: "memory");
        }
    }
    __syncthreads();
}

#ifndef N_LAUNCHES
#define N_LAUNCHES 1
#endif
constexpr int NPHASE = 9;
__global__ void __launch_bounds__(NTHR, 2) hybrid_fwd(Args args) {
    extern __shared__ __attribute__((aligned(16))) unsigned char lds_raw[];
    cg::grid_group grid = cg::this_grid();
    Frame F;
    F.lds = (LAS unsigned char*)lds_raw; F.tid = threadIdx.x; F.lane = F.tid & 63; F.wave = __builtin_amdgcn_readfirstlane(F.tid >> 6);
    F.G = gridDim.x; F.bid = blockIdx.x; F.out = args.out; F.ws = args.ws;
#pragma unroll
    for (int i = 0; i < 25; ++i) F.in[i] = args.in[i];
    const int lo = args.ph_lo, hi = args.ph_hi;
#ifndef REPMASK
#define REPMASK 0
#endif
#ifndef SKIPMASK
#define SKIPMASK 0
#endif
#ifndef PHMASK
#define PHMASK 0x1ff
#endif
#define IN(k) (((PHMASK >> (k)) & 1) && lo <= (k) && (k) < hi)
#ifndef XSYNC
#define XSYNC 0
#endif
#ifndef CG_SEAMS
#define CG_SEAMS 0x1
#endif
    { volatile LAS unsigned* st = (volatile LAS unsigned*)(F.lds + LDS_BAR_OFF); if (F.tid < 2) st[F.tid] = 0u; __syncthreads(); }
    const XcdBarrier xbar = xcd_barrier_post((unsigned*)(F.ws + WS_BAR), (volatile LAS unsigned*)(F.lds + LDS_BAR_OFF));
#define SEAM(k) do { if (IN(k) && IN((k) + 1)) { if ((CG_SEAMS >> (k)) & 1) grid.sync(); else xcd_barrier(xbar); if ((k) == 4) { for (int xs = 0; xs < XSYNC; ++xs) xcd_barrier(xbar); } } } while (0)
    typedef pg8::bf16_t pb;
    if (IN(0)) { p0_prologue(F); if ((REPMASK >> 0) & 1) { __syncthreads(); p0_prologue(F); } } SEAM(0);
    if (IN(1)) {
        pg8::Gemm g{(const pb*)(F.ws + WS_XB), (const pb*)(F.ws + WS_WIN), MP, NIN, DM, DM}; pg8::StaticOrder S; S.init(MP, NIN, F.G, F.bid);
        pg8::EpiIn E{(pb*)(F.ws + WS_PB), (const float*)(F.ws + WS_RS1), NIN};
        pg8::gemm_phase<pg8::EpiIn, pg8::StaticOrder, true, true>(F.lds, g, S, E);
#if (REPMASK >> 1) & 1
        pg8::gemm_phase<pg8::EpiIn, pg8::StaticOrder, true, true>(F.lds, g, S, E);
#endif
    } SEAM(1);
    if (IN(2)) {
#define P2_BODY(DRY) do { \
        if (!((SKIPMASK >> 0) & 1)) for (int u = F.bid; u < NB * SG; u += F.G) s5_prompt_unit(F, u); \
        if (!((SKIPMASK >> 1) & 1)) for (int u = F.bid; u < NB * NH * 8; u += F.G) hgrn_local_unit<DRY>(F, u); \
        for (int u = F.bid; u < NSMP * NH; u += F.G) hgrn_sample_unit(F, u); \
        { const int gw = F.bid * NWAVES + F.wave, NGW = F.G * NWAVES; for (int u = gw; u < NSMP * SG; u += NGW) s5_sample_wave(F, u >> 6, u & 63); } \
        __syncthreads(); } while (0)
#if (REPMASK >> 2) & 1
        P2_BODY(true);
#endif
        P2_BODY(false);
    } SEAM(2);
    if (IN(3)) {
#pragma unroll 1
        for (int rep = ((REPMASK >> 9) & 1) ? 0 : 1; rep < 2; ++rep)
        for (int u = F.bid; u < NB * NH * 8; u += F.G) hgrn_finish_unit(F, u);
#ifndef NO_GLU
        pg8::Gemm g{(const pb*)(F.ws + WS_Z), (const pb*)(F.ws + WS_WGLU), TP, 2 * SW, SW, SW}; pg8::StaticOrder S; S.init(TP, 2 * SW, F.G, F.bid);
        pg8::EpiGlu E{(pb*)(F.ws + WS_OAB) + HW, DM};
        pg8::gemm_phase<pg8::EpiGlu, pg8::StaticOrder, true, true>(F.lds, g, S, E);
#endif
        smm_glu(F);
    } SEAM(3);
    if (IN(4)) {
        pg8::Gemm g{(const pb*)(F.ws + WS_OAB), (const pb*)(F.ws + WS_WCAT), TP, DM, DM, MERGE_MID ? DM / 2 : DM}; pg8::HalvedOrder S; S.init(TP, DM, F.G, F.bid);
        pg8::EpiMerge E{(pb*)(F.ws + WS_MRG), (const pb*)(F.ws + WS_PB), NIN, C_GA, C_GB, DM};
        pg8::gemm_phase<pg8::EpiMerge, pg8::HalvedOrder, true, true>(F.lds, g, S, E);
#if (REPMASK >> 4) & 1
        pg8::gemm_phase<pg8::EpiMerge, pg8::HalvedOrder, true, true>(F.lds, g, S, E);
#endif
        smm_merge(F);
    } SEAM(4);
    if (IN(5)) {
        pg8::Gemm g{(const pb*)(F.ws + WS_MRG), (const pb*)(F.ws + WS_WOUT), TP, DM, DM, DM}; pg8::StaticOrder S; S.init(TP, DM, F.G, F.bid);
        pg8::EpiRes<true> E{F.in[I_XP], F.in[I_XS], TP, (float*)(F.ws + WS_X1), (pb*)(F.ws + WS_X1B), (float*)(F.ws + WS_SS2), MV, DM};
        pg8::gemm_phase<pg8::EpiRes<true>, pg8::StaticOrder, true, true>(F.lds, g, S, E);
        smm_res<true>(F, (const bf16*)(F.ws + WS_MRG), (const bf16*)(F.ws + WS_WOUT), DM, F.in[I_XS], (float*)(F.ws + WS_X1) + (size_t)TP * DM, (bf16*)(F.ws + WS_X1B) + (size_t)TP * DM, (float*)(F.ws + WS_SS2) + TP);
    } SEAM(5);
    if (IN(6)) {
        pg8::Gemm g{(const pb*)(F.ws + WS_X1B), (const pb*)(F.ws + WS_WUP), MP, 2 * FF, DM, DM}; pg8::StaticOrder S; S.init(MP, 2 * FF, F.G, F.bid);
        pg8::EpiSwiGlu E{(pb*)(F.ws + WS_ACT), (const float*)(F.ws + WS_SS2), FF};
        pg8::gemm_phase<pg8::EpiSwiGlu, pg8::StaticOrder, true, true>(F.lds, g, S, E);
#if (REPMASK >> 6) & 1
        pg8::gemm_phase<pg8::EpiSwiGlu, pg8::StaticOrder, true, true>(F.lds, g, S, E);
#endif
    } SEAM(6);
    if (IN(7)) {
        pg8::Gemm g{(const pb*)(F.ws + WS_ACT), (const pb*)(F.ws + WS_WDN), TP, DM, FF, FF}; pg8::StaticOrder S; S.init(TP, DM, F.G, F.bid);
        pg8::EpiRes<false> E{(const float*)(F.ws + WS_X1), (const float*)(F.ws + WS_X1), MP, F.out, nullptr, (float*)(F.ws + WS_SS3), MV, DM};
        pg8::gemm_phase<pg8::EpiRes<false>, pg8::StaticOrder, true, true>(F.lds, g, S, E);
        smm_res<false>(F, (const bf16*)(F.ws + WS_ACT), (const bf16*)(F.ws + WS_WDN), FF, (const float*)(F.ws + WS_X1) + (size_t)TP * DM, F.out + (size_t)TP * DM, nullptr, (float*)(F.ws + WS_SS3) + TP);
    } SEAM(7);
    if (IN(8)) final_norm(F);
#undef IN
#undef SEAM
}

extern "C" void kernel_launch(void* const* d_in, const int* in_sizes, int n_in, void* d_out, int out_size, void* d_ws, size_t ws_size, hipStream_t stream) {
    static int grid = 0;
    if (grid == 0) {
        if (n_in != 25 || ws_size < WS_END || (size_t)out_size != O_END) { fprintf(stderr, "kernel_launch: unexpected problem: n_in %d ws %zu (need %zu) out %d (expect %zu)\n", n_in, ws_size, (size_t)WS_END, out_size, (size_t)O_END); grid = -1; return; }
        int dev = 0, cus = 0, per_cu = 0;
        hipGetDevice(&dev); hipDeviceGetAttribute(&cus, hipDeviceAttributeMultiprocessorCount, dev);
        hipFuncSetAttribute((const void*)hybrid_fwd, hipFuncAttributeMaxDynamicSharedMemorySize, LDS_BYTES);
        hipOccupancyMaxActiveBlocksPerMultiprocessor(&per_cu, (const void*)hybrid_fwd, NTHR, LDS_BYTES);
        if (per_cu < 1) { fprintf(stderr, "kernel_launch: occupancy query reports %d blocks per CU\n", per_cu); per_cu = 1; }
        (void)hipGetLastError();
        grid = cus;
    }
    if (grid < 0) return;
    if (hipMemsetAsync((char*)d_ws + WS_BAR, 0, WS_BAR_BYTES, stream) != hipSuccess) { fprintf(stderr, "kernel_launch: memset of the barrier words failed\n"); return; }
    Args a{};
    for (int i = 0; i < 25; ++i) a.in[i] = (const float*)d_in[i];
    a.out = (float*)d_out; a.ws = (unsigned char*)d_ws;
#if N_LAUNCHES == 1
    a.ph_lo = 0; a.ph_hi = NPHASE;
    void* params[] = {&a};
    hipError_t e = hipLaunchCooperativeKernel((const void*)hybrid_fwd, dim3(grid), dim3(NTHR), params, LDS_BYTES, stream);
    if (e != hipSuccess) fprintf(stderr, "cooperative launch failed: %s (grid %d)\n", hipGetErrorString(e), grid);
#else
    for (int p = 0; p < NPHASE; ++p) { a.ph_lo = p; a.ph_hi = p + 1; hipLaunchKernelGGL(hybrid_fwd, dim3(grid), dim3(NTHR), LDS_BYTES, stream, a); }
#endif
}
```

```cpp
#include <hip/hip_runtime.h>
#include <hip/hip_cooperative_groups.h>
#include <cstdio>
#include <cstdint>
namespace cg = cooperative_groups;

#define DI __device__ __forceinline__
#define LAS __attribute__((address_space(3)))
typedef float f32x2 __attribute__((ext_vector_type(2)));
typedef __bf16 bf16x2_t __attribute__((ext_vector_type(2)));
typedef unsigned u32x2 __attribute__((ext_vector_type(2)));

constexpr int DM = 2048, TSEQ = 2048, NB = 4, TP = NB * TSEQ  , NSMP = 128, MV = TP + NSMP  , MP = 8448  ;
constexpr int HW = 1024, NH = 8, HD = 128, SW = 1024, SG = 64, SPC = 16, SN = 64, FF = 5632, NIN = 9216;
constexpr int C_Q = 0, C_F = 1024, C_I = 2048, C_OG = 3072, C_U = 4096, C_GA = 5120, C_GB = 7168;
constexpr float RMS_EPS = 1e-6f;
#ifndef MERGE_MID
#define MERGE_MID true
#endif

constexpr size_t MiB = 1u << 20;
constexpr size_t WS_R1 = 2 * MiB;
constexpr size_t WS_WIN = WS_R1, WS_XB = WS_R1 + 36 * MiB;
constexpr size_t WS_OL = WS_R1, WS_Z = WS_R1 + 32 * MiB;
constexpr size_t WS_X1 = WS_R1;
constexpr size_t WS_R2 = WS_R1 + 69 * MiB;
constexpr size_t WS_PB = WS_R2;
constexpr size_t WS_ACT = WS_R2, WS_X1B = WS_R2 + 91 * MiB;
constexpr size_t WS_R3 = WS_R2 + 148 * MiB + MiB / 2;
constexpr size_t WS_WGLU = WS_R3, WS_WCAT = WS_R3 + 4 * MiB, WS_WOUT = WS_R3 + 12 * MiB, WS_WUP = WS_R3 + 20 * MiB, WS_WDN = WS_R3 + 64 * MiB;
constexpr size_t WS_R4 = WS_R3 + 86 * MiB;
constexpr size_t WS_OAB = WS_R4, WS_MRG = WS_R4 + 33 * MiB;
constexpr size_t WS_USC = WS_MRG, WS_DSC = WS_MRG + 16 * MiB;
constexpr size_t WS_END = WS_R4 + 66 * MiB;
constexpr size_t WS_RS1 = 0, WS_LB = 192 * 1024, WS_SS2 = 64 * 1024, WS_SS3 = 128 * 1024, WS_PARA = 256 * 1024  , WS_PARB = 512 * 1024  , WS_PARC = 768 * 1024  ;

constexpr size_t WS_BAR = 1 * MiB, WS_BAR_BYTES = 16384;
constexpr int LDS_BAR_OFF = 131072 + 64;
constexpr int LDS_BYTES = 147456;

DI float bflo(unsigned u) { return __uint_as_float(u << 16); }
DI float bfhi(unsigned u) { return __uint_as_float(u & 0xffff0000u); }
DI float bf2f(unsigned short b) { return __uint_as_float((unsigned)b << 16); }
DI unsigned pk2(float lo, float hi) { f32x2 v = {lo, hi}; bf16x2_t b = __builtin_convertvector(v, bf16x2_t); return __builtin_bit_cast(unsigned, b); }
DI unsigned short f2bf(float f) { return (unsigned short)(pk2(f, 0.f) & 0xffffu); }
DI float fexp(float x) { return __expf(x); }
DI float sigm(float x) { return __builtin_amdgcn_rcpf(1.f + __expf(-x)); }
DI float wave_sum(float v) {
#pragma unroll
    for (int o = 1; o < 64; o <<= 1) v += __shfl_xor(v, o);
    return v;
}

namespace pg8 {
#define PG8_LAS __attribute__((address_space(3)))
typedef unsigned short bf16_t;
typedef short bf16x8 __attribute__((ext_vector_type(8)));
typedef float f32x4 __attribute__((ext_vector_type(4)));
typedef unsigned u32x4 __attribute__((ext_vector_type(4)));
constexpr int BM = 256, BK = 64, HALF = 128, HTB = HALF * BK * 2  , STAGE_BYTES = 8 * HTB, NXCD = 8, WGM = 8;

__host__ __device__ __forceinline__ int lds_byte(int r, int c) { const int st = (r >> 4) * 2 + (c >> 5), rr = r & 15, cc = c & 31, ob = rr * 64 + cc * 2; return st * 1024 + (ob ^ (((ob >> 9) & 1) << 5)); }
__host__ __device__ __forceinline__ void stage_rc(int b, int& R, int& C) { const int st = b / 1024, sb = b % 1024, swz = sb ^ (((sb >> 9) & 1) << 5); R = (st >> 1) * 16 + swz / 64; C = (st & 1) * 32 + (swz % 64) / 2; }
__host__ __device__ __forceinline__ int perm32(int rho) { const int n = rho >> 4, i = rho & 15; return 8 * (i >> 2) + 4 * n + (i & 3); }

struct Unit { int pm, pn, kh; };
struct Gemm { const bf16_t* A; const bf16_t* Bt; int M, N, K, KL; };

struct StaticOrder {
    int nM, nN, nwg, G, c;
    __host__ __device__ void init(int M, int N, int G_, int c_) { nM = M / BM; nN = N / BM; nwg = nM * nN; G = G_; c = c_; }
    __host__ __device__ bool next(int i, Unit& u) const {
        const long L = (long)i * G + c; if (L >= nwg) return false;
        int wgid = (int)L; { const int q = nwg / NXCD, r = nwg % NXCD, xcd = wgid % NXCD, off = wgid / NXCD; wgid = (xcd < r ? xcd * (q + 1) : r * (q + 1) + (xcd - r) * q) + off; }
        const int nig = WGM * nN, gid = wgid / nig, fm = gid * WGM, gsz = (nM - fm) < WGM ? (nM - fm) : WGM;
        u.pm = fm + ((wgid % nig) % gsz); u.pn = (wgid % nig) / gsz; u.kh = 0; return true;
    }
    __device__ __forceinline__ void a_ready(const Unit&) const {}
    __device__ __forceinline__ void done(const Unit&) const {}
};

struct HalvedOrder {
    StaticOrder so;
    __host__ __device__ void init(int M, int N, int G_, int c_) { so.init(M, N, G_, c_); }
    __host__ __device__ bool next(int i, Unit& u) const { if (!so.next(i >> 1, u)) return false; u.kh = i & 1; return true; }
    __device__ __forceinline__ void a_ready(const Unit&) const {}
    __device__ __forceinline__ void done(const Unit&) const {}
};
__device__ __forceinline__ u32x4 pack8(f32x4 v0, f32x4 v1) { u32x4 w; w.x = ::pk2(v0[0], v0[1]); w.y = ::pk2(v0[2], v0[3]); w.z = ::pk2(v1[0], v1[1]); w.w = ::pk2(v1[2], v1[3]); return w; }
__device__ __forceinline__ void unpack8(u32x4 w, f32x4& v0, f32x4& v1) { v0 = (f32x4){::bflo(w.x), ::bfhi(w.x), ::bflo(w.y), ::bfhi(w.y)}; v1 = (f32x4){::bflo(w.z), ::bfhi(w.z), ::bflo(w.w), ::bfhi(w.w)}; }
__device__ __forceinline__ f32x4 sig4(f32x4 x) { return (f32x4){::sigm(x[0]), ::sigm(x[1]), ::sigm(x[2]), ::sigm(x[3])}; }

struct EpiIn {
    static constexpr bool PERM = true, AFTER_DRAIN = false, HAS_MID = false;
    bf16_t* O; const float* rs; int ldc;
    __device__ __forceinline__ void operator()(const f32x4 (&acc)[2][2][4][2], const Unit& u, int wr, int wc, int fr, int fq) const {
        const int row0 = u.pm * BM + wr * 64 + fr, col0 = u.pn * BM + wc * 32 + 8 * fq;
#pragma unroll
        for (int ai = 0; ai < 2; ++ai)
#pragma unroll
            for (int m = 0; m < 4; ++m) { const int row = row0 + ai * HALF + m * 16; const float s = rs[row]; bf16_t* rowp = O + (size_t)row * ldc + col0;
#pragma unroll
                for (int bj = 0; bj < 2; ++bj) *(u32x4*)(rowp + bj * HALF) = pack8(acc[ai][bj][m][0] * s, acc[ai][bj][m][1] * s); }
    }
};
struct EpiGlu {
    static constexpr bool PERM = true, AFTER_DRAIN = false, HAS_MID = false;
    bf16_t* O; int ldc;
    __device__ __forceinline__ void operator()(const f32x4 (&acc)[2][2][4][2], const Unit& u, int wr, int wc, int fr, int fq) const {
        const int row0 = u.pm * BM + wr * 64 + fr, col0 = u.pn * HALF + wc * 32 + 8 * fq;
#pragma unroll
        for (int ai = 0; ai < 2; ++ai)
#pragma unroll
            for (int m = 0; m < 4; ++m) { const int row = row0 + ai * HALF + m * 16;
                *(u32x4*)(O + (size_t)row * ldc + col0) = pack8(acc[ai][0][m][0] * sig4(acc[ai][1][m][0]), acc[ai][0][m][1] * sig4(acc[ai][1][m][1])); }
    }
};
struct EpiMerge {
    static constexpr bool PERM = true, AFTER_DRAIN = false, HAS_MID = MERGE_MID;
    bf16_t* O; const bf16_t* P; int ldp; int cga, cgb; int ldc;
    __device__ __forceinline__ void mid(f32x4 (&acc)[2][2][4][2], const Unit& u, int wr, int wc, int fr, int fq) const {
        const int row0 = u.pm * BM + wr * 64 + fr, col0 = u.pn * BM + wc * 32 + 8 * fq;
#pragma unroll
        for (int ai = 0; ai < 2; ++ai)
#pragma unroll
            for (int m = 0; m < 4; ++m) { const int row = row0 + ai * HALF + m * 16; const bf16_t* pr = P + (size_t)row * ldp + col0;
#pragma unroll
                for (int bj = 0; bj < 2; ++bj) { f32x4 a0, a1, b0, b1; unpack8(*(const u32x4*)(pr + cga + bj * HALF), a0, a1); unpack8(*(const u32x4*)(pr + cgb + bj * HALF), b0, b1);
#pragma unroll
                    for (int i = 0; i < 4; ++i) { acc[ai][bj][m][0][i] *= (1.f + __expf(-b0[i])) * __builtin_amdgcn_rcpf(1.f + __expf(-a0[i])); acc[ai][bj][m][1][i] *= (1.f + __expf(-b1[i])) * __builtin_amdgcn_rcpf(1.f + __expf(-a1[i])); } }
                asm volatile("" ::: "memory"); }
    }
    __device__ __forceinline__ void operator()(const f32x4 (&acc)[2][2][4][2], const Unit& u, int wr, int wc, int fr, int fq) const {
        const int row0 = u.pm * BM + wr * 64 + fr, col0 = u.pn * BM + wc * 32 + 8 * fq;
#pragma unroll
        for (int ai = 0; ai < 2; ++ai)
#pragma unroll
            for (int m = 0; m < 4; ++m) { const int row = row0 + ai * HALF + m * 16; const bf16_t* pr = P + (size_t)row * ldp + col0 + cgb; bf16_t* rowp = O + (size_t)row * ldc + col0;
#pragma unroll
                for (int bj = 0; bj < 2; ++bj) { f32x4 b0, b1; unpack8(*(const u32x4*)(pr + bj * HALF), b0, b1);
                    *(u32x4*)(rowp + bj * HALF) = pack8(acc[ai][bj][m][0] * sig4(b0), acc[ai][bj][m][1] * sig4(b1)); }
                asm volatile("" ::: "memory"); }
    }
};
template <bool WRITE_BF16> struct EpiRes {
    static constexpr bool PERM = true, AFTER_DRAIN = false, HAS_MID = false;
    const float* base0; const float* base1; int split;
    float* out; bf16_t* ob; float* ss; int nvalid; int ldc;
    __device__ __forceinline__ void operator()(const f32x4 (&acc)[2][2][4][2], const Unit& u, int wr, int wc, int fr, int fq) const {
        const int row0 = u.pm * BM + wr * 64 + fr, col0 = u.pn * BM + wc * 32 + 8 * fq;
#pragma unroll
        for (int ai = 0; ai < 2; ++ai)
#pragma unroll
            for (int m = 0; m < 4; ++m) { const int row = row0 + ai * HALF + m * 16;
                if (row < nvalid) {
                    const float* bp = (row < split ? base0 + (size_t)row * ldc : base1 + (size_t)(row - split) * ldc) + col0; float* op = out + (size_t)row * ldc + col0; float s = 0.f;
#pragma unroll
                    for (int bj = 0; bj < 2; ++bj) { const f32x4 x0 = *(const f32x4*)(bp + bj * HALF), x1 = *(const f32x4*)(bp + bj * HALF + 4);
                        const f32x4 y0 = x0 + acc[ai][bj][m][0], y1 = x1 + acc[ai][bj][m][1];
                        *(f32x4*)(op + bj * HALF) = y0; *(f32x4*)(op + bj * HALF + 4) = y1;
                        if (WRITE_BF16) *(u32x4*)(ob + (size_t)row * ldc + col0 + bj * HALF) = pack8(y0, y1);
                        s += (y0[0] * y0[0] + y0[1] * y0[1]) + (y0[2] * y0[2] + y0[3] * y0[3]) + (y1[0] * y1[0] + y1[1] * y1[1]) + (y1[2] * y1[2] + y1[3] * y1[3]); }
                    s += __shfl_xor(s, 16); s += __shfl_xor(s, 32);
                    if (fq == 0) atomicAdd(ss + row, s);
                } }
    }
};
struct EpiSwiGlu {
    static constexpr bool PERM = true, AFTER_DRAIN = false, HAS_MID = false;
    bf16_t* O; const float* ss; int ldc;
    __device__ __forceinline__ void operator()(const f32x4 (&acc)[2][2][4][2], const Unit& u, int wr, int wc, int fr, int fq) const {
        const int row0 = u.pm * BM + wr * 64 + fr, col0 = u.pn * HALF + wc * 32 + 8 * fq;
#pragma unroll
        for (int ai = 0; ai < 2; ++ai)
#pragma unroll
            for (int m = 0; m < 4; ++m) { const int row = row0 + ai * HALF + m * 16; const float r = __builtin_amdgcn_rsqf(ss[row] * (1.0f / 2048.0f) + 1e-6f);
                const f32x4 a0 = acc[ai][0][m][0] * r, a1 = acc[ai][0][m][1] * r, b0 = acc[ai][1][m][0] * r, b1 = acc[ai][1][m][1] * r;
                *(u32x4*)(O + (size_t)row * ldc + col0) = pack8(a0 * sig4(a0) * b0, a1 * sig4(a1) * b1); }
    }
};
template <class Epi, class Sched, bool ALIGN_EPI = false, bool SP2 = false>
__device__ __forceinline__ void gemm_phase(PG8_LAS unsigned char* lds, const Gemm g, const Sched& S, const Epi& E) {
    const int tid = threadIdx.x, wid = __builtin_amdgcn_readfirstlane(tid >> 6), lane = tid & 63, wr = wid >> 2, wc = wid & 3, fr = lane & 15, fq = lane >> 4;
    const int K = g.K, nt = g.KL / BK; const size_t khb = (size_t)g.KL * 2;
    unsigned voffA[2], voffB[2];
#pragma unroll
    for (int i = 0; i < 2; ++i) { int R, C; stage_rc(tid * 16 + i * 8192, R, C); const int Rb = Epi::PERM ? ((R & ~31) + perm32(R & 31)) : R;
        voffA[i] = (unsigned)(R * K + C) * 2u; voffB[i] = (unsigned)(Rb * K + C) * 2u; }
    const size_t kstep = (size_t)(BK * 2);
    const size_t hstep = (size_t)HALF * K * 2;
    const size_t tstep = 2 * hstep;
    const unsigned ldsw = (unsigned)wid * 1024u;
    const int aoff = lds_byte(wr * 64 + fr, fq * 8), boff = lds_byte(wc * 32 + fr, fq * 8);
#define PG8_SA(b, h) (((b) * 2 + (h)) * HTB)
#define PG8_SB(b, h) ((4 + (b) * 2 + (h)) * HTB)
#define PG8_STAGE(bufoff, gbase, voff) do { _Pragma("unroll") for (int _i = 0; _i < 2; ++_i) \
        __builtin_amdgcn_global_load_lds((const unsigned*)((const char*)(gbase) + (voff)[_i]), (PG8_LAS unsigned*)(lds + (bufoff) + ldsw + _i * 8192), 16, 0, 0); } while (0)
#define PG8_LDA(dst, b, h) do { _Pragma("unroll") for (int m = 0; m < 4; ++m) _Pragma("unroll") for (int k = 0; k < 2; ++k) dst[m][k] = *(const PG8_LAS bf16x8*)(lds + PG8_SA(b, h) + aoff + m * 2048 + k * 1024); } while (0)
#define PG8_LDB(dst, b, h) do { _Pragma("unroll") for (int n = 0; n < 2; ++n) _Pragma("unroll") for (int k = 0; k < 2; ++k) dst[n][k] = *(const PG8_LAS bf16x8*)(lds + PG8_SB(b, h) + boff + n * 2048 + k * 1024); } while (0)
#define PG8_MMA(ai, bj, At, Bt) do { __builtin_amdgcn_s_setprio(1); _Pragma("unroll") for (int m = 0; m < 4; ++m) _Pragma("unroll") for (int n = 0; n < 2; ++n) _Pragma("unroll") for (int k = 0; k < 2; ++k) \
        acc[ai][bj][m][n] = __builtin_amdgcn_mfma_f32_16x16x32_bf16(Bt[n][k], At[m][k], acc[ai][bj][m][n], 0, 0, 0); __builtin_amdgcn_s_setprio(0); } while (0)
#define PG8_WAIT_V(n) asm volatile("s_waitcnt vmcnt(" #n ")" ::: "memory")
#define PG8_WAIT_L(n) asm volatile("s_waitcnt lgkmcnt(" #n ")" ::: "memory")
#define PG8_BAR __builtin_amdgcn_s_barrier()
#define PG8_SCHED __builtin_amdgcn_sched_barrier(0)
    Unit cur, nxt; int ui = 0;
    if (!S.next(0, cur)) return;
    f32x4 acc[2][2][4][2];
#pragma unroll
    for (int a = 0; a < 2; ++a)
#pragma unroll
        for (int b = 0; b < 2; ++b)
#pragma unroll
            for (int m = 0; m < 4; ++m)
#pragma unroll
                for (int n = 0; n < 2; ++n) acc[a][b][m][n] = (f32x4){0.f, 0.f, 0.f, 0.f};
    bf16x8 At[4][2], B0[2][2], B1[2][2];
    const char* cA = (const char*)g.A + (size_t)cur.pm * tstep + cur.kh * khb; const char* cB = (const char*)g.Bt + (size_t)cur.pn * tstep + cur.kh * khb;
    S.a_ready(cur);
    if constexpr (SP2) {
        PG8_STAGE(PG8_SB(0, 0), cB, voffB); PG8_STAGE(PG8_SB(0, 1), cB + hstep, voffB); PG8_STAGE(PG8_SA(0, 0), cA, voffA); PG8_STAGE(PG8_SA(0, 1), cA + hstep, voffA);
        if (wr == 1) PG8_BAR;
        PG8_WAIT_V(2); PG8_BAR;
        PG8_STAGE(PG8_SB(1, 0), cB + kstep, voffB); PG8_STAGE(PG8_SA(1, 0), cA + kstep, voffA); PG8_STAGE(PG8_SB(1, 1), cB + hstep + kstep, voffB);
        PG8_WAIT_V(6); PG8_BAR;
    } else {
        PG8_STAGE(PG8_SB(0, 0), cB, voffB); PG8_STAGE(PG8_SA(0, 0), cA, voffA); PG8_STAGE(PG8_SB(0, 1), cB + hstep, voffB); PG8_STAGE(PG8_SA(0, 1), cA + hstep, voffA);
        if (wr == 1) PG8_BAR;
        PG8_WAIT_V(4); PG8_BAR;
        PG8_STAGE(PG8_SB(1, 0), cB + kstep, voffB); PG8_STAGE(PG8_SA(1, 0), cA + kstep, voffA); PG8_STAGE(PG8_SB(1, 1), cB + hstep + kstep, voffB);
        PG8_WAIT_V(6); PG8_BAR;
    }
    for (;;) {
        const bool has_next = S.next(ui + 1, nxt);
        const char* nA = has_next ? (const char*)g.A + (size_t)nxt.pm * tstep + nxt.kh * khb : cA; const char* nB = has_next ? (const char*)g.Bt + (size_t)nxt.pn * tstep + nxt.kh * khb : cB;
        for (int t = 0; t < nt; t += 2) {
            const bool last = (t == nt - 2);
            const char* a1 = cA + (size_t)(t + 1) * kstep;
            const char* a2 = last ? nA : cA + (size_t)(t + 2) * kstep; const char* b2 = last ? nB : cB + (size_t)(t + 2) * kstep;
            const char* a3 = a2 + kstep; const char* b3 = b2 + kstep;
            if (last && has_next) S.a_ready(nxt);
            if constexpr (SP2) {
            PG8_LDB(B0, 0, 0); PG8_LDB(B1, 0, 1); PG8_SCHED; PG8_LDA(At, 0, 0); PG8_STAGE(PG8_SA(1, 1), a1 + hstep, voffA);
            PG8_WAIT_V(8); PG8_WAIT_L(0); PG8_BAR; PG8_MMA(0, 0, At, B0); PG8_MMA(0, 1, At, B1); PG8_BAR; PG8_SCHED;
            PG8_LDA(At, 0, 1); PG8_STAGE(PG8_SB(0, 0), b2, voffB); PG8_STAGE(PG8_SB(0, 1), b2 + hstep, voffB); PG8_STAGE(PG8_SA(0, 0), a2, voffA);
            PG8_WAIT_V(8); PG8_WAIT_L(0); PG8_BAR; PG8_MMA(1, 0, At, B0); PG8_MMA(1, 1, At, B1); PG8_BAR; PG8_SCHED;
            PG8_LDB(B0, 1, 0); PG8_LDB(B1, 1, 1); PG8_SCHED; PG8_LDA(At, 1, 0); PG8_STAGE(PG8_SA(0, 1), a2 + hstep, voffA);
            PG8_WAIT_V(8); PG8_WAIT_L(0); PG8_BAR; PG8_MMA(0, 0, At, B0); PG8_MMA(0, 1, At, B1); PG8_BAR; PG8_SCHED;
            PG8_LDA(At, 1, 1); PG8_STAGE(PG8_SB(1, 0), b3, voffB); PG8_STAGE(PG8_SB(1, 1), b3 + hstep, voffB); PG8_STAGE(PG8_SA(1, 0), a3, voffA);
            PG8_WAIT_V(8); PG8_WAIT_L(0); PG8_BAR; PG8_MMA(1, 0, At, B0); PG8_MMA(1, 1, At, B1); PG8_BAR; PG8_SCHED;
            } else {
            PG8_LDB(B0, 0, 0); PG8_SCHED; PG8_LDA(At, 0, 0); PG8_STAGE(PG8_SA(1, 1), a1 + hstep, voffA);
            PG8_WAIT_L(8); PG8_BAR; PG8_WAIT_L(0); PG8_MMA(0, 0, At, B0); PG8_BAR; PG8_SCHED;
            PG8_LDB(B1, 0, 1); PG8_STAGE(PG8_SB(0, 0), b2, voffB);
            PG8_BAR; PG8_WAIT_L(0); PG8_MMA(0, 1, At, B1); PG8_BAR;
            PG8_LDA(At, 0, 1); PG8_STAGE(PG8_SA(0, 0), a2, voffA);
            PG8_BAR; PG8_WAIT_L(0); PG8_MMA(1, 0, At, B0); PG8_BAR; PG8_SCHED;
            PG8_STAGE(PG8_SB(0, 1), b2 + hstep, voffB);
            PG8_WAIT_V(6); PG8_BAR; PG8_MMA(1, 1, At, B1); PG8_BAR;
            PG8_LDB(B0, 1, 0); PG8_SCHED; PG8_LDA(At, 1, 0); PG8_STAGE(PG8_SA(0, 1), a2 + hstep, voffA);
            PG8_WAIT_L(8); PG8_BAR; PG8_WAIT_L(0); PG8_MMA(0, 0, At, B0); PG8_BAR; PG8_SCHED;
            PG8_LDB(B1, 1, 1); PG8_STAGE(PG8_SB(1, 0), b3, voffB);
            PG8_BAR; PG8_WAIT_L(0); PG8_MMA(0, 1, At, B1); PG8_BAR;
            PG8_LDA(At, 1, 1); PG8_STAGE(PG8_SA(1, 0), a3, voffA);
            PG8_BAR; PG8_WAIT_L(0); PG8_MMA(1, 0, At, B0); PG8_BAR; PG8_SCHED;
            PG8_STAGE(PG8_SB(1, 1), b3 + hstep, voffB);
            PG8_WAIT_V(6); PG8_BAR; PG8_MMA(1, 1, At, B1); PG8_BAR;
            }
        }
        if constexpr (ALIGN_EPI) { if (wr == 0) PG8_BAR; }
        bool keep = false;
        if constexpr (Epi::HAS_MID) { if (cur.kh == 0) { E.mid(acc, cur, wr, wc, fr, fq); keep = true; } }
        if (!keep) { if constexpr (!Epi::AFTER_DRAIN) { E(acc, cur, wr, wc, fr, fq); S.done(cur); } }
        if (!has_next) break;
        if (!keep) {
#pragma unroll
        for (int a = 0; a < 2; ++a)
#pragma unroll
            for (int b = 0; b < 2; ++b)
#pragma unroll
                for (int m = 0; m < 4; ++m)
#pragma unroll
                    for (int n = 0; n < 2; ++n) acc[a][b][m][n] = (f32x4){0.f, 0.f, 0.f, 0.f};
        }
        cur = nxt; cA = nA; cB = nB; ++ui;
        if constexpr (ALIGN_EPI) { if (wr == 1) PG8_BAR; }
    }
    PG8_WAIT_V(0);
    if constexpr (!ALIGN_EPI) { if (wr == 0) PG8_BAR; }
    PG8_BAR;
    if constexpr (Epi::AFTER_DRAIN) { E.fused(acc, cur, wr, wc, fr, fq, lds, wid, lane); S.done(cur); }
#undef PG8_SA
#undef PG8_SB
#undef PG8_STAGE
#undef PG8_LDA
#undef PG8_LDB
#undef PG8_MMA
#undef PG8_WAIT_V
#undef PG8_WAIT_L
#undef PG8_BAR
#undef PG8_SCHED
}
}

typedef unsigned short bf16;
typedef unsigned v4u __attribute__((ext_vector_type(4)));
typedef float f32x4 __attribute__((ext_vector_type(4)));
typedef short bf16x8 __attribute__((ext_vector_type(8)));
constexpr int NWAVES = 8, NTHR = 512;
#define MFMA16(a, b, c) __builtin_amdgcn_mfma_f32_16x16x32_bf16((a), (b), (c), 0, 0, 0)
#define LDS_FENCE() asm volatile("s_waitcnt lgkmcnt(0)" ::: "memory")

struct Args {
    const float* in[25]; float* out; unsigned char* ws; int ph_lo, ph_hi;
};
struct Frame {
    LAS unsigned char* lds; int tid, lane, wave, G, bid;
    const float* in[25]; float* out; unsigned char* ws;
};
constexpr size_t O_YP = 0, O_YS = (size_t)TP * DM, O_HP = O_YS + (size_t)NSMP * DM, O_S5RP = O_HP + (size_t)NB * NH * HD * HD, O_S5IP = O_S5RP + NB * SG * SN,
                 O_HS = O_S5IP + NB * SG * SN, O_S5RS = O_HS + (size_t)NSMP * NH * HD * HD, O_S5IS = O_S5RS + (size_t)NSMP * SG * SN, O_END = O_S5IS + (size_t)NSMP * SG * SN;
enum { I_XP = 0, I_XS, I_SH, I_SRE, I_SIM, I_LB, I_N1, I_WIN, I_HG, I_LRE, I_LIM, I_LDT, I_BRE, I_BIM, I_CRE, I_CIM, I_D, I_WGLU, I_WPA, I_WPB, I_WOUT, I_N2, I_WUP, I_WDN, I_NF };

DI void p0_transpose_item(const float* W, int K, int N, bf16* WT, int ldk, int koff, int glu_half, const float* gk, LAS float* scr, int item, int lane) {
    const int nblk = N / 32, kb = item / nblk, nb = item % nblk, k0 = 64 * kb, n0 = 32 * nb;
    int d0 = n0;
    if (glu_half) { const int hf = n0 >= glu_half ? 1 : 0, nn = n0 - hf * glu_half; d0 = (nn / 128) * 256 + hf * 128 + (nn % 128); }
    f32x4 v[8];
#pragma unroll
    for (int i = 0; i < 8; ++i) v[i] = *(const f32x4*)(W + (size_t)(k0 + i * 8 + (lane >> 3)) * N + n0 + 4 * (lane & 7));
#pragma unroll
    for (int i = 0; i < 8; ++i) { const int kk = i * 8 + (lane >> 3); const float gs = gk ? gk[k0 + kk] : 1.0f; LAS float* d = scr + kk * 33 + 4 * (lane & 7);
        d[0] = v[i].x * gs; d[1] = v[i].y * gs; d[2] = v[i].z * gs; d[3] = v[i].w * gs; }
    LDS_FENCE();
    const int c = lane & 7;
#pragma unroll
    for (int j = 0; j < 4; ++j) { const int n = (lane >> 3) + 8 * j; const LAS float* s = scr + (8 * c) * 33 + n;
        v4u o; o.x = pk2(s[0 * 33], s[1 * 33]); o.y = pk2(s[2 * 33], s[3 * 33]); o.z = pk2(s[4 * 33], s[5 * 33]); o.w = pk2(s[6 * 33], s[7 * 33]);
        *(v4u*)(WT + (size_t)(d0 + n) * ldk + koff + k0 + 8 * c) = o; }
    LDS_FENCE();
}
DI double exp_d(double x) {
    const double k = __builtin_rint(x * 1.4426950408889634); const double r = (x - k * 0.693147180369123816490e+00) - k * 1.90821492927058770002e-10;
    double p = 1.0 / 6227020800.0;
    p = p * r + 1.0 / 479001600.0; p = p * r + 1.0 / 39916800.0; p = p * r + 1.0 / 3628800.0; p = p * r + 1.0 / 362880.0; p = p * r + 1.0 / 40320.0; p = p * r + 1.0 / 5040.0;
    p = p * r + 1.0 / 720.0; p = p * r + 1.0 / 120.0; p = p * r + 1.0 / 24.0; p = p * r + 1.0 / 6.0; p = p * r + 0.5; p = p * r + 1.0; p = p * r + 1.0;
    const long long ki = (long long)k; const double sc = __builtin_bit_cast(double, (unsigned long long)(1023 + ki) << 52);
    return p * sc;
}
DI void sincos_d(double x, double& s, double& c) {
    const double k = __builtin_rint(x * 0.15915494309189535); double r = (x - k * 6.28318530717958623200e+00) - k * 2.44929359829470635445e-16;
    const double q = r * 0.25, q2 = q * q;
    double sp = -1.0 / 1307674368000.0; sp = sp * q2 + 1.0 / 6227020800.0; sp = sp * q2 - 1.0 / 39916800.0; sp = sp * q2 + 1.0 / 362880.0; sp = sp * q2 - 1.0 / 5040.0; sp = sp * q2 + 1.0 / 120.0; sp = sp * q2 - 1.0 / 6.0; sp = sp * q2 + 1.0;
    double cp = 1.0 / 20922789888000.0; cp = cp * q2 - 1.0 / 87178291200.0; cp = cp * q2 + 1.0 / 479001600.0; cp = cp * q2 - 1.0 / 3628800.0; cp = cp * q2 + 1.0 / 40320.0; cp = cp * q2 - 1.0 / 720.0; cp = cp * q2 + 1.0 / 24.0; cp = cp * q2 - 0.5; cp = cp * q2 + 1.0;
    double s1 = sp * q, c1 = cp;
    double s2 = 2.0 * s1 * c1, c2 = c1 * c1 - s1 * s1;
    s = 2.0 * s2 * c2; c = c2 * c2 - s2 * s2;
}
DI void p0_prologue(Frame& F) {
    LAS float* scr = (LAS float*)(F.lds + F.wave * 16384);
    const int gw = F.bid * NWAVES + F.wave, NGW = F.G * NWAVES;
    bf16* Win_t = (bf16*)(F.ws + WS_WIN); bf16* Wglu_t = (bf16*)(F.ws + WS_WGLU); bf16* Wcat_t = (bf16*)(F.ws + WS_WCAT); bf16* Wout_t = (bf16*)(F.ws + WS_WOUT);
    bf16* Wup_t = (bf16*)(F.ws + WS_WUP); bf16* Wdn_t = (bf16*)(F.ws + WS_WDN);
    constexpr int IT_IN = (DM / 64) * (NIN / 32), IT_GLU = (SW / 64) * (2 * SW / 32), IT_PA = (HW / 64) * (DM / 32), IT_PB = (SW / 64) * (DM / 32), IT_OUT = (DM / 64) * (DM / 32),
                  IT_UP = (DM / 64) * (2 * FF / 32), IT_DN = (FF / 64) * (DM / 32), NITEMS = IT_IN + IT_GLU + IT_PA + IT_PB + IT_OUT + IT_UP + IT_DN;
    for (int it = gw; it < NITEMS; it += NGW) {
        int r = it;
        if (r < IT_UP) { p0_transpose_item(F.in[I_WUP], DM, 2 * FF, Wup_t, DM, 0, FF, F.in[I_N2], scr, r, F.lane); continue; } r -= IT_UP;
        if (r < IT_IN) { p0_transpose_item(F.in[I_WIN], DM, NIN, Win_t, DM, 0, 0, F.in[I_N1], scr, r, F.lane); continue; } r -= IT_IN;
        if (r < IT_DN) { p0_transpose_item(F.in[I_WDN], FF, DM, Wdn_t, FF, 0, 0, nullptr, scr, r, F.lane); continue; } r -= IT_DN;
        if (r < IT_OUT) { p0_transpose_item(F.in[I_WOUT], DM, DM, Wout_t, DM, 0, 0, nullptr, scr, r, F.lane); continue; } r -= IT_OUT;
        if (r < IT_GLU) { p0_transpose_item(F.in[I_WGLU], SW, 2 * SW, Wglu_t, SW, 0, SW, nullptr, scr, r, F.lane); continue; } r -= IT_GLU;
        if (r < IT_PA) { p0_transpose_item(F.in[I_WPA], HW, DM, Wcat_t, 2048, 0, 0, nullptr, scr, r, F.lane); continue; } r -= IT_PA;
        p0_transpose_item(F.in[I_WPB], SW, DM, Wcat_t, 2048, 1024, 0, nullptr, scr, r, F.lane);
    }
    bf16* xb = (bf16*)(F.ws + WS_XB); float* rs1 = (float*)(F.ws + WS_RS1);
    for (int m = gw; m < MP; m += NGW) {
        unsigned long long* o8 = (unsigned long long*)(xb + (size_t)m * DM) + F.lane;
        if (m < MV) {
            const float* xr = m < TP ? F.in[I_XP] + (size_t)m * DM : F.in[I_XS] + (size_t)(m - TP) * DM;
            const f32x4* x4 = (const f32x4*)xr + F.lane; f32x4 v[8]; float s = 0.f;
#pragma unroll
            for (int j = 0; j < 8; ++j) { v[j] = x4[64 * j]; s += (v[j].x * v[j].x + v[j].y * v[j].y) + (v[j].z * v[j].z + v[j].w * v[j].w); }
            s = wave_sum(s);
            if (F.lane == 0) rs1[m] = 1.0f / sqrtf(s * (1.0f / DM) + RMS_EPS);
#pragma unroll
            for (int j = 0; j < 8; ++j) o8[64 * j] = (unsigned long long)pk2(v[j].x, v[j].y) | ((unsigned long long)pk2(v[j].z, v[j].w) << 32);
        } else {
            if (F.lane == 0) rs1[m] = 0.f;
#pragma unroll
            for (int j = 0; j < 8; ++j) o8[64 * j] = 0ull;
        }
    }
    { float* ss2 = (float*)(F.ws + WS_SS2); float* ss3 = (float*)(F.ws + WS_SS3); float* lb = (float*)(F.ws + WS_LB);
      for (int i = F.bid * NTHR + F.tid; i < MP; i += F.G * NTHR) { ss2[i] = 0.f; ss3[i] = 0.f; }
      for (int i = F.bid * NTHR + F.tid; i < HW; i += F.G * NTHR) { const float l0 = F.in[I_LB][i], l1 = F.in[I_LB][HW + i]; lb[i] = 1.0f / (1.0f + expf(l1 - l0)); } }
    for (int g = gw; g < SG; g += NGW) {
        const int n = F.lane;
        const double dt = exp_d((double)F.in[I_LDT][g]);
        const double lr = (double)F.in[I_LRE][g * SN + n], li = (double)F.in[I_LIM][g * SN + n];
        const double mag = exp_d(lr * dt); double sn, cs; sincos_d(li * dt, sn, cs);
        const double are = mag * cs, aim = mag * sn, den = lr * lr + li * li, nr = are - 1.0, ni = aim;
        const double zre = (nr * lr + ni * li) / den, zim = (ni * lr - nr * li) / den;
        double pr = are, pi = aim;
#pragma unroll 1
        for (int i = 0; i < 8; ++i) { const double t = pr * pr - pi * pi; pi = 2.0 * pr * pi; pr = t; }
        float* pa = (float*)(F.ws + WS_PARA) + (size_t)g * 256;
        pa[n] = (float)are; pa[64 + n] = (float)aim; pa[128 + n] = (float)pr; pa[192 + n] = (float)pi;
        bf16* pb = (bf16*)(F.ws + WS_PARB) + (size_t)g * 2048;
        const float* Bre = F.in[I_BRE] + ((size_t)g * SN + n) * SPC; const float* Bim = F.in[I_BIM] + ((size_t)g * SN + n) * SPC;
#pragma unroll
        for (int p = 0; p < SPC; ++p) { const double br = (double)Bre[p], bi = (double)Bim[p];
            pb[n * 16 + p] = f2bf((float)(zre * br - zim * bi)); pb[(64 + n) * 16 + p] = f2bf((float)(zre * bi + zim * br)); }
        bf16* pc = (bf16*)(F.ws + WS_PARC) + (size_t)g * 2048;
#pragma unroll
        for (int p = 0; p < SPC; ++p) { pc[p * 128 + n] = f2bf(F.in[I_CRE][((size_t)g * SPC + p) * SN + n]); pc[p * 128 + 64 + n] = f2bf(-F.in[I_CIM][((size_t)g * SPC + p) * SN + n]); }
    }
}

DI float gelu1(float v) {
    const float av = fabsf(v), t = __builtin_amdgcn_rcpf(av * 0.2316418882f + 1.0f);
    float q = t * 0.5307027145f + (-0.7265760135f); q = q * t + 0.7107068705f; q = q * t + (-0.142248368f); q = q * t + 0.127414796f; q = q * t;
    const float e = __builtin_amdgcn_exp2f((v * v) * (-0.72134752044f));
    const float m = v * (q * e);
    return v < 0.f ? m : v - m;
}

constexpr int S5_BU_STRIDE = 132  , S5_H_STRIDE = 272  , S5_WAVE_BYTES = 16 * S5_BU_STRIDE * 4 + 16 * S5_H_STRIDE  , S5_HE_OFF = 8 * S5_WAVE_BYTES;
DI void s5_prompt_unit(Frame& F, int unit) {
    const int b = unit >> 6, g = unit & 63, lane = F.lane, w = F.wave, r16 = lane & 15, q4 = lane >> 4;
    LAS float* BU = (LAS float*)(F.lds + w * S5_WAVE_BYTES);
    LAS unsigned char* Hb = F.lds + w * S5_WAVE_BYTES + 16 * S5_BU_STRIDE * 4;
    LAS float* HE = (LAS float*)(F.lds + S5_HE_OFF);
    const bf16* Pb = (const bf16*)(F.ws + WS_PB);
    const float* pa = (const float*)(F.ws + WS_PARA) + (size_t)g * 256;
    const float ar = pa[lane], ai = pa[64 + lane], a256r = pa[128 + lane], a256i = pa[192 + lane];
    const bf16* pb = (const bf16*)(F.ws + WS_PARB) + (size_t)g * 2048; const bf16* pc = (const bf16*)(F.ws + WS_PARC) + (size_t)g * 2048;
    bf16x8 Bf[8], Cf[4];
    const bf16x8 zero8 = {0, 0, 0, 0, 0, 0, 0, 0};
#pragma unroll
    for (int nb = 0; nb < 8; ++nb) Bf[nb] = q4 < 2 ? *(const bf16x8*)(pb + (nb * 16 + r16) * 16 + 8 * q4) : zero8;
#pragma unroll
    for (int ks = 0; ks < 4; ++ks) Cf[ks] = *(const bf16x8*)(pc + r16 * 128 + ks * 32 + 8 * q4);
    const float dsk = F.in[I_D][g * 16 + r16];
    const size_t row0 = (size_t)b * TSEQ + w * 256;
    const bf16* ucol = Pb + C_U + g * 16;
    float hr = 0.f, hi = 0.f;
#pragma unroll 1
    for (int pass = 0; pass < 2; ++pass) {
        if (pass == 1) {
            HE[w * 128 + lane] = hr; HE[w * 128 + 64 + lane] = hi;
            __syncthreads();
            float cr = 0.f, ci = 0.f;
            for (int j = 0; j < w; ++j) { const float er = HE[j * 128 + lane], ei = HE[j * 128 + 64 + lane]; const float t = a256r * cr - a256i * ci + er; ci = a256r * ci + a256i * cr + ei; cr = t; }
            if (w == 7) { const float fr_ = a256r * cr - a256i * ci + hr, fi_ = a256r * ci + a256i * cr + hi;
                F.out[O_S5RP + ((size_t)b * SG + g) * SN + lane] = fr_; F.out[O_S5IP + ((size_t)b * SG + g) * SN + lane] = fi_; }
            hr = cr; hi = ci;
        }
#pragma unroll 1
        for (int tile = 0; tile < 16; ++tile) {
            const size_t trow = row0 + tile * 16;
            const bf16x8 uf = q4 < 2 ? *(const bf16x8*)(ucol + (trow + r16) * NIN + 8 * q4) : zero8;
#pragma unroll
            for (int nb = 0; nb < 8; ++nb) { f32x4 a = {0.f, 0.f, 0.f, 0.f}; a = MFMA16(uf, Bf[nb], a);
#pragma unroll
                for (int i = 0; i < 4; ++i) BU[(4 * q4 + i) * S5_BU_STRIDE + nb * 16 + r16] = a[i]; }
            LDS_FENCE();
            if (pass == 0) {
#pragma unroll
                for (int tt = 0; tt < 16; ++tt) { const float br = BU[tt * S5_BU_STRIDE + lane], bi = BU[tt * S5_BU_STRIDE + 64 + lane];
                    const float t = ar * hr - ai * hi + br; hi = ar * hi + ai * hr + bi; hr = t; }
                LDS_FENCE();
            } else {
#pragma unroll
                for (int tt = 0; tt < 16; ++tt) { const float br = BU[tt * S5_BU_STRIDE + lane], bi = BU[tt * S5_BU_STRIDE + 64 + lane];
                    const float t = ar * hr - ai * hi + br; hi = ar * hi + ai * hr + bi; hr = t;
                    *(LAS unsigned short*)(Hb + tt * S5_H_STRIDE + lane * 2) = f2bf(hr); *(LAS unsigned short*)(Hb + tt * S5_H_STRIDE + 128 + lane * 2) = f2bf(hi); }
                LDS_FENCE();
                f32x4 y = {0.f, 0.f, 0.f, 0.f};
#pragma unroll
                for (int ks = 0; ks < 4; ++ks) { const bf16x8 hf = *(const LAS bf16x8*)(Hb + r16 * S5_H_STRIDE + (ks * 32 + 8 * q4) * 2); y = MFMA16(hf, Cf[ks], y); }
                bf16* Z = (bf16*)(F.ws + WS_Z);
#pragma unroll
                for (int i = 0; i < 4; ++i) { const size_t rr = trow + 4 * q4 + i; const float uv = bf2f(ucol[rr * NIN + r16]);
                    Z[rr * SW + g * 16 + r16] = f2bf(gelu1(y[i] + dsk * uv)); }
                LDS_FENCE();
            }
        }
    }
    __syncthreads();
}
DI void s5_sample_wave(Frame& F, int bs, int g) {
    const int lane = F.lane, r16 = lane & 15, q4 = lane >> 4;
    LAS float* hv = (LAS float*)(F.lds + F.wave * 512);
    const float* pa = (const float*)(F.ws + WS_PARA) + (size_t)g * 256; const float ar = pa[lane], ai = pa[64 + lane];
    const bf16* pb = (const bf16*)(F.ws + WS_PARB) + (size_t)g * 2048;
    const bf16* urow = (const bf16*)(F.ws + WS_PB) + (size_t)(TP + bs) * NIN + C_U + g * 16;
    const v4u u0 = *(const v4u*)urow, u1 = *(const v4u*)(urow + 8);
    const v4u bre0 = *(const v4u*)(pb + lane * 16), bre1 = *(const v4u*)(pb + lane * 16 + 8), bim0 = *(const v4u*)(pb + (64 + lane) * 16), bim1 = *(const v4u*)(pb + (64 + lane) * 16 + 8);
    float br = 0.f, bi = 0.f;
#define S5ACC(uw, rw, iw) { br += bflo(uw) * bflo(rw) + bfhi(uw) * bfhi(rw); bi += bflo(uw) * bflo(iw) + bfhi(uw) * bfhi(iw); }
    S5ACC(u0.x, bre0.x, bim0.x) S5ACC(u0.y, bre0.y, bim0.y) S5ACC(u0.z, bre0.z, bim0.z) S5ACC(u0.w, bre0.w, bim0.w)
    S5ACC(u1.x, bre1.x, bim1.x) S5ACC(u1.y, bre1.y, bim1.y) S5ACC(u1.z, bre1.z, bim1.z) S5ACC(u1.w, bre1.w, bim1.w)
#undef S5ACC
    const size_t so = ((size_t)bs * SG + g) * SN + lane;
    const float h0r = F.in[I_SRE][so], h0i = F.in[I_SIM][so];
    const float hr = ar * h0r - ai * h0i + br, hi = ar * h0i + ai * h0r + bi;
    F.out[O_S5RS + so] = hr; F.out[O_S5IS + so] = hi;
    hv[lane] = hr; hv[64 + lane] = hi;
    LDS_FENCE();
    const float* cre = F.in[I_CRE] + ((size_t)g * SPC + r16) * SN + 16 * q4; const float* cim = F.in[I_CIM] + ((size_t)g * SPC + r16) * SN + 16 * q4;
    float y = 0.f;
#pragma unroll
    for (int j = 0; j < 16; ++j) y += cre[j] * hv[16 * q4 + j] - cim[j] * hv[64 + 16 * q4 + j];
    y += __shfl_xor(y, 16); y += __shfl_xor(y, 32);
    const float uv = bf2f(urow[r16]);
    if (q4 == 0) ((bf16*)(F.ws + WS_Z))[(size_t)(TP + bs) * SW + g * 16 + r16] = f2bf(gelu1(y + F.in[I_D][g * 16 + r16] * uv));
    LDS_FENCE();
}

constexpr int HQ_STRIDE = 272, HK_STRIDE = 80;
constexpr int L_QT = 0, L_KT = 8704, L_QIN = 17408, L_KU = 26112, L_VT = 36352, L_ST = 46592, L_SC = 81408, L_PT = 83968, L_G16 = 88064, L_DEC = 88576, L_HG_END = 89088;
template <bool dry> DI void hgrn_local_unit(Frame& F, int unit) {
    const int b = unit >> 6, h = (unit >> 3) & 7, sc = unit & 7, lane = F.lane, w = F.wave, r16 = lane & 15, q4 = lane >> 4;
    LAS unsigned char* L = F.lds;
    bf16* Pb = (bf16*)(F.ws + WS_PB);
    float* OL = (float*)(F.ws + WS_OL);
    const float* lbp = (const float*)(F.ws + WS_LB) + h * HD + 2 * lane;
    const float lb0 = lbp[0], lb1 = lbp[1];
    const size_t urow0 = (size_t)b * TSEQ + sc * 256;
    f32x4 S[8];
#pragma unroll
    for (int kb = 0; kb < 8; ++kb) S[kb] = (f32x4){0.f, 0.f, 0.f, 0.f};
#pragma unroll
    for (int kb = 0; kb < 8; ++kb) *(LAS u32x2*)(L + L_ST + (w * 16 + r16) * HQ_STRIDE + (kb * 16 + 4 * q4) * 2) = (u32x2){0u, 0u};
    float Bp0 = 0.f, Bp1 = 0.f;
    unsigned qn[4], fn[4], vn[4];
#pragma unroll
    for (int j = 0; j < 4; ++j) { const bf16* rp = Pb + (urow0 + 4 * w + j) * NIN + h * HD + 2 * lane; qn[j] = *(const unsigned*)(rp + C_Q); fn[j] = *(const unsigned*)(rp + C_F); vn[j] = *(const unsigned*)(rp + C_I); }
#pragma unroll 1
    for (int c = 0; c < 8; ++c) {
        const size_t t0 = urow0 + c * 32;
        unsigned qc[4], fc[4], vc[4];
#pragma unroll
        for (int j = 0; j < 4; ++j) { qc[j] = qn[j]; fc[j] = fn[j]; vc[j] = vn[j]; }
        if (c < 7) {
#pragma unroll
            for (int j = 0; j < 4; ++j) { const bf16* rp = Pb + (t0 + 32 + 4 * w + j) * NIN + h * HD + 2 * lane; qn[j] = *(const unsigned*)(rp + C_Q); fn[j] = *(const unsigned*)(rp + C_F); vn[j] = *(const unsigned*)(rp + C_I); }
        }
        float kk0[4], kk1[4], cu0[4], cu1[4]; float g16a = 0.f, g16b = 0.f;
        { float c0 = 0.f, c1 = 0.f;
#pragma unroll
          for (int j = 0; j < 4; ++j) { const float f0 = lb0 + (1.f - lb0) * sigm(bflo(fc[j])), f1 = lb1 + (1.f - lb1) * sigm(bfhi(fc[j]));
              const float g0 = __logf(f0), g1 = __logf(f1); kk0[j] = 1.f - f0; kk1[j] = 1.f - f1; c0 += g0; c1 += g1; cu0[j] = c0; cu1[j] = c1; if (j == 0) { g16a = g0; g16b = g1; } } }
        *(LAS f32x2*)(L + L_PT + (w * 128 + 2 * lane) * 4) = (f32x2){cu0[3], cu1[3]};
        if (w == 4) *(LAS f32x2*)(L + L_G16 + 2 * lane * 4) = (f32x2){g16a, g16b};
        __syncthreads();
        float pre0 = 0.f, pre1 = 0.f, tot0 = 0.f, tot1 = 0.f, mid0 = 0.f, mid1 = 0.f;
#pragma unroll
        for (int j = 0; j < 8; ++j) { const f32x2 p = *(const LAS f32x2*)(L + L_PT + (j * 128 + 2 * lane) * 4); tot0 += p.x; tot1 += p.y; if (j < w) { pre0 += p.x; pre1 += p.y; } if (j < 4) { mid0 += p.x; mid1 += p.y; } }
        { const f32x2 p = *(const LAS f32x2*)(L + L_G16 + 2 * lane * 4); mid0 += p.x; mid1 += p.y; }
        unsigned ku0[2], ku1[2], vt0[2], vt1[2];
        { float kuA[4], kuB[4];
#pragma unroll
          for (int j = 0; j < 4; ++j) {
              const float b0 = pre0 + cu0[j], b1 = pre1 + cu1[j]; const float q0 = bflo(qc[j]), q1 = bfhi(qc[j]);
              const int trow = 4 * w + j;
              *(LAS unsigned*)(L + L_QT + trow * HQ_STRIDE + lane * 4) = pk2(q0 * fexp(b0 - mid0), q1 * fexp(b1 - mid1));
              *(LAS unsigned*)(L + L_KT + trow * HQ_STRIDE + lane * 4) = pk2(kk0[j] * fexp(mid0 - b0), kk1[j] * fexp(mid1 - b1));
              *(LAS unsigned*)(L + L_QIN + trow * HQ_STRIDE + lane * 4) = pk2(q0 * fexp(b0), q1 * fexp(b1));
              kuA[j] = kk0[j] * fexp(tot0 - b0); kuB[j] = kk1[j] * fexp(tot1 - b1);
              if (!dry) *(unsigned*)(Pb + (t0 + trow) * NIN + C_Q + h * HD + 2 * lane) = pk2(q0 * fexp(Bp0 + b0), q1 * fexp(Bp1 + b1));
          }
          ku0[0] = pk2(kuA[0], kuA[1]); ku0[1] = pk2(kuA[2], kuA[3]); ku1[0] = pk2(kuB[0], kuB[1]); ku1[1] = pk2(kuB[2], kuB[3]); }
        vt0[0] = (vc[0] & 0xffffu) | (vc[1] << 16); vt0[1] = (vc[2] & 0xffffu) | (vc[3] << 16);
        vt1[0] = (vc[0] >> 16) | (vc[1] & 0xffff0000u); vt1[1] = (vc[2] >> 16) | (vc[3] & 0xffff0000u);
        *(LAS u32x2*)(L + L_KU + (2 * lane) * HK_STRIDE + 8 * w) = (u32x2){ku0[0], ku0[1]};
        *(LAS u32x2*)(L + L_KU + (2 * lane + 1) * HK_STRIDE + 8 * w) = (u32x2){ku1[0], ku1[1]};
        *(LAS u32x2*)(L + L_VT + (2 * lane) * HK_STRIDE + 8 * w) = (u32x2){vt0[0], vt0[1]};
        *(LAS u32x2*)(L + L_VT + (2 * lane + 1) * HK_STRIDE + 8 * w) = (u32x2){vt1[0], vt1[1]};
        if (w == 0) *(LAS f32x2*)(L + L_DEC + 2 * lane * 4) = (f32x2){fexp(tot0), fexp(tot1)};
        Bp0 += tot0; Bp1 += tot1;
        __syncthreads();
        if (w < 3) {
            const int tb = w == 0 ? 0 : 1, sb = w == 2 ? 1 : 0;
            f32x4 a = {0.f, 0.f, 0.f, 0.f};
#pragma unroll
            for (int ks = 0; ks < 4; ++ks) { const bf16x8 af = *(const LAS bf16x8*)(L + L_QT + (tb * 16 + r16) * HQ_STRIDE + (ks * 32 + 8 * q4) * 2), bf = *(const LAS bf16x8*)(L + L_KT + (sb * 16 + r16) * HQ_STRIDE + (ks * 32 + 8 * q4) * 2); a = MFMA16(af, bf, a); }
#pragma unroll
            for (int i = 0; i < 4; ++i) { const int t = tb * 16 + 4 * q4 + i, s = sb * 16 + r16; *(LAS unsigned short*)(L + L_SC + t * HK_STRIDE + s * 2) = s <= t ? f2bf(a[i]) : (unsigned short)0; }
        } else if (w == 3) {
#pragma unroll
            for (int i = 0; i < 4; ++i) *(LAS unsigned short*)(L + L_SC + (4 * q4 + i) * HK_STRIDE + (16 + r16) * 2) = (unsigned short)0;
        }
        __syncthreads();
        const bf16x8 vtf = *(const LAS bf16x8*)(L + L_VT + (w * 16 + r16) * HK_STRIDE + 16 * q4);
        bf16x8 stf[4];
#pragma unroll
        for (int ks = 0; ks < 4; ++ks) stf[ks] = *(const LAS bf16x8*)(L + L_ST + (w * 16 + r16) * HQ_STRIDE + (ks * 32 + 8 * q4) * 2);
#pragma unroll
        for (int tb = 0; tb < 2; ++tb) {
            f32x4 o = {0.f, 0.f, 0.f, 0.f};
            { const bf16x8 sf = *(const LAS bf16x8*)(L + L_SC + (tb * 16 + r16) * HK_STRIDE + 16 * q4); o = MFMA16(sf, vtf, o); }
#pragma unroll
            for (int ks = 0; ks < 4; ++ks) { const bf16x8 qf = *(const LAS bf16x8*)(L + L_QIN + (tb * 16 + r16) * HQ_STRIDE + (ks * 32 + 8 * q4) * 2); o = MFMA16(qf, stf[ks], o); }
#pragma unroll
            for (int i = 0; i < 4; ++i) OL[(t0 + tb * 16 + 4 * q4 + i) * HW + h * HD + w * 16 + r16] = o[i];
        }
#pragma unroll
        for (int kb = 0; kb < 8; ++kb) {
            const f32x4 d = *(const LAS f32x4*)(L + L_DEC + (kb * 16 + 4 * q4) * 4);
            const bf16x8 kf = *(const LAS bf16x8*)(L + L_KU + (kb * 16 + r16) * HK_STRIDE + 16 * q4);
            S[kb] = MFMA16(kf, vtf, S[kb] * d);
            *(LAS u32x2*)(L + L_ST + (w * 16 + r16) * HQ_STRIDE + (kb * 16 + 4 * q4) * 2) = (u32x2){pk2(S[kb][0], S[kb][1]), pk2(S[kb][2], S[kb][3])};
        }
    }
    float* USC = (float*)(F.ws + WS_USC) + (size_t)unit * HD * HD; float* DSC = (float*)(F.ws + WS_DSC) + (size_t)unit * HD;
#pragma unroll
    for (int kb = 0; kb < 8; ++kb)
#pragma unroll
        for (int i = 0; i < 4; ++i) USC[(kb * 16 + 4 * q4 + i) * HD + w * 16 + r16] = S[kb][i];
    if (w == 0) { DSC[2 * lane] = fexp(Bp0); DSC[2 * lane + 1] = fexp(Bp1); }
    __syncthreads();
}

DI void hgrn_sample_unit(Frame& F, int unit) {
    const int bs = unit >> 3, h = unit & 7, tid = F.tid, lane = F.lane, w = F.wave;
    LAS float* part = (LAS float*)F.lds;
    const bf16* prow = (const bf16*)(F.ws + WS_PB) + (size_t)(TP + bs) * NIN + h * HD;
    const float* lb = (const float*)(F.ws + WS_LB) + h * HD;
    const int vq = tid & 31, kr = tid >> 5;
    const float* S0 = F.in[I_SH] + ((size_t)bs * NH + h) * HD * HD; float* S1 = F.out + O_HS + ((size_t)bs * NH + h) * HD * HD;
    f32x4 iv; { const u32x2 t = *(const u32x2*)(prow + C_I + 4 * vq); iv = (f32x4){bflo(t.x), bfhi(t.x), bflo(t.y), bfhi(t.y)}; }
    f32x4 o = {0.f, 0.f, 0.f, 0.f};
#pragma unroll
    for (int j = 0; j < 8; ++j) { const int k = kr + 16 * j;
        const float l = lb[k], f = l + (1.f - l) * sigm(bf2f(prow[C_F + k])), q = bf2f(prow[C_Q + k]);
        const f32x4 s = *(const f32x4*)(S0 + (size_t)k * HD + 4 * vq) * f + iv * (1.f - f);
        *(f32x4*)(S1 + (size_t)k * HD + 4 * vq) = s; o += s * q; }
#pragma unroll
    for (int i = 0; i < 4; ++i) o[i] += __shfl_xor(o[i], 32);
    if (lane < 32) *(LAS f32x4*)(part + w * 128 + 4 * vq) = o;
    __syncthreads();
    if (w == 0) {
        float o0 = 0.f, o1 = 0.f;
#pragma unroll
        for (int j = 0; j < 8; ++j) { o0 += part[j * 128 + lane]; o1 += part[j * 128 + 64 + lane]; }
        const float rs = 1.0f / sqrtf(wave_sum(o0 * o0 + o1 * o1) * (1.0f / HD) + RMS_EPS);
        const float* gn = F.in[I_HG] + h * HD; bf16* oa = (bf16*)(F.ws + WS_OAB) + (size_t)(TP + bs) * DM + h * HD;
        const float g0 = bf2f(prow[C_OG + lane]), g1 = bf2f(prow[C_OG + 64 + lane]);
        oa[lane] = f2bf(o0 * rs * gn[lane] * g0 * sigm(g0)); oa[64 + lane] = f2bf(o1 * rs * gn[64 + lane] * g1 * sigm(g1));
    }
    __syncthreads();
}

DI void hgrn_finish_unit(Frame& F, int unit) {
    const int b = unit >> 6, h = (unit >> 3) & 7, sc = unit & 7, lane = F.lane, w = F.wave, r16 = lane & 15, q4 = lane >> 4;
    LAS unsigned char* L = F.lds;
    const bf16* Pb = (const bf16*)(F.ws + WS_PB);
    const float* OL = (const float*)(F.ws + WS_OL);
    const size_t urow0 = (size_t)b * TSEQ + sc * 256;
    f32x4 S[8];
#pragma unroll
    for (int kb = 0; kb < 8; ++kb) S[kb] = (f32x4){0.f, 0.f, 0.f, 0.f};
    const int nprev = sc == 7 ? 8 : sc;
#pragma unroll 1
    for (int j = 0; j < nprev; ++j) {
        if (j == sc) {
#pragma unroll
            for (int kb = 0; kb < 8; ++kb) *(LAS u32x2*)(L + L_ST + (w * 16 + r16) * HQ_STRIDE + (kb * 16 + 4 * q4) * 2) = (u32x2){pk2(S[kb][0], S[kb][1]), pk2(S[kb][2], S[kb][3])};
        }
        const float* USC = (const float*)(F.ws + WS_USC) + (size_t)((unit & ~7) + j) * HD * HD; const float* DSC = (const float*)(F.ws + WS_DSC) + (size_t)((unit & ~7) + j) * HD;
#pragma unroll
        for (int kb = 0; kb < 8; ++kb) { const f32x4 d = *(const f32x4*)(DSC + kb * 16 + 4 * q4);
#pragma unroll
            for (int i = 0; i < 4; ++i) S[kb][i] = S[kb][i] * d[i] + USC[(kb * 16 + 4 * q4 + i) * HD + w * 16 + r16]; }
    }
    if (sc == 7) {
        float* HP = F.out + O_HP + ((size_t)b * NH + h) * HD * HD;
#pragma unroll
        for (int kb = 0; kb < 8; ++kb)
#pragma unroll
            for (int i = 0; i < 4; ++i) HP[(kb * 16 + 4 * q4 + i) * HD + w * 16 + r16] = S[kb][i];
    } else {
#pragma unroll
        for (int kb = 0; kb < 8; ++kb) *(LAS u32x2*)(L + L_ST + (w * 16 + r16) * HQ_STRIDE + (kb * 16 + 4 * q4) * 2) = (u32x2){pk2(S[kb][0], S[kb][1]), pk2(S[kb][2], S[kb][3])};
    }
    __syncthreads();
    const float* gn = F.in[I_HG] + h * HD; bf16* OA = (bf16*)(F.ws + WS_OAB);
#pragma unroll 1
    for (int tbi = 0; tbi < 2; ++tbi) {
        const size_t t0 = urow0 + (2 * w + tbi) * 16;
        bf16x8 qf[4];
#pragma unroll
        for (int ks = 0; ks < 4; ++ks) qf[ks] = *(const bf16x8*)(Pb + (t0 + r16) * NIN + C_Q + h * HD + ks * 32 + 8 * q4);
        f32x4 o[8]; float ssq[4] = {0.f, 0.f, 0.f, 0.f};
        const float* olp = OL + (t0 + 4 * q4) * HW + h * HD + r16;
#pragma unroll
        for (int vb = 0; vb < 8; ++vb) {
            f32x4 a = {0.f, 0.f, 0.f, 0.f};
#pragma unroll
            for (int ks = 0; ks < 4; ++ks) { const bf16x8 sf = *(const LAS bf16x8*)(L + L_ST + (vb * 16 + r16) * HQ_STRIDE + (ks * 32 + 8 * q4) * 2); a = MFMA16(qf[ks], sf, a); }
#pragma unroll
            for (int i = 0; i < 4; ++i) { a[i] += olp[i * HW + vb * 16]; ssq[i] += a[i] * a[i]; }
            o[vb] = a;
            asm volatile("" ::: "memory");
        }
#pragma unroll
        for (int i = 0; i < 4; ++i) { float s = ssq[i]; s += __shfl_xor(s, 1); s += __shfl_xor(s, 2); s += __shfl_xor(s, 4); s += __shfl_xor(s, 8); ssq[i] = 1.0f / sqrtf(s * (1.0f / HD) + RMS_EPS); }
        const bf16* ogp = Pb + (t0 + 4 * q4) * NIN + C_OG + h * HD + r16; bf16* oap = OA + (t0 + 4 * q4) * DM + h * HD + r16;
#pragma unroll
        for (int vb = 0; vb < 8; ++vb) { const float gv = gn[vb * 16 + r16];
#pragma unroll
            for (int i = 0; i < 4; ++i) { const float og = bf2f(ogp[i * NIN + vb * 16]);
                oap[i * DM + vb * 16] = f2bf(o[vb][i] * ssq[i] * gv * og * sigm(og)); }
            asm volatile("" ::: "memory"); }
    }
    __syncthreads();
}


DI f32x4 smm_core(const bf16* ap, const bf16* bp, int klen) {
    f32x4 c0 = {0.f, 0.f, 0.f, 0.f}, c1 = c0, c2 = c0, c3 = c0;
#pragma unroll 2
    for (int k = 0; k < klen; k += 128) {
        const bf16x8 a0 = *(const bf16x8*)(ap + k), a1 = *(const bf16x8*)(ap + k + 32), a2 = *(const bf16x8*)(ap + k + 64), a3 = *(const bf16x8*)(ap + k + 96);
        const bf16x8 b0 = *(const bf16x8*)(bp + k), b1 = *(const bf16x8*)(bp + k + 32), b2 = *(const bf16x8*)(bp + k + 64), b3 = *(const bf16x8*)(bp + k + 96);
        c0 = MFMA16(a0, b0, c0); c1 = MFMA16(a1, b1, c1); c2 = MFMA16(a2, b2, c2); c3 = MFMA16(a3, b3, c3);
    }
    return (c0 + c1) + (c2 + c3);
}
DI void smm_glu(Frame& F) {
    const int lane = F.lane, w = F.wave, r16 = lane & 15, q4 = lane >> 4, rb = w & 3, kh = w >> 2;
    LAS f32x4* X = (LAS f32x4*)F.lds;
    const bf16* Z = (const bf16*)(F.ws + WS_Z); const bf16* Wt = (const bf16*)(F.ws + WS_WGLU); bf16* OAB = (bf16*)(F.ws + WS_OAB);
    for (int it = F.bid; it < 128; it += F.G) {
        const int cb = it >> 1, rh = it & 1, j0 = cb * 16, row0 = TP + rh * 64 + rb * 16;
        const int wrow = (j0 >> 7) * 256 + (j0 & 127);
        const bf16* ap = Z + (size_t)(row0 + r16) * SW + kh * 512 + 8 * q4;
        const f32x4 av = smm_core(ap, Wt + (size_t)(wrow + r16) * SW + kh * 512 + 8 * q4, 512);
        const f32x4 gv = smm_core(ap, Wt + (size_t)(wrow + 128 + r16) * SW + kh * 512 + 8 * q4, 512);
        if (kh == 1) { X[(rb * 2 + 0) * 64 + lane] = av; X[(rb * 2 + 1) * 64 + lane] = gv; }
        __syncthreads();
        if (kh == 0) { const f32x4 a = av + X[(rb * 2 + 0) * 64 + lane], g = gv + X[(rb * 2 + 1) * 64 + lane];
#pragma unroll
            for (int i = 0; i < 4; ++i) OAB[(size_t)(row0 + 4 * q4 + i) * DM + HW + j0 + r16] = f2bf(a[i] * sigm(g[i])); }
        __syncthreads();
    }
}
DI void smm_merge(Frame& F) {
    const int lane = F.lane, w = F.wave, r16 = lane & 15, q4 = lane >> 4, rb = w & 3, kh = w >> 2;
    LAS f32x4* X = (LAS f32x4*)F.lds;
    const bf16* OAB = (const bf16*)(F.ws + WS_OAB); const bf16* Wt = (const bf16*)(F.ws + WS_WCAT); const bf16* Pb = (const bf16*)(F.ws + WS_PB); bf16* MRG = (bf16*)(F.ws + WS_MRG);
    for (int it = F.bid; it < 256; it += F.G) {
        const int cb = it >> 1, rh = it & 1, c0 = cb * 16, row0 = TP + rh * 64 + rb * 16;
        f32x4 v = smm_core(OAB + (size_t)(row0 + r16) * DM + kh * 1024 + 8 * q4, Wt + (size_t)(c0 + r16) * DM + kh * 1024 + 8 * q4, 1024);
#pragma unroll
        for (int i = 0; i < 4; ++i) v[i] *= sigm(bf2f(Pb[(size_t)(row0 + 4 * q4 + i) * NIN + (kh ? C_GB : C_GA) + c0 + r16]));
        if (kh == 1) X[rb * 64 + lane] = v;
        __syncthreads();
        if (kh == 0) { v += X[rb * 64 + lane];
#pragma unroll
            for (int i = 0; i < 4; ++i) MRG[(size_t)(row0 + 4 * q4 + i) * DM + c0 + r16] = f2bf(v[i]); }
        __syncthreads();
    }
}
template <bool WRITE_BF16> DI void smm_res(Frame& F, const bf16* A, const bf16* Wt, int K, const float* base  , float* out  , bf16* ob  , float* ss  ) {
    const int lane = F.lane, w = F.wave, r16 = lane & 15, q4 = lane >> 4, rb = w & 3, kh = w >> 2;
    LAS f32x4* X = (LAS f32x4*)F.lds;
    const int khl = K >> 1;
    for (int it = F.bid; it < 256; it += F.G) {
        const int cb = it >> 1, rh = it & 1, c0 = cb * 16, row0 = rh * 64 + rb * 16;
        f32x4 v = smm_core(A + (size_t)(TP + row0 + r16) * K + kh * khl + 8 * q4, Wt + (size_t)(c0 + r16) * K + kh * khl + 8 * q4, khl);
        if (kh == 1) X[rb * 64 + lane] = v;
        __syncthreads();
        if (kh == 0) { v += X[rb * 64 + lane];
#pragma unroll
            for (int i = 0; i < 4; ++i) { const size_t o = (size_t)(row0 + 4 * q4 + i) * DM + c0 + r16; const float y = base[o] + v[i]; out[o] = y; if (WRITE_BF16) ob[o] = f2bf(y);
                float s = y * y; s += __shfl_xor(s, 1); s += __shfl_xor(s, 2); s += __shfl_xor(s, 4); s += __shfl_xor(s, 8);
                if (r16 == 0) atomicAdd(ss + row0 + 4 * q4 + i, s); } }
        __syncthreads();
    }
}

DI void final_norm(Frame& F) {
    const int gw = F.bid * NWAVES + F.wave, NGW = F.G * NWAVES;
    const float* ss3 = (const float*)(F.ws + WS_SS3); const f32x4* gf = (const f32x4*)F.in[I_NF] + F.lane;
    for (int m = gw; m < MV; m += NGW) {
        const float r = 1.0f / sqrtf(ss3[m] * (1.0f / DM) + RMS_EPS);
        f32x4* x4 = (f32x4*)(F.out + (size_t)m * DM) + F.lane;
#pragma unroll
        for (int j = 0; j < 8; ++j) x4[64 * j] = x4[64 * j] * r * gf[64 * j];
    }
}

#define XB_TMO      128
#define XB_XCNT(j)  (256  + 64 * (j))
#define XB_XSUB(j)  (1280 + 64 * (j))
#define XB_XGEN(j)  (2304 + 64 * (j))
#define XB_TOP      3328
#define XB_TOPGEN   3392
#define XCD_BAR_WORDS 3456
#define XB_SPIN_CAP (1u << 18)

__device__ __forceinline__ unsigned xb_ld(unsigned* p)              { return __hip_atomic_load(p, __ATOMIC_RELAXED, __HIP_MEMORY_SCOPE_AGENT); }
__device__ __forceinline__ unsigned xb_add(unsigned* p, unsigned v) { return __hip_atomic_fetch_add(p, v, __ATOMIC_RELAXED, __HIP_MEMORY_SCOPE_AGENT); }
__device__ __forceinline__ unsigned xb_xcc_id() { return (unsigned)__builtin_amdgcn_s_getreg((3 << 11) | 20) & 0xFu; }
#define XB_SPIN(cond, bar) do { unsigned _sp = 0; while (cond) { __builtin_amdgcn_s_sleep(1); \
    if ((++_sp & 255u) == 0u) { if (xb_ld(&(bar)[XB_TMO])) break; if (_sp > XB_SPIN_CAP) { atomicAdd(&(bar)[XB_TMO], 1u); break; } } } } while (0)

struct XcdBarrier {
    unsigned* bar; unsigned x;
    volatile LAS unsigned* st;
};

__device__ __forceinline__ XcdBarrier xcd_barrier_post(unsigned* bar, volatile LAS unsigned* st) {
    XcdBarrier b; b.bar = bar; b.x = xb_xcc_id(); b.st = st;
    if (threadIdx.x == 0) (void)xb_add(&bar[XB_XCNT(b.x)], 1u);
    return b;
}
__device__ __forceinline__ void xcd_barrier_complete(unsigned* bar, unsigned x, unsigned& nloc, unsigned& nx) {
    const unsigned G = gridDim.x * gridDim.y * gridDim.z;
    unsigned sum, cnt, mine, sp = 0u;
    for (;;) {
        sum = 0u; cnt = 0u; mine = 0u;
#pragma unroll
        for (unsigned j = 0; j < 16; ++j) { const unsigned c = xb_ld(&bar[XB_XCNT(j)]); sum += c; cnt += (c > 0u) ? 1u : 0u; mine = (j == x) ? c : mine; }
        if (sum == G) break;
        __builtin_amdgcn_s_sleep(1);
        if ((++sp & 255u) == 0u) { if (xb_ld(&bar[XB_TMO])) break; if (sp > XB_SPIN_CAP) { atomicAdd(&bar[XB_TMO], 1u); break; } }
    }
    nloc = mine > 0u ? mine : 1u; nx = cnt > 0u ? cnt : 1u;
}

__device__ __forceinline__ void xcd_barrier(const XcdBarrier& b) {
    asm volatile("s_waitcnt vmcnt(0)" ::: "memory");
    __syncthreads();
    if (threadIdx.x == 0) {
        unsigned* bar = b.bar;
        __builtin_amdgcn_s_waitcnt(0);
        unsigned nloc = b.st[0], nx = b.st[1];
        if (nloc == 0u) { xcd_barrier_complete(bar, b.x, nloc, nx); b.st[0] = nloc; b.st[1] = nx; }
        const unsigned old = xb_add(&bar[XB_XSUB(b.x)], 1u);
        const unsigned gen = old / nloc;
        if (old + 1u == (gen + 1u) * nloc) {
            __builtin_amdgcn_fence(__ATOMIC_RELEASE, "agent");
            asm volatile("s_waitcnt vmcnt(0)" ::: "memory");
            const unsigned og = xb_add(&bar[XB_TOP], 1u);
            const unsigned tg = og / nx;
            if (og + 1u == (tg + 1u) * nx) xb_add(&bar[XB_TOPGEN], 1u);
            else XB_SPIN(xb_ld(&bar[XB_TOPGEN]) == tg, bar);
            __builtin_amdgcn_fence(__ATOMIC_ACQUIRE, "agent");
            xb_add(&bar[XB_XGEN(b.x)], 1u);
            asm volatile("s_waitcnt vmcnt(0)" ::: "memory");
        } else {
            XB_SPIN(xb_ld(&bar[XB_XGEN(b.x)]) == gen, bar);
            __builtin_amdgcn_fence(__ATOMIC_ACQUIRE, "agent");
            asm volatile("s_waitcnt vmcnt(0)" ::: "memory");
        }
    }
    __syncthreads();
}

#ifndef N_LAUNCHES
#define N_LAUNCHES 1
#endif
constexpr int NPHASE = 9;
__global__ void __launch_bounds__(NTHR, 2) hybrid_fwd(Args args) {
    extern __shared__ __attribute__((aligned(16))) unsigned char lds_raw[];
    cg::grid_group grid = cg::this_grid();
    Frame F;
    F.lds = (LAS unsigned char*)lds_raw; F.tid = threadIdx.x; F.lane = F.tid & 63; F.wave = __builtin_amdgcn_readfirstlane(F.tid >> 6);
    F.G = gridDim.x; F.bid = blockIdx.x; F.out = args.out; F.ws = args.ws;
#pragma unroll
    for (int i = 0; i < 25; ++i) F.in[i] = args.in[i];
    const int lo = args.ph_lo, hi = args.ph_hi;
    if (hi > 1000) grid.sync();
#ifndef REPMASK
#define REPMASK 0
#endif
#ifndef SKIPMASK
#define SKIPMASK 0
#endif
#ifndef PHMASK
#define PHMASK 0x1ff
#endif
#define IN(k) (((PHMASK >> (k)) & 1) && lo <= (k) && (k) < hi)
#ifndef XSYNC
#define XSYNC 0
#endif
#ifndef CG_SEAMS
#define CG_SEAMS 0x0
#endif
    { volatile LAS unsigned* st = (volatile LAS unsigned*)(F.lds + LDS_BAR_OFF); if (F.tid < 2) st[F.tid] = 0u; __syncthreads(); }
    const XcdBarrier xbar = xcd_barrier_post((unsigned*)(F.ws + WS_BAR), (volatile LAS unsigned*)(F.lds + LDS_BAR_OFF));
#define SEAM(k) do { if (IN(k) && IN((k) + 1)) { if ((CG_SEAMS >> (k)) & 1) grid.sync(); else xcd_barrier(xbar); if ((k) == 4) { for (int xs = 0; xs < XSYNC; ++xs) xcd_barrier(xbar); } } } while (0)
    typedef pg8::bf16_t pb;
    if (IN(0)) { p0_prologue(F); if ((REPMASK >> 0) & 1) { __syncthreads(); p0_prologue(F); } } SEAM(0);
    if (IN(1)) {
        pg8::Gemm g{(const pb*)(F.ws + WS_XB), (const pb*)(F.ws + WS_WIN), MP, NIN, DM, DM}; pg8::StaticOrder S; S.init(MP, NIN, F.G, F.bid);
        pg8::EpiIn E{(pb*)(F.ws + WS_PB), (const float*)(F.ws + WS_RS1), NIN};
        pg8::gemm_phase<pg8::EpiIn, pg8::StaticOrder, true, true>(F.lds, g, S, E);
#if (REPMASK >> 1) & 1
        pg8::gemm_phase<pg8::EpiIn, pg8::StaticOrder, true, true>(F.lds, g, S, E);
#endif
    } SEAM(1);
    if (IN(2)) {
#define P2_BODY(DRY) do { \
        if (!((SKIPMASK >> 0) & 1)) for (int u = F.bid; u < NB * SG; u += F.G) s5_prompt_unit(F, u); \
        if (!((SKIPMASK >> 1) & 1)) for (int u = F.bid; u < NB * NH * 8; u += F.G) hgrn_local_unit<DRY>(F, u); \
        for (int u = F.bid; u < NSMP * NH; u += F.G) hgrn_sample_unit(F, u); \
        { const int gw = F.bid * NWAVES + F.wave, NGW = F.G * NWAVES; for (int u = gw; u < NSMP * SG; u += NGW) s5_sample_wave(F, u >> 6, u & 63); } \
        __syncthreads(); } while (0)
#if (REPMASK >> 2) & 1
        P2_BODY(true);
#endif
        P2_BODY(false);
    } SEAM(2);
    if (IN(3)) {
#pragma unroll 1
        for (int rep = ((REPMASK >> 9) & 1) ? 0 : 1; rep < 2; ++rep)
        for (int u = F.bid; u < NB * NH * 8; u += F.G) hgrn_finish_unit(F, u);
#ifndef NO_GLU
        pg8::Gemm g{(const pb*)(F.ws + WS_Z), (const pb*)(F.ws + WS_WGLU), TP, 2 * SW, SW, SW}; pg8::StaticOrder S; S.init(TP, 2 * SW, F.G, F.bid);
        pg8::EpiGlu E{(pb*)(F.ws + WS_OAB) + HW, DM};
        pg8::gemm_phase<pg8::EpiGlu, pg8::StaticOrder, true, true>(F.lds, g, S, E);
#if (REPMASK >> 3) & 1
        pg8::gemm_phase<pg8::EpiGlu, pg8::StaticOrder, true, true>(F.lds, g, S, E);
#endif
#endif
        smm_glu(F);
#if (REPMASK >> 10) & 1
        smm_glu(F);
#endif
    } SEAM(3);
    if (IN(4)) {
        pg8::Gemm g{(const pb*)(F.ws + WS_OAB), (const pb*)(F.ws + WS_WCAT), TP, DM, DM, MERGE_MID ? DM / 2 : DM}; pg8::HalvedOrder S; S.init(TP, DM, F.G, F.bid);
        pg8::EpiMerge E{(pb*)(F.ws + WS_MRG), (const pb*)(F.ws + WS_PB), NIN, C_GA, C_GB, DM};
        pg8::gemm_phase<pg8::EpiMerge, pg8::HalvedOrder, true, true>(F.lds, g, S, E);
#if (REPMASK >> 4) & 1
        pg8::gemm_phase<pg8::EpiMerge, pg8::HalvedOrder, true, true>(F.lds, g, S, E);
#endif
        smm_merge(F);
#if (REPMASK >> 10) & 1
        smm_merge(F);
#endif
    } SEAM(4);
    if (IN(5)) {
        pg8::Gemm g{(const pb*)(F.ws + WS_MRG), (const pb*)(F.ws + WS_WOUT), TP, DM, DM, DM}; pg8::StaticOrder S; S.init(TP, DM, F.G, F.bid);
        pg8::EpiRes<true> E{F.in[I_XP], F.in[I_XS], TP, (float*)(F.ws + WS_X1), (pb*)(F.ws + WS_X1B), (float*)(F.ws + WS_SS2), MV, DM};
        pg8::gemm_phase<pg8::EpiRes<true>, pg8::StaticOrder, true, true>(F.lds, g, S, E);
#if (REPMASK >> 5) & 1
        pg8::gemm_phase<pg8::EpiRes<true>, pg8::StaticOrder, true, true>(F.lds, g, S, E);
#endif
        smm_res<true>(F, (const bf16*)(F.ws + WS_MRG), (const bf16*)(F.ws + WS_WOUT), DM, F.in[I_XS], (float*)(F.ws + WS_X1) + (size_t)TP * DM, (bf16*)(F.ws + WS_X1B) + (size_t)TP * DM, (float*)(F.ws + WS_SS2) + TP);
    } SEAM(5);
    if (IN(6)) {
        pg8::Gemm g{(const pb*)(F.ws + WS_X1B), (const pb*)(F.ws + WS_WUP), MP, 2 * FF, DM, DM}; pg8::StaticOrder S; S.init(MP, 2 * FF, F.G, F.bid);
        pg8::EpiSwiGlu E{(pb*)(F.ws + WS_ACT), (const float*)(F.ws + WS_SS2), FF};
        pg8::gemm_phase<pg8::EpiSwiGlu, pg8::StaticOrder, true, true>(F.lds, g, S, E);
#if (REPMASK >> 6) & 1
        pg8::gemm_phase<pg8::EpiSwiGlu, pg8::StaticOrder, true, true>(F.lds, g, S, E);
#endif
    } SEAM(6);
    if (IN(7)) {
        pg8::Gemm g{(const pb*)(F.ws + WS_ACT), (const pb*)(F.ws + WS_WDN), TP, DM, FF, FF}; pg8::StaticOrder S; S.init(TP, DM, F.G, F.bid);
        pg8::EpiRes<false> E{(const float*)(F.ws + WS_X1), (const float*)(F.ws + WS_X1), MP, F.out, nullptr, (float*)(F.ws + WS_SS3), MV, DM};
        pg8::gemm_phase<pg8::EpiRes<false>, pg8::StaticOrder, true, true>(F.lds, g, S, E);
#if (REPMASK >> 7) & 1
        pg8::gemm_phase<pg8::EpiRes<false>, pg8::StaticOrder, true, true>(F.lds, g, S, E);
#endif
        smm_res<false>(F, (const bf16*)(F.ws + WS_ACT), (const bf16*)(F.ws + WS_WDN), FF, (const float*)(F.ws + WS_X1) + (size_t)TP * DM, F.out + (size_t)TP * DM, nullptr, (float*)(F.ws + WS_SS3) + TP);
    } SEAM(7);
    if (IN(8)) final_norm(F);
#undef IN
#undef SEAM
}

extern "C" void kernel_launch(void* const* d_in, const int* in_sizes, int n_in, void* d_out, int out_size, void* d_ws, size_t ws_size, hipStream_t stream) {
    static int grid = 0;
    if (grid == 0) {
        if (n_in != 25 || ws_size < WS_END || (size_t)out_size != O_END) { fprintf(stderr, "kernel_launch: unexpected problem: n_in %d ws %zu (need %zu) out %d (expect %zu)\n", n_in, ws_size, (size_t)WS_END, out_size, (size_t)O_END); grid = -1; return; }
        int dev = 0, cus = 0, per_cu = 0;
        hipGetDevice(&dev); hipDeviceGetAttribute(&cus, hipDeviceAttributeMultiprocessorCount, dev);
        hipFuncSetAttribute((const void*)hybrid_fwd, hipFuncAttributeMaxDynamicSharedMemorySize, LDS_BYTES);
        hipOccupancyMaxActiveBlocksPerMultiprocessor(&per_cu, (const void*)hybrid_fwd, NTHR, LDS_BYTES);
        if (per_cu < 1) { fprintf(stderr, "kernel_launch: occupancy query reports %d blocks per CU\n", per_cu); per_cu = 1; }
        (void)hipGetLastError();
        grid = cus;
    }
    if (grid < 0) return;
    if (hipMemsetAsync((char*)d_ws + WS_BAR, 0, WS_BAR_BYTES, stream) != hipSuccess) { fprintf(stderr, "kernel_launch: memset of the barrier words failed\n"); return; }
    Args a{};
    for (int i = 0; i < 25; ++i) a.in[i] = (const float*)d_in[i];
    a.out = (float*)d_out; a.ws = (unsigned char*)d_ws;
#if N_LAUNCHES == 1
    a.ph_lo = 0; a.ph_hi = NPHASE;
    void* params[] = {&a};
    hipError_t e = hipLaunchCooperativeKernel((const void*)hybrid_fwd, dim3(grid), dim3(NTHR), params, LDS_BYTES, stream);
    if (e != hipSuccess) fprintf(stderr, "cooperative launch failed: %s (grid %d)\n", hipGetErrorString(e), grid);
#else
    for (int p = 0; p < NPHASE; ++p) { a.ph_lo = p; a.ph_hi = p + 1; hipLaunchKernelGGL(hybrid_fwd, dim3(grid), dim3(NTHR), LDS_BYTES, stream, a); }
#endif
}
```

```cpp
#include <hip/hip_runtime.h>
#include <hip/hip_cooperative_groups.h>
#include <cstdio>
#include <cstdint>
namespace cg = cooperative_groups;

#define DI __device__ __forceinline__
#define LAS __attribute__((address_space(3)))
typedef float f32x2 __attribute__((ext_vector_type(2)));
typedef __bf16 bf16x2_t __attribute__((ext_vector_type(2)));
typedef unsigned u32x2 __attribute__((ext_vector_type(2)));

constexpr int DM = 2048, TSEQ = 2048, NB = 4, TP = NB * TSEQ  , NSMP = 128, MV = TP + NSMP  , MP = 8448  ;
constexpr int HW = 1024, NH = 8, HD = 128, SW = 1024, SG = 64, SPC = 16, SN = 64, FF = 5632, NIN = 9216;
constexpr int C_Q = 0, C_F = 1024, C_I = 2048, C_OG = 3072, C_U = 4096, C_GA = 5120, C_GB = 7168;
constexpr float RMS_EPS = 1e-6f;
#ifndef MERGE_MID
#define MERGE_MID true
#endif

constexpr size_t MiB = 1u << 20;
constexpr size_t WS_R1 = 2 * MiB;
constexpr size_t WS_WIN = WS_R1, WS_XB = WS_R1 + 36 * MiB;
constexpr size_t WS_OL = WS_R1, WS_Z = WS_R1 + 32 * MiB;
constexpr size_t WS_X1 = WS_R1;
constexpr size_t WS_R2 = WS_R1 + 69 * MiB;
constexpr size_t WS_PB = WS_R2;
constexpr size_t WS_ACT = WS_R2, WS_X1B = WS_R2 + 91 * MiB;
constexpr size_t WS_R3 = WS_R2 + 148 * MiB + MiB / 2;
constexpr size_t WS_WGLU = WS_R3, WS_WCAT = WS_R3 + 4 * MiB, WS_WOUT = WS_R3 + 12 * MiB, WS_WUP = WS_R3 + 20 * MiB, WS_WDN = WS_R3 + 64 * MiB;
constexpr size_t WS_R4 = WS_R3 + 86 * MiB;
constexpr size_t WS_OAB = WS_R4, WS_MRG = WS_R4 + 33 * MiB;
constexpr size_t WS_USC = WS_MRG, WS_DSC = WS_MRG + 16 * MiB;
constexpr size_t WS_END = WS_R4 + 66 * MiB;
constexpr size_t WS_RS1 = 0, WS_LB = 192 * 1024, WS_SS2 = 64 * 1024, WS_SS3 = 128 * 1024, WS_PARA = 256 * 1024  , WS_PARB = 512 * 1024  , WS_PARC = 768 * 1024  ;

constexpr size_t WS_BAR = 1 * MiB, WS_BAR_BYTES = 16384;
constexpr int LDS_BAR_OFF = 131072 + 64;
constexpr int WORKCTR_WORD = 3584;
constexpr int LDS_BYTES = 147456;

DI float bflo(unsigned u) { return __uint_as_float(u << 16); }
DI float bfhi(unsigned u) { return __uint_as_float(u & 0xffff0000u); }
DI float bf2f(unsigned short b) { return __uint_as_float((unsigned)b << 16); }
DI unsigned pk2(float lo, float hi) { f32x2 v = {lo, hi}; bf16x2_t b = __builtin_convertvector(v, bf16x2_t); return __builtin_bit_cast(unsigned, b); }
DI unsigned short f2bf(float f) { return (unsigned short)(pk2(f, 0.f) & 0xffffu); }
DI float fexp(float x) { return __expf(x); }
DI float sigm(float x) { return __builtin_amdgcn_rcpf(1.f + __expf(-x)); }
DI float wave_sum(float v) {
#pragma unroll
    for (int o = 1; o < 64; o <<= 1) v += __shfl_xor(v, o);
    return v;
}

namespace pg8 {
#define PG8_LAS __attribute__((address_space(3)))
typedef unsigned short bf16_t;
typedef short bf16x8 __attribute__((ext_vector_type(8)));
typedef float f32x4 __attribute__((ext_vector_type(4)));
typedef unsigned u32x4 __attribute__((ext_vector_type(4)));
constexpr int BM = 256, BK = 64, HALF = 128, HTB = HALF * BK * 2  , STAGE_BYTES = 8 * HTB, NXCD = 8, WGM = 8;

__host__ __device__ __forceinline__ int lds_byte(int r, int c) { const int st = (r >> 4) * 2 + (c >> 5), rr = r & 15, cc = c & 31, ob = rr * 64 + cc * 2; return st * 1024 + (ob ^ (((ob >> 9) & 1) << 5)); }
__host__ __device__ __forceinline__ void stage_rc(int b, int& R, int& C) { const int st = b / 1024, sb = b % 1024, swz = sb ^ (((sb >> 9) & 1) << 5); R = (st >> 1) * 16 + swz / 64; C = (st & 1) * 32 + (swz % 64) / 2; }
__host__ __device__ __forceinline__ int perm32(int rho) { const int n = rho >> 4, i = rho & 15; return 8 * (i >> 2) + 4 * n + (i & 3); }

struct Unit { int pm, pn, kh; };
struct Gemm { const bf16_t* A; const bf16_t* Bt; int M, N, K, KL; };

struct StaticOrder {
    int nM, nN, nwg, G, c;
    __host__ __device__ void init(int M, int N, int G_, int c_) { nM = M / BM; nN = N / BM; nwg = nM * nN; G = G_; c = c_; }
    __host__ __device__ bool next(int i, Unit& u) const {
        const long L = (long)i * G + c; if (L >= nwg) return false;
        int wgid = (int)L; { const int q = nwg / NXCD, r = nwg % NXCD, xcd = wgid % NXCD, off = wgid / NXCD; wgid = (xcd < r ? xcd * (q + 1) : r * (q + 1) + (xcd - r) * q) + off; }
        const int nig = WGM * nN, gid = wgid / nig, fm = gid * WGM, gsz = (nM - fm) < WGM ? (nM - fm) : WGM;
        u.pm = fm + ((wgid % nig) % gsz); u.pn = (wgid % nig) / gsz; u.kh = 0; return true;
    }
    __device__ __forceinline__ void a_ready(const Unit&) const {}
    __device__ __forceinline__ void done(const Unit&) const {}
};

struct HalvedOrder {
    StaticOrder so;
    __host__ __device__ void init(int M, int N, int G_, int c_) { so.init(M, N, G_, c_); }
    __host__ __device__ bool next(int i, Unit& u) const { if (!so.next(i >> 1, u)) return false; u.kh = i & 1; return true; }
    __device__ __forceinline__ void a_ready(const Unit&) const {}
    __device__ __forceinline__ void done(const Unit&) const {}
};
__device__ __forceinline__ u32x4 pack8(f32x4 v0, f32x4 v1) { u32x4 w; w.x = ::pk2(v0[0], v0[1]); w.y = ::pk2(v0[2], v0[3]); w.z = ::pk2(v1[0], v1[1]); w.w = ::pk2(v1[2], v1[3]); return w; }
__device__ __forceinline__ void unpack8(u32x4 w, f32x4& v0, f32x4& v1) { v0 = (f32x4){::bflo(w.x), ::bfhi(w.x), ::bflo(w.y), ::bfhi(w.y)}; v1 = (f32x4){::bflo(w.z), ::bfhi(w.z), ::bflo(w.w), ::bfhi(w.w)}; }
__device__ __forceinline__ f32x4 sig4(f32x4 x) { return (f32x4){::sigm(x[0]), ::sigm(x[1]), ::sigm(x[2]), ::sigm(x[3])}; }

struct EpiIn {
    static constexpr bool PERM = true, AFTER_DRAIN = false, HAS_MID = false;
    bf16_t* O; const float* rs; int ldc;
    __device__ __forceinline__ void operator()(const f32x4 (&acc)[2][2][4][2], const Unit& u, int wr, int wc, int fr, int fq) const {
        const int row0 = u.pm * BM + wr * 64 + fr, col0 = u.pn * BM + wc * 32 + 8 * fq;
#pragma unroll
        for (int ai = 0; ai < 2; ++ai)
#pragma unroll
            for (int m = 0; m < 4; ++m) { const int row = row0 + ai * HALF + m * 16; const float s = rs[row]; bf16_t* rowp = O + (size_t)row * ldc + col0;
#pragma unroll
                for (int bj = 0; bj < 2; ++bj) *(u32x4*)(rowp + bj * HALF) = pack8(acc[ai][bj][m][0] * s, acc[ai][bj][m][1] * s); }
    }
};
struct EpiGlu {
    static constexpr bool PERM = true, AFTER_DRAIN = false, HAS_MID = false;
    bf16_t* O; int ldc;
    __device__ __forceinline__ void operator()(const f32x4 (&acc)[2][2][4][2], const Unit& u, int wr, int wc, int fr, int fq) const {
        const int row0 = u.pm * BM + wr * 64 + fr, col0 = u.pn * HALF + wc * 32 + 8 * fq;
#pragma unroll
        for (int ai = 0; ai < 2; ++ai)
#pragma unroll
            for (int m = 0; m < 4; ++m) { const int row = row0 + ai * HALF + m * 16;
                *(u32x4*)(O + (size_t)row * ldc + col0) = pack8(acc[ai][0][m][0] * sig4(acc[ai][1][m][0]), acc[ai][0][m][1] * sig4(acc[ai][1][m][1])); }
    }
};
struct EpiMerge {
    static constexpr bool PERM = true, AFTER_DRAIN = false, HAS_MID = MERGE_MID;
    bf16_t* O; const bf16_t* P; int ldp; int cga, cgb; int ldc;
    __device__ __forceinline__ void mid(f32x4 (&acc)[2][2][4][2], const Unit& u, int wr, int wc, int fr, int fq) const {
        const int row0 = u.pm * BM + wr * 64 + fr, col0 = u.pn * BM + wc * 32 + 8 * fq;
#pragma unroll
        for (int ai = 0; ai < 2; ++ai)
#pragma unroll
            for (int m = 0; m < 4; ++m) { const int row = row0 + ai * HALF + m * 16; const bf16_t* pr = P + (size_t)row * ldp + col0;
#pragma unroll
                for (int bj = 0; bj < 2; ++bj) { f32x4 a0, a1, b0, b1; unpack8(*(const u32x4*)(pr + cga + bj * HALF), a0, a1); unpack8(*(const u32x4*)(pr + cgb + bj * HALF), b0, b1);
#pragma unroll
                    for (int i = 0; i < 4; ++i) { acc[ai][bj][m][0][i] *= (1.f + __expf(-b0[i])) * __builtin_amdgcn_rcpf(1.f + __expf(-a0[i])); acc[ai][bj][m][1][i] *= (1.f + __expf(-b1[i])) * __builtin_amdgcn_rcpf(1.f + __expf(-a1[i])); } }
                asm volatile("" ::: "memory"); }
    }
    __device__ __forceinline__ void operator()(const f32x4 (&acc)[2][2][4][2], const Unit& u, int wr, int wc, int fr, int fq) const {
        const int row0 = u.pm * BM + wr * 64 + fr, col0 = u.pn * BM + wc * 32 + 8 * fq;
#pragma unroll
        for (int ai = 0; ai < 2; ++ai)
#pragma unroll
            for (int m = 0; m < 4; ++m) { const int row = row0 + ai * HALF + m * 16; const bf16_t* pr = P + (size_t)row * ldp + col0 + cgb; bf16_t* rowp = O + (size_t)row * ldc + col0;
#pragma unroll
                for (int bj = 0; bj < 2; ++bj) { f32x4 b0, b1; unpack8(*(const u32x4*)(pr + bj * HALF), b0, b1);
                    *(u32x4*)(rowp + bj * HALF) = pack8(acc[ai][bj][m][0] * sig4(b0), acc[ai][bj][m][1] * sig4(b1)); }
                asm volatile("" ::: "memory"); }
    }
};
template <bool WRITE_BF16> struct EpiRes {
    static constexpr bool PERM = true, AFTER_DRAIN = false, HAS_MID = false;
    const float* base0; const float* base1; int split;
    float* out; bf16_t* ob; float* ss; int nvalid; int ldc;
    __device__ __forceinline__ void operator()(const f32x4 (&acc)[2][2][4][2], const Unit& u, int wr, int wc, int fr, int fq) const {
        const int row0 = u.pm * BM + wr * 64 + fr, col0 = u.pn * BM + wc * 32 + 8 * fq;
#pragma unroll
        for (int ai = 0; ai < 2; ++ai)
#pragma unroll
            for (int m = 0; m < 4; ++m) { const int row = row0 + ai * HALF + m * 16;
                if (row < nvalid) {
                    const float* bp = (row < split ? base0 + (size_t)row * ldc : base1 + (size_t)(row - split) * ldc) + col0; float* op = out + (size_t)row * ldc + col0; float s = 0.f;
#pragma unroll
                    for (int bj = 0; bj < 2; ++bj) { const f32x4 x0 = *(const f32x4*)(bp + bj * HALF), x1 = *(const f32x4*)(bp + bj * HALF + 4);
                        const f32x4 y0 = x0 + acc[ai][bj][m][0], y1 = x1 + acc[ai][bj][m][1];
                        *(f32x4*)(op + bj * HALF) = y0; *(f32x4*)(op + bj * HALF + 4) = y1;
                        if (WRITE_BF16) *(u32x4*)(ob + (size_t)row * ldc + col0 + bj * HALF) = pack8(y0, y1);
                        s += (y0[0] * y0[0] + y0[1] * y0[1]) + (y0[2] * y0[2] + y0[3] * y0[3]) + (y1[0] * y1[0] + y1[1] * y1[1]) + (y1[2] * y1[2] + y1[3] * y1[3]); }
                    s += __shfl_xor(s, 16); s += __shfl_xor(s, 32);
                    if (fq == 0) atomicAdd(ss + row, s);
                } }
    }
};
struct EpiSwiGlu {
    static constexpr bool PERM = true, AFTER_DRAIN = false, HAS_MID = false;
    bf16_t* O; const float* ss; int ldc;
    __device__ __forceinline__ void operator()(const f32x4 (&acc)[2][2][4][2], const Unit& u, int wr, int wc, int fr, int fq) const {
        const int row0 = u.pm * BM + wr * 64 + fr, col0 = u.pn * HALF + wc * 32 + 8 * fq;
#pragma unroll
        for (int ai = 0; ai < 2; ++ai)
#pragma unroll
            for (int m = 0; m < 4; ++m) { const int row = row0 + ai * HALF + m * 16; const float r = __builtin_amdgcn_rsqf(ss[row] * (1.0f / 2048.0f) + 1e-6f);
                const f32x4 a0 = acc[ai][0][m][0] * r, a1 = acc[ai][0][m][1] * r, b0 = acc[ai][1][m][0] * r, b1 = acc[ai][1][m][1] * r;
                *(u32x4*)(O + (size_t)row * ldc + col0) = pack8(a0 * sig4(a0) * b0, a1 * sig4(a1) * b1); }
    }
};
template <class Epi, class Sched, bool ALIGN_EPI = false, bool SP2 = false>
__device__ __forceinline__ void gemm_phase(PG8_LAS unsigned char* lds, const Gemm g, const Sched& S, const Epi& E) {
    const int tid = threadIdx.x, wid = __builtin_amdgcn_readfirstlane(tid >> 6), lane = tid & 63, wr = wid >> 2, wc = wid & 3, fr = lane & 15, fq = lane >> 4;
    const int K = g.K, nt = g.KL / BK; const size_t khb = (size_t)g.KL * 2;
    unsigned voffA[2], voffB[2];
#pragma unroll
    for (int i = 0; i < 2; ++i) { int R, C; stage_rc(tid * 16 + i * 8192, R, C); const int Rb = Epi::PERM ? ((R & ~31) + perm32(R & 31)) : R;
        voffA[i] = (unsigned)(R * K + C) * 2u; voffB[i] = (unsigned)(Rb * K + C) * 2u; }
    const size_t kstep = (size_t)(BK * 2);
    const size_t hstep = (size_t)HALF * K * 2;
    const size_t tstep = 2 * hstep;
    const unsigned ldsw = (unsigned)wid * 1024u;
    const int aoff = lds_byte(wr * 64 + fr, fq * 8), boff = lds_byte(wc * 32 + fr, fq * 8);
#define PG8_SA(b, h) (((b) * 2 + (h)) * HTB)
#define PG8_SB(b, h) ((4 + (b) * 2 + (h)) * HTB)
#define PG8_STAGE(bufoff, gbase, voff) do { _Pragma("unroll") for (int _i = 0; _i < 2; ++_i) \
        __builtin_amdgcn_global_load_lds((const unsigned*)((const char*)(gbase) + (voff)[_i]), (PG8_LAS unsigned*)(lds + (bufoff) + ldsw + _i * 8192), 16, 0, 0); } while (0)
#define PG8_LDA(dst, b, h) do { _Pragma("unroll") for (int m = 0; m < 4; ++m) _Pragma("unroll") for (int k = 0; k < 2; ++k) dst[m][k] = *(const PG8_LAS bf16x8*)(lds + PG8_SA(b, h) + aoff + m * 2048 + k * 1024); } while (0)
#define PG8_LDB(dst, b, h) do { _Pragma("unroll") for (int n = 0; n < 2; ++n) _Pragma("unroll") for (int k = 0; k < 2; ++k) dst[n][k] = *(const PG8_LAS bf16x8*)(lds + PG8_SB(b, h) + boff + n * 2048 + k * 1024); } while (0)
#define PG8_MMA(ai, bj, At, Bt) do { __builtin_amdgcn_s_setprio(1); _Pragma("unroll") for (int m = 0; m < 4; ++m) _Pragma("unroll") for (int n = 0; n < 2; ++n) _Pragma("unroll") for (int k = 0; k < 2; ++k) \
        acc[ai][bj][m][n] = __builtin_amdgcn_mfma_f32_16x16x32_bf16(Bt[n][k], At[m][k], acc[ai][bj][m][n], 0, 0, 0); __builtin_amdgcn_s_setprio(0); } while (0)
#define PG8_WAIT_V(n) asm volatile("s_waitcnt vmcnt(" #n ")" ::: "memory")
#define PG8_WAIT_L(n) asm volatile("s_waitcnt lgkmcnt(" #n ")" ::: "memory")
#define PG8_BAR __builtin_amdgcn_s_barrier()
#define PG8_SCHED __builtin_amdgcn_sched_barrier(0)
    Unit cur, nxt; int ui = 0;
    if (!S.next(0, cur)) return;
    f32x4 acc[2][2][4][2];
#pragma unroll
    for (int a = 0; a < 2; ++a)
#pragma unroll
        for (int b = 0; b < 2; ++b)
#pragma unroll
            for (int m = 0; m < 4; ++m)
#pragma unroll
                for (int n = 0; n < 2; ++n) acc[a][b][m][n] = (f32x4){0.f, 0.f, 0.f, 0.f};
    bf16x8 At[4][2], B0[2][2], B1[2][2];
    const char* cA = (const char*)g.A + (size_t)cur.pm * tstep + cur.kh * khb; const char* cB = (const char*)g.Bt + (size_t)cur.pn * tstep + cur.kh * khb;
    S.a_ready(cur);
    if constexpr (SP2) {
        PG8_STAGE(PG8_SB(0, 0), cB, voffB); PG8_STAGE(PG8_SB(0, 1), cB + hstep, voffB); PG8_STAGE(PG8_SA(0, 0), cA, voffA); PG8_STAGE(PG8_SA(0, 1), cA + hstep, voffA);
        if (wr == 1) PG8_BAR;
        PG8_WAIT_V(2); PG8_BAR;
        PG8_STAGE(PG8_SB(1, 0), cB + kstep, voffB); PG8_STAGE(PG8_SA(1, 0), cA + kstep, voffA); PG8_STAGE(PG8_SB(1, 1), cB + hstep + kstep, voffB);
        PG8_WAIT_V(6); PG8_BAR;
    } else {
        PG8_STAGE(PG8_SB(0, 0), cB, voffB); PG8_STAGE(PG8_SA(0, 0), cA, voffA); PG8_STAGE(PG8_SB(0, 1), cB + hstep, voffB); PG8_STAGE(PG8_SA(0, 1), cA + hstep, voffA);
        if (wr == 1) PG8_BAR;
        PG8_WAIT_V(4); PG8_BAR;
        PG8_STAGE(PG8_SB(1, 0), cB + kstep, voffB); PG8_STAGE(PG8_SA(1, 0), cA + kstep, voffA); PG8_STAGE(PG8_SB(1, 1), cB + hstep + kstep, voffB);
        PG8_WAIT_V(6); PG8_BAR;
    }
    for (;;) {
        const bool has_next = S.next(ui + 1, nxt);
        const char* nA = has_next ? (const char*)g.A + (size_t)nxt.pm * tstep + nxt.kh * khb : cA; const char* nB = has_next ? (const char*)g.Bt + (size_t)nxt.pn * tstep + nxt.kh * khb : cB;
        for (int t = 0; t < nt; t += 2) {
            const bool last = (t == nt - 2);
            const char* a1 = cA + (size_t)(t + 1) * kstep;
            const char* a2 = last ? nA : cA + (size_t)(t + 2) * kstep; const char* b2 = last ? nB : cB + (size_t)(t + 2) * kstep;
            const char* a3 = a2 + kstep; const char* b3 = b2 + kstep;
            if (last && has_next) S.a_ready(nxt);
            if constexpr (SP2) {
            PG8_LDB(B0, 0, 0); PG8_LDB(B1, 0, 1); PG8_SCHED; PG8_LDA(At, 0, 0); PG8_STAGE(PG8_SA(1, 1), a1 + hstep, voffA);
            PG8_WAIT_V(8); PG8_WAIT_L(0); PG8_BAR; PG8_MMA(0, 0, At, B0); PG8_MMA(0, 1, At, B1); PG8_BAR; PG8_SCHED;
            PG8_LDA(At, 0, 1); PG8_STAGE(PG8_SB(0, 0), b2, voffB); PG8_STAGE(PG8_SB(0, 1), b2 + hstep, voffB); PG8_STAGE(PG8_SA(0, 0), a2, voffA);
            PG8_WAIT_V(8); PG8_WAIT_L(0); PG8_BAR; PG8_MMA(1, 0, At, B0); PG8_MMA(1, 1, At, B1); PG8_BAR; PG8_SCHED;
            PG8_LDB(B0, 1, 0); PG8_LDB(B1, 1, 1); PG8_SCHED; PG8_LDA(At, 1, 0); PG8_STAGE(PG8_SA(0, 1), a2 + hstep, voffA);
            PG8_WAIT_V(8); PG8_WAIT_L(0); PG8_BAR; PG8_MMA(0, 0, At, B0); PG8_MMA(0, 1, At, B1); PG8_BAR; PG8_SCHED;
            PG8_LDA(At, 1, 1); PG8_STAGE(PG8_SB(1, 0), b3, voffB); PG8_STAGE(PG8_SB(1, 1), b3 + hstep, voffB); PG8_STAGE(PG8_SA(1, 0), a3, voffA);
            PG8_WAIT_V(8); PG8_WAIT_L(0); PG8_BAR; PG8_MMA(1, 0, At, B0); PG8_MMA(1, 1, At, B1); PG8_BAR; PG8_SCHED;
            } else {
            PG8_LDB(B0, 0, 0); PG8_SCHED; PG8_LDA(At, 0, 0); PG8_STAGE(PG8_SA(1, 1), a1 + hstep, voffA);
            PG8_WAIT_L(8); PG8_BAR; PG8_WAIT_L(0); PG8_MMA(0, 0, At, B0); PG8_BAR; PG8_SCHED;
            PG8_LDB(B1, 0, 1); PG8_STAGE(PG8_SB(0, 0), b2, voffB);
            PG8_BAR; PG8_WAIT_L(0); PG8_MMA(0, 1, At, B1); PG8_BAR;
            PG8_LDA(At, 0, 1); PG8_STAGE(PG8_SA(0, 0), a2, voffA);
            PG8_BAR; PG8_WAIT_L(0); PG8_MMA(1, 0, At, B0); PG8_BAR; PG8_SCHED;
            PG8_STAGE(PG8_SB(0, 1), b2 + hstep, voffB);
            PG8_WAIT_V(6); PG8_BAR; PG8_MMA(1, 1, At, B1); PG8_BAR;
            PG8_LDB(B0, 1, 0); PG8_SCHED; PG8_LDA(At, 1, 0); PG8_STAGE(PG8_SA(0, 1), a2 + hstep, voffA);
            PG8_WAIT_L(8); PG8_BAR; PG8_WAIT_L(0); PG8_MMA(0, 0, At, B0); PG8_BAR; PG8_SCHED;
            PG8_LDB(B1, 1, 1); PG8_STAGE(PG8_SB(1, 0), b3, voffB);
            PG8_BAR; PG8_WAIT_L(0); PG8_MMA(0, 1, At, B1); PG8_BAR;
            PG8_LDA(At, 1, 1); PG8_STAGE(PG8_SA(1, 0), a3, voffA);
            PG8_BAR; PG8_WAIT_L(0); PG8_MMA(1, 0, At, B0); PG8_BAR; PG8_SCHED;
            PG8_STAGE(PG8_SB(1, 1), b3 + hstep, voffB);
            PG8_WAIT_V(6); PG8_BAR; PG8_MMA(1, 1, At, B1); PG8_BAR;
            }
        }
        if constexpr (ALIGN_EPI) { if (wr == 0) PG8_BAR; }
        bool keep = false;
        if constexpr (Epi::HAS_MID) { if (cur.kh == 0) { E.mid(acc, cur, wr, wc, fr, fq); keep = true; } }
        if (!keep) { if constexpr (!Epi::AFTER_DRAIN) { E(acc, cur, wr, wc, fr, fq); S.done(cur); } }
        if (!has_next) break;
        if (!keep) {
#pragma unroll
        for (int a = 0; a < 2; ++a)
#pragma unroll
            for (int b = 0; b < 2; ++b)
#pragma unroll
                for (int m = 0; m < 4; ++m)
#pragma unroll
                    for (int n = 0; n < 2; ++n) acc[a][b][m][n] = (f32x4){0.f, 0.f, 0.f, 0.f};
        }
        cur = nxt; cA = nA; cB = nB; ++ui;
        if constexpr (ALIGN_EPI) { if (wr == 1) PG8_BAR; }
    }
    PG8_WAIT_V(0);
    if constexpr (!ALIGN_EPI) { if (wr == 0) PG8_BAR; }
    PG8_BAR;
    if constexpr (Epi::AFTER_DRAIN) { E.fused(acc, cur, wr, wc, fr, fq, lds, wid, lane); S.done(cur); }
#undef PG8_SA
#undef PG8_SB
#undef PG8_STAGE
#undef PG8_LDA
#undef PG8_LDB
#undef PG8_MMA
#undef PG8_WAIT_V
#undef PG8_WAIT_L
#undef PG8_BAR
#undef PG8_SCHED
}
}

typedef unsigned short bf16;
typedef unsigned v4u __attribute__((ext_vector_type(4)));
typedef float f32x4 __attribute__((ext_vector_type(4)));
typedef short bf16x8 __attribute__((ext_vector_type(8)));
constexpr int NWAVES = 8, NTHR = 512;
#define MFMA16(a, b, c) __builtin_amdgcn_mfma_f32_16x16x32_bf16((a), (b), (c), 0, 0, 0)
#define LDS_FENCE() asm volatile("s_waitcnt lgkmcnt(0)" ::: "memory")

struct Args {
    const float* in[25]; float* out; unsigned char* ws; int ph_lo, ph_hi;
};
struct Frame {
    LAS unsigned char* lds; int tid, lane, wave, G, bid;
    const float* in[25]; float* out; unsigned char* ws;
};
constexpr size_t O_YP = 0, O_YS = (size_t)TP * DM, O_HP = O_YS + (size_t)NSMP * DM, O_S5RP = O_HP + (size_t)NB * NH * HD * HD, O_S5IP = O_S5RP + NB * SG * SN,
                 O_HS = O_S5IP + NB * SG * SN, O_S5RS = O_HS + (size_t)NSMP * NH * HD * HD, O_S5IS = O_S5RS + (size_t)NSMP * SG * SN, O_END = O_S5IS + (size_t)NSMP * SG * SN;
enum { I_XP = 0, I_XS, I_SH, I_SRE, I_SIM, I_LB, I_N1, I_WIN, I_HG, I_LRE, I_LIM, I_LDT, I_BRE, I_BIM, I_CRE, I_CIM, I_D, I_WGLU, I_WPA, I_WPB, I_WOUT, I_N2, I_WUP, I_WDN, I_NF };

DI void p0_transpose_item(const float* W, int K, int N, bf16* WT, int ldk, int koff, int glu_half, const float* gk, LAS float* scr, int item, int lane) {
    const int nblk = N / 32, kb = item / nblk, nb = item % nblk, k0 = 64 * kb, n0 = 32 * nb;
    int d0 = n0;
    if (glu_half) { const int hf = n0 >= glu_half ? 1 : 0, nn = n0 - hf * glu_half; d0 = (nn / 128) * 256 + hf * 128 + (nn % 128); }
    f32x4 v[8];
#pragma unroll
    for (int i = 0; i < 8; ++i) v[i] = *(const f32x4*)(W + (size_t)(k0 + i * 8 + (lane >> 3)) * N + n0 + 4 * (lane & 7));
#pragma unroll
    for (int i = 0; i < 8; ++i) { const int kk = i * 8 + (lane >> 3); const float gs = gk ? gk[k0 + kk] : 1.0f; LAS float* d = scr + kk * 33 + 4 * (lane & 7);
        d[0] = v[i].x * gs; d[1] = v[i].y * gs; d[2] = v[i].z * gs; d[3] = v[i].w * gs; }
    LDS_FENCE();
    const int c = lane & 7;
#pragma unroll
    for (int j = 0; j < 4; ++j) { const int n = (lane >> 3) + 8 * j; const LAS float* s = scr + (8 * c) * 33 + n;
        v4u o; o.x = pk2(s[0 * 33], s[1 * 33]); o.y = pk2(s[2 * 33], s[3 * 33]); o.z = pk2(s[4 * 33], s[5 * 33]); o.w = pk2(s[6 * 33], s[7 * 33]);
        *(v4u*)(WT + (size_t)(d0 + n) * ldk + koff + k0 + 8 * c) = o; }
    LDS_FENCE();
}
DI double exp_d(double x) {
    const double k = __builtin_rint(x * 1.4426950408889634); const double r = (x - k * 0.693147180369123816490e+00) - k * 1.90821492927058770002e-10;
    double p = 1.0 / 6227020800.0;
    p = p * r + 1.0 / 479001600.0; p = p * r + 1.0 / 39916800.0; p = p * r + 1.0 / 3628800.0; p = p * r + 1.0 / 362880.0; p = p * r + 1.0 / 40320.0; p = p * r + 1.0 / 5040.0;
    p = p * r + 1.0 / 720.0; p = p * r + 1.0 / 120.0; p = p * r + 1.0 / 24.0; p = p * r + 1.0 / 6.0; p = p * r + 0.5; p = p * r + 1.0; p = p * r + 1.0;
    const long long ki = (long long)k; const double sc = __builtin_bit_cast(double, (unsigned long long)(1023 + ki) << 52);
    return p * sc;
}
DI void sincos_d(double x, double& s, double& c) {
    const double k = __builtin_rint(x * 0.15915494309189535); double r = (x - k * 6.28318530717958623200e+00) - k * 2.44929359829470635445e-16;
    const double q = r * 0.25, q2 = q * q;
    double sp = -1.0 / 1307674368000.0; sp = sp * q2 + 1.0 / 6227020800.0; sp = sp * q2 - 1.0 / 39916800.0; sp = sp * q2 + 1.0 / 362880.0; sp = sp * q2 - 1.0 / 5040.0; sp = sp * q2 + 1.0 / 120.0; sp = sp * q2 - 1.0 / 6.0; sp = sp * q2 + 1.0;
    double cp = 1.0 / 20922789888000.0; cp = cp * q2 - 1.0 / 87178291200.0; cp = cp * q2 + 1.0 / 479001600.0; cp = cp * q2 - 1.0 / 3628800.0; cp = cp * q2 + 1.0 / 40320.0; cp = cp * q2 - 1.0 / 720.0; cp = cp * q2 + 1.0 / 24.0; cp = cp * q2 - 0.5; cp = cp * q2 + 1.0;
    double s1 = sp * q, c1 = cp;
    double s2 = 2.0 * s1 * c1, c2 = c1 * c1 - s1 * s1;
    s = 2.0 * s2 * c2; c = c2 * c2 - s2 * s2;
}
DI void p0_prologue(Frame& F) {
    LAS float* scr = (LAS float*)(F.lds + F.wave * 16384);
    const int gw = F.bid * NWAVES + F.wave, NGW = F.G * NWAVES;
    bf16* Win_t = (bf16*)(F.ws + WS_WIN); bf16* Wglu_t = (bf16*)(F.ws + WS_WGLU); bf16* Wcat_t = (bf16*)(F.ws + WS_WCAT); bf16* Wout_t = (bf16*)(F.ws + WS_WOUT);
    bf16* Wup_t = (bf16*)(F.ws + WS_WUP); bf16* Wdn_t = (bf16*)(F.ws + WS_WDN);
    constexpr int IT_IN = (DM / 64) * (NIN / 32), IT_GLU = (SW / 64) * (2 * SW / 32), IT_PA = (HW / 64) * (DM / 32), IT_PB = (SW / 64) * (DM / 32), IT_OUT = (DM / 64) * (DM / 32),
                  IT_UP = (DM / 64) * (2 * FF / 32), IT_DN = (FF / 64) * (DM / 32), NITEMS = IT_IN + IT_GLU + IT_PA + IT_PB + IT_OUT + IT_UP + IT_DN;
    for (int it = gw; it < IT_IN; it += NGW) p0_transpose_item(F.in[I_WIN], DM, NIN, Win_t, DM, 0, 0, F.in[I_N1], scr, it, F.lane);
    bf16* xb = (bf16*)(F.ws + WS_XB); float* rs1 = (float*)(F.ws + WS_RS1);
    for (int m = gw; m < MP; m += NGW) {
        unsigned long long* o8 = (unsigned long long*)(xb + (size_t)m * DM) + F.lane;
        if (m < MV) {
            const float* xr = m < TP ? F.in[I_XP] + (size_t)m * DM : F.in[I_XS] + (size_t)(m - TP) * DM;
            const f32x4* x4 = (const f32x4*)xr + F.lane; f32x4 v[8]; float s = 0.f;
#pragma unroll
            for (int j = 0; j < 8; ++j) { v[j] = x4[64 * j]; s += (v[j].x * v[j].x + v[j].y * v[j].y) + (v[j].z * v[j].z + v[j].w * v[j].w); }
            s = wave_sum(s);
            if (F.lane == 0) rs1[m] = 1.0f / sqrtf(s * (1.0f / DM) + RMS_EPS);
#pragma unroll
            for (int j = 0; j < 8; ++j) o8[64 * j] = (unsigned long long)pk2(v[j].x, v[j].y) | ((unsigned long long)pk2(v[j].z, v[j].w) << 32);
        } else {
            if (F.lane == 0) rs1[m] = 0.f;
#pragma unroll
            for (int j = 0; j < 8; ++j) o8[64 * j] = 0ull;
        }
    }
    { float* ss2 = (float*)(F.ws + WS_SS2); float* ss3 = (float*)(F.ws + WS_SS3); float* lb = (float*)(F.ws + WS_LB);
      for (int i = F.bid * NTHR + F.tid; i < MP; i += F.G * NTHR) { ss2[i] = 0.f; ss3[i] = 0.f; }
      for (int i = F.bid * NTHR + F.tid; i < HW; i += F.G * NTHR) { const float l0 = F.in[I_LB][i], l1 = F.in[I_LB][HW + i]; lb[i] = 1.0f / (1.0f + expf(l1 - l0)); } }
    for (int g = gw; g < SG; g += NGW) {
        const int n = F.lane;
        const double dt = exp_d((double)F.in[I_LDT][g]);
        const double lr = (double)F.in[I_LRE][g * SN + n], li = (double)F.in[I_LIM][g * SN + n];
        const double mag = exp_d(lr * dt); double sn, cs; sincos_d(li * dt, sn, cs);
        const double are = mag * cs, aim = mag * sn, den = lr * lr + li * li, nr = are - 1.0, ni = aim;
        const double zre = (nr * lr + ni * li) / den, zim = (ni * lr - nr * li) / den;
        double pr = are, pi = aim;
#pragma unroll 1
        for (int i = 0; i < 8; ++i) { const double t = pr * pr - pi * pi; pi = 2.0 * pr * pi; pr = t; }
        float* pa = (float*)(F.ws + WS_PARA) + (size_t)g * 256;
        pa[n] = (float)are; pa[64 + n] = (float)aim; pa[128 + n] = (float)pr; pa[192 + n] = (float)pi;
        bf16* pb = (bf16*)(F.ws + WS_PARB) + (size_t)g * 2048;
        const float* Bre = F.in[I_BRE] + ((size_t)g * SN + n) * SPC; const float* Bim = F.in[I_BIM] + ((size_t)g * SN + n) * SPC;
#pragma unroll
        for (int p = 0; p < SPC; ++p) { const double br = (double)Bre[p], bi = (double)Bim[p];
            pb[n * 16 + p] = f2bf((float)(zre * br - zim * bi)); pb[(64 + n) * 16 + p] = f2bf((float)(zre * bi + zim * br)); }
        bf16* pc = (bf16*)(F.ws + WS_PARC) + (size_t)g * 2048;
#pragma unroll
        for (int p = 0; p < SPC; ++p) { pc[p * 128 + n] = f2bf(F.in[I_CRE][((size_t)g * SPC + p) * SN + n]); pc[p * 128 + 64 + n] = f2bf(-F.in[I_CIM][((size_t)g * SPC + p) * SN + n]); }
    }
}

DI void late_convert(Frame& F) {
    LAS float* scr = (LAS float*)(F.lds + F.wave * 16384);
    bf16* Wglu_t = (bf16*)(F.ws + WS_WGLU); bf16* Wcat_t = (bf16*)(F.ws + WS_WCAT); bf16* Wout_t = (bf16*)(F.ws + WS_WOUT); bf16* Wup_t = (bf16*)(F.ws + WS_WUP); bf16* Wdn_t = (bf16*)(F.ws + WS_WDN);
    constexpr int IT_GLU = (SW / 64) * (2 * SW / 32), IT_PA = (HW / 64) * (DM / 32), IT_PB = (SW / 64) * (DM / 32), IT_OUT = (DM / 64) * (DM / 32),
                  IT_UP = (DM / 64) * (2 * FF / 32), IT_DN = (FF / 64) * (DM / 32), NLATE = IT_GLU + IT_PA + IT_PB + IT_OUT + IT_UP + IT_DN;
    unsigned* ctr = (unsigned*)(F.ws + WS_BAR) + WORKCTR_WORD;
    constexpr int CHUNK = 8;
    for (;;) {
        unsigned itu = 0; if (F.lane == 0) itu = atomicAdd(ctr, 1u);
        const int r0 = (int)__builtin_amdgcn_readfirstlane(itu) * CHUNK;
        if (r0 >= NLATE) break;
#pragma unroll 1
        for (int rr = r0; rr < r0 + CHUNK && rr < NLATE; ++rr) {
        int r = rr;
        if (r < IT_GLU) { p0_transpose_item(F.in[I_WGLU], SW, 2 * SW, Wglu_t, SW, 0, SW, nullptr, scr, r, F.lane); continue; } r -= IT_GLU;
        if (r < IT_PA) { p0_transpose_item(F.in[I_WPA], HW, DM, Wcat_t, 2048, 0, 0, nullptr, scr, r, F.lane); continue; } r -= IT_PA;
        if (r < IT_PB) { p0_transpose_item(F.in[I_WPB], SW, DM, Wcat_t, 2048, 1024, 0, nullptr, scr, r, F.lane); continue; } r -= IT_PB;
        if (r < IT_OUT) { p0_transpose_item(F.in[I_WOUT], DM, DM, Wout_t, DM, 0, 0, nullptr, scr, r, F.lane); continue; } r -= IT_OUT;
        if (r < IT_UP) { p0_transpose_item(F.in[I_WUP], DM, 2 * FF, Wup_t, DM, 0, FF, F.in[I_N2], scr, r, F.lane); continue; } r -= IT_UP;
        p0_transpose_item(F.in[I_WDN], FF, DM, Wdn_t, FF, 0, 0, nullptr, scr, r, F.lane);
        }
    }
}

DI float gelu1(float v) {
    const float av = fabsf(v), t = __builtin_amdgcn_rcpf(av * 0.2316418882f + 1.0f);
    float q = t * 0.5307027145f + (-0.7265760135f); q = q * t + 0.7107068705f; q = q * t + (-0.142248368f); q = q * t + 0.127414796f; q = q * t;
    const float e = __builtin_amdgcn_exp2f((v * v) * (-0.72134752044f));
    const float m = v * (q * e);
    return v < 0.f ? m : v - m;
}

constexpr int S5_BU_STRIDE = 132  , S5_H_STRIDE = 272  , S5_WAVE_BYTES = 16 * S5_BU_STRIDE * 4 + 16 * S5_H_STRIDE  , S5_HE_OFF = 8 * S5_WAVE_BYTES;
DI void s5_prompt_unit(Frame& F, int unit) {
    const int b = unit >> 6, g = unit & 63, lane = F.lane, w = F.wave, r16 = lane & 15, q4 = lane >> 4;
    LAS float* BU = (LAS float*)(F.lds + w * S5_WAVE_BYTES);
    LAS unsigned char* Hb = F.lds + w * S5_WAVE_BYTES + 16 * S5_BU_STRIDE * 4;
    LAS float* HE = (LAS float*)(F.lds + S5_HE_OFF);
    const bf16* Pb = (const bf16*)(F.ws + WS_PB);
    const float* pa = (const float*)(F.ws + WS_PARA) + (size_t)g * 256;
    const float ar = pa[lane], ai = pa[64 + lane], a256r = pa[128 + lane], a256i = pa[192 + lane];
    const bf16* pb = (const bf16*)(F.ws + WS_PARB) + (size_t)g * 2048; const bf16* pc = (const bf16*)(F.ws + WS_PARC) + (size_t)g * 2048;
    bf16x8 Bf[8], Cf[4], Df;
    const bf16x8 zero8 = {0, 0, 0, 0, 0, 0, 0, 0};
#pragma unroll
    for (int nb = 0; nb < 8; ++nb) Bf[nb] = q4 < 2 ? *(const bf16x8*)(pb + (nb * 16 + r16) * 16 + 8 * q4) : zero8;
#pragma unroll
    for (int ks = 0; ks < 4; ++ks) Cf[ks] = *(const bf16x8*)(pc + r16 * 128 + ks * 32 + 8 * q4);
    { const short dv = (short)f2bf(F.in[I_D][g * 16 + r16]); Df = zero8;
#pragma unroll
      for (int j = 0; j < 8; ++j) Df[j] = (8 * q4 + j == r16) ? dv : (short)0; }
    const size_t row0 = (size_t)b * TSEQ + w * 256;
    const bf16* ucol = Pb + C_U + g * 16;
    const bf16* up = ucol + (row0 + r16) * NIN + 8 * (q4 & 1);
    float hr = 0.f, hi = 0.f;
#pragma unroll 1
    for (int pass = 0; pass < 2; ++pass) {
        if (pass == 1) {
            HE[w * 128 + lane] = hr; HE[w * 128 + 64 + lane] = hi;
            __syncthreads();
            float cr = 0.f, ci = 0.f;
            for (int j = 0; j < w; ++j) { const float er = HE[j * 128 + lane], ei = HE[j * 128 + 64 + lane]; const float t = a256r * cr - a256i * ci + er; ci = a256r * ci + a256i * cr + ei; cr = t; }
            if (w == 7) { const float fr_ = a256r * cr - a256i * ci + hr, fi_ = a256r * ci + a256i * cr + hi;
                F.out[O_S5RP + ((size_t)b * SG + g) * SN + lane] = fr_; F.out[O_S5IP + ((size_t)b * SG + g) * SN + lane] = fi_; }
            hr = cr; hi = ci;
        }
        bf16x8 un0 = *(const bf16x8*)up, un1 = *(const bf16x8*)(up + 16 * NIN);
#pragma unroll 1
        for (int tile = 0; tile < 16; ++tile) {
            const size_t trow = row0 + tile * 16;
            const bf16x8 uf = q4 < 2 ? un0 : zero8;
            un0 = un1;
            if (tile < 14) un1 = *(const bf16x8*)(up + (size_t)(tile + 2) * 16 * NIN);
#pragma unroll
            for (int nb = 0; nb < 8; ++nb) { f32x4 a = {0.f, 0.f, 0.f, 0.f}; a = MFMA16(uf, Bf[nb], a);
#pragma unroll
                for (int i = 0; i < 4; ++i) BU[(4 * q4 + i) * S5_BU_STRIDE + nb * 16 + r16] = a[i]; }
            LDS_FENCE();
            if (pass == 0) {
#pragma unroll
                for (int tt = 0; tt < 16; ++tt) { const float br = BU[tt * S5_BU_STRIDE + lane], bi = BU[tt * S5_BU_STRIDE + 64 + lane];
                    const float t = ar * hr - ai * hi + br; hi = ar * hi + ai * hr + bi; hr = t; }
                LDS_FENCE();
            } else {
#pragma unroll
                for (int tt = 0; tt < 16; ++tt) { const float br = BU[tt * S5_BU_STRIDE + lane], bi = BU[tt * S5_BU_STRIDE + 64 + lane];
                    const float t = ar * hr - ai * hi + br; hi = ar * hi + ai * hr + bi; hr = t;
                    *(LAS unsigned short*)(Hb + tt * S5_H_STRIDE + lane * 2) = f2bf(hr); *(LAS unsigned short*)(Hb + tt * S5_H_STRIDE + 128 + lane * 2) = f2bf(hi); }
                LDS_FENCE();
                f32x4 y = {0.f, 0.f, 0.f, 0.f};
                y = MFMA16(uf, Df, y);
#pragma unroll
                for (int ks = 0; ks < 4; ++ks) { const bf16x8 hf = *(const LAS bf16x8*)(Hb + r16 * S5_H_STRIDE + (ks * 32 + 8 * q4) * 2); y = MFMA16(hf, Cf[ks], y); }
                bf16* Z = (bf16*)(F.ws + WS_Z);
#pragma unroll
                for (int i = 0; i < 4; ++i) Z[(trow + 4 * q4 + i) * SW + g * 16 + r16] = f2bf(gelu1(y[i]));
                LDS_FENCE();
            }
        }
    }
    __syncthreads();
}
DI void s5_sample_wave(Frame& F, int bs, int g) {
    const int lane = F.lane, r16 = lane & 15, q4 = lane >> 4;
    LAS float* hv = (LAS float*)(F.lds + F.wave * 512);
    const float* pa = (const float*)(F.ws + WS_PARA) + (size_t)g * 256; const float ar = pa[lane], ai = pa[64 + lane];
    const bf16* pb = (const bf16*)(F.ws + WS_PARB) + (size_t)g * 2048;
    const bf16* urow = (const bf16*)(F.ws + WS_PB) + (size_t)(TP + bs) * NIN + C_U + g * 16;
    const v4u u0 = *(const v4u*)urow, u1 = *(const v4u*)(urow + 8);
    const v4u bre0 = *(const v4u*)(pb + lane * 16), bre1 = *(const v4u*)(pb + lane * 16 + 8), bim0 = *(const v4u*)(pb + (64 + lane) * 16), bim1 = *(const v4u*)(pb + (64 + lane) * 16 + 8);
    float br = 0.f, bi = 0.f;
#define S5ACC(uw, rw, iw) { br += bflo(uw) * bflo(rw) + bfhi(uw) * bfhi(rw); bi += bflo(uw) * bflo(iw) + bfhi(uw) * bfhi(iw); }
    S5ACC(u0.x, bre0.x, bim0.x) S5ACC(u0.y, bre0.y, bim0.y) S5ACC(u0.z, bre0.z, bim0.z) S5ACC(u0.w, bre0.w, bim0.w)
    S5ACC(u1.x, bre1.x, bim1.x) S5ACC(u1.y, bre1.y, bim1.y) S5ACC(u1.z, bre1.z, bim1.z) S5ACC(u1.w, bre1.w, bim1.w)
#undef S5ACC
    const size_t so = ((size_t)bs * SG + g) * SN + lane;
    const float h0r = F.in[I_SRE][so], h0i = F.in[I_SIM][so];
    const float hr = ar * h0r - ai * h0i + br, hi = ar * h0i + ai * h0r + bi;
    F.out[O_S5RS + so] = hr; F.out[O_S5IS + so] = hi;
    hv[lane] = hr; hv[64 + lane] = hi;
    LDS_FENCE();
    const float* cre = F.in[I_CRE] + ((size_t)g * SPC + r16) * SN + 16 * q4; const float* cim = F.in[I_CIM] + ((size_t)g * SPC + r16) * SN + 16 * q4;
    float y = 0.f;
#pragma unroll
    for (int j = 0; j < 16; ++j) y += cre[j] * hv[16 * q4 + j] - cim[j] * hv[64 + 16 * q4 + j];
    y += __shfl_xor(y, 16); y += __shfl_xor(y, 32);
    const float uv = bf2f(urow[r16]);
    if (q4 == 0) ((bf16*)(F.ws + WS_Z))[(size_t)(TP + bs) * SW + g * 16 + r16] = f2bf(gelu1(y + F.in[I_D][g * 16 + r16] * uv));
    LDS_FENCE();
}

constexpr int HQ_STRIDE = 272, HK_STRIDE = 80;
constexpr int L_QT = 0, L_KT = 8704, L_QIN = 17408, L_KU = 26112, L_VT = 36352, L_ST = 46592, L_SC = 81408, L_PT = 83968, L_G16 = 88064, L_DEC = 88576, L_HG_END = 89088;
template <bool dry> DI void hgrn_local_unit(Frame& F, int unit) {
    const int b = unit >> 6, h = (unit >> 3) & 7, sc = unit & 7, lane = F.lane, w = F.wave, r16 = lane & 15, q4 = lane >> 4;
    LAS unsigned char* L = F.lds;
    bf16* Pb = (bf16*)(F.ws + WS_PB);
    float* OL = (float*)(F.ws + WS_OL);
    const float* lbp = (const float*)(F.ws + WS_LB) + h * HD + 2 * lane;
    const float lb0 = lbp[0], lb1 = lbp[1];
    const size_t urow0 = (size_t)b * TSEQ + sc * 256;
    f32x4 S[8];
#pragma unroll
    for (int kb = 0; kb < 8; ++kb) S[kb] = (f32x4){0.f, 0.f, 0.f, 0.f};
#pragma unroll
    for (int kb = 0; kb < 8; ++kb) *(LAS u32x2*)(L + L_ST + (w * 16 + r16) * HQ_STRIDE + (kb * 16 + 4 * q4) * 2) = (u32x2){0u, 0u};
    float Bp0 = 0.f, Bp1 = 0.f;
    unsigned qn[4], fn[4], vn[4];
#pragma unroll
    for (int j = 0; j < 4; ++j) { const bf16* rp = Pb + (urow0 + 4 * w + j) * NIN + h * HD + 2 * lane; qn[j] = *(const unsigned*)(rp + C_Q); fn[j] = *(const unsigned*)(rp + C_F); vn[j] = *(const unsigned*)(rp + C_I); }
#pragma unroll 1
    for (int c = 0; c < 8; ++c) {
        const size_t t0 = urow0 + c * 32;
        unsigned qc[4], fc[4], vc[4];
#pragma unroll
        for (int j = 0; j < 4; ++j) { qc[j] = qn[j]; fc[j] = fn[j]; vc[j] = vn[j]; }
        if (c < 7) {
#pragma unroll
            for (int j = 0; j < 4; ++j) { const bf16* rp = Pb + (t0 + 32 + 4 * w + j) * NIN + h * HD + 2 * lane; qn[j] = *(const unsigned*)(rp + C_Q); fn[j] = *(const unsigned*)(rp + C_F); vn[j] = *(const unsigned*)(rp + C_I); }
        }
        float kk0[4], kk1[4], cu0[4], cu1[4]; float g16a = 0.f, g16b = 0.f;
        { float c0 = 0.f, c1 = 0.f;
#pragma unroll
          for (int j = 0; j < 4; ++j) { const float f0 = lb0 + (1.f - lb0) * sigm(bflo(fc[j])), f1 = lb1 + (1.f - lb1) * sigm(bfhi(fc[j]));
              const float g0 = __logf(f0), g1 = __logf(f1); kk0[j] = 1.f - f0; kk1[j] = 1.f - f1; c0 += g0; c1 += g1; cu0[j] = c0; cu1[j] = c1; if (j == 0) { g16a = g0; g16b = g1; } } }
        *(LAS f32x2*)(L + L_PT + (w * 128 + 2 * lane) * 4) = (f32x2){cu0[3], cu1[3]};
        if (w == 4) *(LAS f32x2*)(L + L_G16 + 2 * lane * 4) = (f32x2){g16a, g16b};
        __syncthreads();
        float pre0 = 0.f, pre1 = 0.f, tot0 = 0.f, tot1 = 0.f, mid0 = 0.f, mid1 = 0.f;
#pragma unroll
        for (int j = 0; j < 8; ++j) { const f32x2 p = *(const LAS f32x2*)(L + L_PT + (j * 128 + 2 * lane) * 4); tot0 += p.x; tot1 += p.y; if (j < w) { pre0 += p.x; pre1 += p.y; } if (j < 4) { mid0 += p.x; mid1 += p.y; } }
        { const f32x2 p = *(const LAS f32x2*)(L + L_G16 + 2 * lane * 4); mid0 += p.x; mid1 += p.y; }
        unsigned ku0[2], ku1[2], vt0[2], vt1[2];
        { float kuA[4], kuB[4];
#pragma unroll
          for (int j = 0; j < 4; ++j) {
              const float b0 = pre0 + cu0[j], b1 = pre1 + cu1[j]; const float q0 = bflo(qc[j]), q1 = bfhi(qc[j]);
              const int trow = 4 * w + j;
              *(LAS unsigned*)(L + L_QT + trow * HQ_STRIDE + lane * 4) = pk2(q0 * fexp(b0 - mid0), q1 * fexp(b1 - mid1));
              *(LAS unsigned*)(L + L_KT + trow * HQ_STRIDE + lane * 4) = pk2(kk0[j] * fexp(mid0 - b0), kk1[j] * fexp(mid1 - b1));
              *(LAS unsigned*)(L + L_QIN + trow * HQ_STRIDE + lane * 4) = pk2(q0 * fexp(b0), q1 * fexp(b1));
              kuA[j] = kk0[j] * fexp(tot0 - b0); kuB[j] = kk1[j] * fexp(tot1 - b1);
              if (!dry) *(unsigned*)(Pb + (t0 + trow) * NIN + C_Q + h * HD + 2 * lane) = pk2(q0 * fexp(Bp0 + b0), q1 * fexp(Bp1 + b1));
          }
          ku0[0] = pk2(kuA[0], kuA[1]); ku0[1] = pk2(kuA[2], kuA[3]); ku1[0] = pk2(kuB[0], kuB[1]); ku1[1] = pk2(kuB[2], kuB[3]); }
        vt0[0] = (vc[0] & 0xffffu) | (vc[1] << 16); vt0[1] = (vc[2] & 0xffffu) | (vc[3] << 16);
        vt1[0] = (vc[0] >> 16) | (vc[1] & 0xffff0000u); vt1[1] = (vc[2] >> 16) | (vc[3] & 0xffff0000u);
        *(LAS u32x2*)(L + L_KU + (2 * lane) * HK_STRIDE + 8 * w) = (u32x2){ku0[0], ku0[1]};
        *(LAS u32x2*)(L + L_KU + (2 * lane + 1) * HK_STRIDE + 8 * w) = (u32x2){ku1[0], ku1[1]};
        *(LAS u32x2*)(L + L_VT + (2 * lane) * HK_STRIDE + 8 * w) = (u32x2){vt0[0], vt0[1]};
        *(LAS u32x2*)(L + L_VT + (2 * lane + 1) * HK_STRIDE + 8 * w) = (u32x2){vt1[0], vt1[1]};
        if (w == 0) *(LAS f32x2*)(L + L_DEC + 2 * lane * 4) = (f32x2){fexp(tot0), fexp(tot1)};
        Bp0 += tot0; Bp1 += tot1;
        __syncthreads();
        if (w < 3) {
            const int tb = w == 0 ? 0 : 1, sb = w == 2 ? 1 : 0;
            f32x4 a = {0.f, 0.f, 0.f, 0.f};
#pragma unroll
            for (int ks = 0; ks < 4; ++ks) { const bf16x8 af = *(const LAS bf16x8*)(L + L_QT + (tb * 16 + r16) * HQ_STRIDE + (ks * 32 + 8 * q4) * 2), bf = *(const LAS bf16x8*)(L + L_KT + (sb * 16 + r16) * HQ_STRIDE + (ks * 32 + 8 * q4) * 2); a = MFMA16(af, bf, a); }
#pragma unroll
            for (int i = 0; i < 4; ++i) { const int t = tb * 16 + 4 * q4 + i, s = sb * 16 + r16; *(LAS unsigned short*)(L + L_SC + t * HK_STRIDE + s * 2) = s <= t ? f2bf(a[i]) : (unsigned short)0; }
        } else if (w == 3) {
#pragma unroll
            for (int i = 0; i < 4; ++i) *(LAS unsigned short*)(L + L_SC + (4 * q4 + i) * HK_STRIDE + (16 + r16) * 2) = (unsigned short)0;
        }
        __syncthreads();
        const bf16x8 vtf = *(const LAS bf16x8*)(L + L_VT + (w * 16 + r16) * HK_STRIDE + 16 * q4);
        bf16x8 stf[4];
#pragma unroll
        for (int ks = 0; ks < 4; ++ks) stf[ks] = *(const LAS bf16x8*)(L + L_ST + (w * 16 + r16) * HQ_STRIDE + (ks * 32 + 8 * q4) * 2);
#pragma unroll
        for (int tb = 0; tb < 2; ++tb) {
            f32x4 o = {0.f, 0.f, 0.f, 0.f};
            { const bf16x8 sf = *(const LAS bf16x8*)(L + L_SC + (tb * 16 + r16) * HK_STRIDE + 16 * q4); o = MFMA16(sf, vtf, o); }
#pragma unroll
            for (int ks = 0; ks < 4; ++ks) { const bf16x8 qf = *(const LAS bf16x8*)(L + L_QIN + (tb * 16 + r16) * HQ_STRIDE + (ks * 32 + 8 * q4) * 2); o = MFMA16(qf, stf[ks], o); }
#pragma unroll
            for (int i = 0; i < 4; ++i) OL[(t0 + tb * 16 + 4 * q4 + i) * HW + h * HD + w * 16 + r16] = o[i];
        }
#pragma unroll
        for (int kb = 0; kb < 8; ++kb) {
            const f32x4 d = *(const LAS f32x4*)(L + L_DEC + (kb * 16 + 4 * q4) * 4);
            const bf16x8 kf = *(const LAS bf16x8*)(L + L_KU + (kb * 16 + r16) * HK_STRIDE + 16 * q4);
            S[kb] = MFMA16(kf, vtf, S[kb] * d);
            *(LAS u32x2*)(L + L_ST + (w * 16 + r16) * HQ_STRIDE + (kb * 16 + 4 * q4) * 2) = (u32x2){pk2(S[kb][0], S[kb][1]), pk2(S[kb][2], S[kb][3])};
        }
    }
    float* USC = (float*)(F.ws + WS_USC) + (size_t)unit * HD * HD; float* DSC = (float*)(F.ws + WS_DSC) + (size_t)unit * HD;
#pragma unroll
    for (int kb = 0; kb < 8; ++kb)
#pragma unroll
        for (int i = 0; i < 4; ++i) USC[(kb * 16 + 4 * q4 + i) * HD + w * 16 + r16] = S[kb][i];
    if (w == 0) { DSC[2 * lane] = fexp(Bp0); DSC[2 * lane + 1] = fexp(Bp1); }
    __syncthreads();
}

struct HsIn { f32x4 s[8]; unsigned short fl[8], q[8]; u32x2 iv; };
DI void hgrn_sample_load(Frame& F, int unit, HsIn& x) {
    const int bs = unit >> 3, h = unit & 7, vq = F.tid & 31, kr = F.tid >> 5;
    const bf16* prow = (const bf16*)(F.ws + WS_PB) + (size_t)(TP + bs) * NIN + h * HD;
    const float* S0 = F.in[I_SH] + ((size_t)bs * NH + h) * HD * HD;
#pragma unroll
    for (int j = 0; j < 8; ++j) { const int k = kr + 16 * j; x.s[j] = *(const f32x4*)(S0 + (size_t)k * HD + 4 * vq); x.fl[j] = prow[C_F + k]; x.q[j] = prow[C_Q + k]; }
    x.iv = *(const u32x2*)(prow + C_I + 4 * vq);
}
DI void hgrn_sample_all(Frame& F) {
    const int tid = F.tid, lane = F.lane, w = F.wave, vq = tid & 31, kr = tid >> 5;
    LAS float* part = (LAS float*)F.lds;
    int unit = F.bid; if (unit >= NSMP * NH) return;
    HsIn nx; hgrn_sample_load(F, unit, nx);
#pragma unroll 1
    for (; unit < NSMP * NH; unit += F.G) {
        const int bs = unit >> 3, h = unit & 7;
        HsIn cu = nx;
        if (unit + F.G < NSMP * NH) hgrn_sample_load(F, unit + F.G, nx);
        const bf16* prow = (const bf16*)(F.ws + WS_PB) + (size_t)(TP + bs) * NIN + h * HD;
        const float* lb = (const float*)(F.ws + WS_LB) + h * HD;
        float* S1 = F.out + O_HS + ((size_t)bs * NH + h) * HD * HD;
        const f32x4 iv = {bflo(cu.iv.x), bfhi(cu.iv.x), bflo(cu.iv.y), bfhi(cu.iv.y)};
        f32x4 o = {0.f, 0.f, 0.f, 0.f};
#pragma unroll
        for (int j = 0; j < 8; ++j) { const int k = kr + 16 * j;
            const float l = lb[k], f = l + (1.f - l) * sigm(bf2f(cu.fl[j])), q = bf2f(cu.q[j]);
            const f32x4 sv = cu.s[j] * f + iv * (1.f - f);
            *(f32x4*)(S1 + (size_t)k * HD + 4 * vq) = sv; o += sv * q; }
#pragma unroll
        for (int i = 0; i < 4; ++i) o[i] += __shfl_xor(o[i], 32);
        if (lane < 32) *(LAS f32x4*)(part + w * 128 + 4 * vq) = o;
        __syncthreads();
        if (w == 0) {
            float o0 = 0.f, o1 = 0.f;
#pragma unroll
            for (int j = 0; j < 8; ++j) { o0 += part[j * 128 + lane]; o1 += part[j * 128 + 64 + lane]; }
            const float rs = 1.0f / sqrtf(wave_sum(o0 * o0 + o1 * o1) * (1.0f / HD) + RMS_EPS);
            const float* gn = F.in[I_HG] + h * HD; bf16* oa = (bf16*)(F.ws + WS_OAB) + (size_t)(TP + bs) * DM + h * HD;
            const float g0 = bf2f(prow[C_OG + lane]), g1 = bf2f(prow[C_OG + 64 + lane]);
            oa[lane] = f2bf(o0 * rs * gn[lane] * g0 * sigm(g0)); oa[64 + lane] = f2bf(o1 * rs * gn[64 + lane] * g1 * sigm(g1));
        }
        __syncthreads();
    }
}

DI void hgrn_finish_unit(Frame& F, int unit) {
    const int b = unit >> 6, h = (unit >> 3) & 7, sc = unit & 7, lane = F.lane, w = F.wave, r16 = lane & 15, q4 = lane >> 4;
    LAS unsigned char* L = F.lds;
    const bf16* Pb = (const bf16*)(F.ws + WS_PB);
    const float* OL = (const float*)(F.ws + WS_OL);
    const size_t urow0 = (size_t)b * TSEQ + sc * 256;
    f32x4 S[8];
#pragma unroll
    for (int kb = 0; kb < 8; ++kb) S[kb] = (f32x4){0.f, 0.f, 0.f, 0.f};
    const int nprev = sc == 7 ? 8 : sc;
#pragma unroll 1
    for (int j = 0; j < nprev; ++j) {
        if (j == sc) {
#pragma unroll
            for (int kb = 0; kb < 8; ++kb) *(LAS u32x2*)(L + L_ST + (w * 16 + r16) * HQ_STRIDE + (kb * 16 + 4 * q4) * 2) = (u32x2){pk2(S[kb][0], S[kb][1]), pk2(S[kb][2], S[kb][3])};
        }
        const float* USC = (const float*)(F.ws + WS_USC) + (size_t)((unit & ~7) + j) * HD * HD; const float* DSC = (const float*)(F.ws + WS_DSC) + (size_t)((unit & ~7) + j) * HD;
#pragma unroll
        for (int kb = 0; kb < 8; ++kb) { const f32x4 d = *(const f32x4*)(DSC + kb * 16 + 4 * q4);
#pragma unroll
            for (int i = 0; i < 4; ++i) S[kb][i] = S[kb][i] * d[i] + USC[(kb * 16 + 4 * q4 + i) * HD + w * 16 + r16]; }
    }
    if (sc == 7) {
        float* HP = F.out + O_HP + ((size_t)b * NH + h) * HD * HD;
#pragma unroll
        for (int kb = 0; kb < 8; ++kb)
#pragma unroll
            for (int i = 0; i < 4; ++i) HP[(kb * 16 + 4 * q4 + i) * HD + w * 16 + r16] = S[kb][i];
    } else {
#pragma unroll
        for (int kb = 0; kb < 8; ++kb) *(LAS u32x2*)(L + L_ST + (w * 16 + r16) * HQ_STRIDE + (kb * 16 + 4 * q4) * 2) = (u32x2){pk2(S[kb][0], S[kb][1]), pk2(S[kb][2], S[kb][3])};
    }
    __syncthreads();
    const float* gn = F.in[I_HG] + h * HD; bf16* OA = (bf16*)(F.ws + WS_OAB);
#pragma unroll 1
    for (int tbi = 0; tbi < 2; ++tbi) {
        const size_t t0 = urow0 + (2 * w + tbi) * 16;
        bf16x8 qf[4];
#pragma unroll
        for (int ks = 0; ks < 4; ++ks) qf[ks] = *(const bf16x8*)(Pb + (t0 + r16) * NIN + C_Q + h * HD + ks * 32 + 8 * q4);
        f32x4 o[8]; float ssq[4] = {0.f, 0.f, 0.f, 0.f};
        const float* olp = OL + (t0 + 4 * q4) * HW + h * HD + r16;
#pragma unroll
        for (int vb = 0; vb < 8; ++vb) {
            f32x4 a = {0.f, 0.f, 0.f, 0.f};
#pragma unroll
            for (int ks = 0; ks < 4; ++ks) { const bf16x8 sf = *(const LAS bf16x8*)(L + L_ST + (vb * 16 + r16) * HQ_STRIDE + (ks * 32 + 8 * q4) * 2); a = MFMA16(qf[ks], sf, a); }
#pragma unroll
            for (int i = 0; i < 4; ++i) { a[i] += olp[i * HW + vb * 16]; ssq[i] += a[i] * a[i]; }
            o[vb] = a;
            asm volatile("" ::: "memory");
        }
#pragma unroll
        for (int i = 0; i < 4; ++i) { float s = ssq[i]; s += __shfl_xor(s, 1); s += __shfl_xor(s, 2); s += __shfl_xor(s, 4); s += __shfl_xor(s, 8); ssq[i] = 1.0f / sqrtf(s * (1.0f / HD) + RMS_EPS); }
        const bf16* ogp = Pb + (t0 + 4 * q4) * NIN + C_OG + h * HD + r16; bf16* oap = OA + (t0 + 4 * q4) * DM + h * HD + r16;
#pragma unroll
        for (int vb = 0; vb < 8; ++vb) { const float gv = gn[vb * 16 + r16];
#pragma unroll
            for (int i = 0; i < 4; ++i) { const float og = bf2f(ogp[i * NIN + vb * 16]);
                oap[i * DM + vb * 16] = f2bf(o[vb][i] * ssq[i] * gv * og * sigm(og)); }
            asm volatile("" ::: "memory"); }
    }
    __syncthreads();
}


DI f32x4 smm_core(const bf16* ap, const bf16* bp, int klen) {
    f32x4 c0 = {0.f, 0.f, 0.f, 0.f}, c1 = c0, c2 = c0, c3 = c0;
#pragma unroll 2
    for (int k = 0; k < klen; k += 128) {
        const bf16x8 a0 = *(const bf16x8*)(ap + k), a1 = *(const bf16x8*)(ap + k + 32), a2 = *(const bf16x8*)(ap + k + 64), a3 = *(const bf16x8*)(ap + k + 96);
        const bf16x8 b0 = *(const bf16x8*)(bp + k), b1 = *(const bf16x8*)(bp + k + 32), b2 = *(const bf16x8*)(bp + k + 64), b3 = *(const bf16x8*)(bp + k + 96);
        c0 = MFMA16(a0, b0, c0); c1 = MFMA16(a1, b1, c1); c2 = MFMA16(a2, b2, c2); c3 = MFMA16(a3, b3, c3);
    }
    return (c0 + c1) + (c2 + c3);
}
DI void smm_glu(Frame& F) {
    const int lane = F.lane, w = F.wave, r16 = lane & 15, q4 = lane >> 4, rb = w & 3, kh = w >> 2;
    LAS f32x4* X = (LAS f32x4*)F.lds;
    const bf16* Z = (const bf16*)(F.ws + WS_Z); const bf16* Wt = (const bf16*)(F.ws + WS_WGLU); bf16* OAB = (bf16*)(F.ws + WS_OAB);
    for (int it = F.bid; it < 128; it += F.G) {
        const int cb = it >> 1, rh = it & 1, j0 = cb * 16, row0 = TP + rh * 64 + rb * 16;
        const int wrow = (j0 >> 7) * 256 + (j0 & 127);
        const bf16* ap = Z + (size_t)(row0 + r16) * SW + kh * 512 + 8 * q4;
        const f32x4 av = smm_core(ap, Wt + (size_t)(wrow + r16) * SW + kh * 512 + 8 * q4, 512);
        const f32x4 gv = smm_core(ap, Wt + (size_t)(wrow + 128 + r16) * SW + kh * 512 + 8 * q4, 512);
        if (kh == 1) { X[(rb * 2 + 0) * 64 + lane] = av; X[(rb * 2 + 1) * 64 + lane] = gv; }
        __syncthreads();
        if (kh == 0) { const f32x4 a = av + X[(rb * 2 + 0) * 64 + lane], g = gv + X[(rb * 2 + 1) * 64 + lane];
#pragma unroll
            for (int i = 0; i < 4; ++i) OAB[(size_t)(row0 + 4 * q4 + i) * DM + HW + j0 + r16] = f2bf(a[i] * sigm(g[i])); }
        __syncthreads();
    }
}
DI void smm_merge(Frame& F) {
    const int lane = F.lane, w = F.wave, r16 = lane & 15, q4 = lane >> 4, rb = w & 3, kh = w >> 2;
    LAS f32x4* X = (LAS f32x4*)F.lds;
    const bf16* OAB = (const bf16*)(F.ws + WS_OAB); const bf16* Wt = (const bf16*)(F.ws + WS_WCAT); const bf16* Pb = (const bf16*)(F.ws + WS_PB); bf16* MRG = (bf16*)(F.ws + WS_MRG);
    for (int it = F.bid; it < 256; it += F.G) {
        const int cb = it >> 1, rh = it & 1, c0 = cb * 16, row0 = TP + rh * 64 + rb * 16;
        f32x4 v = smm_core(OAB + (size_t)(row0 + r16) * DM + kh * 1024 + 8 * q4, Wt + (size_t)(c0 + r16) * DM + kh * 1024 + 8 * q4, 1024);
#pragma unroll
        for (int i = 0; i < 4; ++i) v[i] *= sigm(bf2f(Pb[(size_t)(row0 + 4 * q4 + i) * NIN + (kh ? C_GB : C_GA) + c0 + r16]));
        if (kh == 1) X[rb * 64 + lane] = v;
        __syncthreads();
        if (kh == 0) { v += X[rb * 64 + lane];
#pragma unroll
            for (int i = 0; i < 4; ++i) MRG[(size_t)(row0 + 4 * q4 + i) * DM + c0 + r16] = f2bf(v[i]); }
        __syncthreads();
    }
}
template <bool WRITE_BF16> DI void smm_res(Frame& F, const bf16* A, const bf16* Wt, int K, const float* base  , float* out  , bf16* ob  , float* ss  ) {
    const int lane = F.lane, w = F.wave, r16 = lane & 15, q4 = lane >> 4, rb = w & 3, kh = w >> 2;
    LAS f32x4* X = (LAS f32x4*)F.lds;
    const int khl = K >> 1;
    for (int it = F.bid; it < 256; it += F.G) {
        const int cb = it >> 1, rh = it & 1, c0 = cb * 16, row0 = rh * 64 + rb * 16;
        f32x4 v = smm_core(A + (size_t)(TP + row0 + r16) * K + kh * khl + 8 * q4, Wt + (size_t)(c0 + r16) * K + kh * khl + 8 * q4, khl);
        if (kh == 1) X[rb * 64 + lane] = v;
        __syncthreads();
        if (kh == 0) { v += X[rb * 64 + lane];
#pragma unroll
            for (int i = 0; i < 4; ++i) { const size_t o = (size_t)(row0 + 4 * q4 + i) * DM + c0 + r16; const float y = base[o] + v[i]; out[o] = y; if (WRITE_BF16) ob[o] = f2bf(y);
                float s = y * y; s += __shfl_xor(s, 1); s += __shfl_xor(s, 2); s += __shfl_xor(s, 4); s += __shfl_xor(s, 8);
                if (r16 == 0) atomicAdd(ss + row0 + 4 * q4 + i, s); } }
        __syncthreads();
    }
}

DI void final_norm(Frame& F, float* dst) {
    const int gw = F.bid * NWAVES + F.wave, NGW = F.G * NWAVES;
    const float* ss3 = (const float*)(F.ws + WS_SS3); const f32x4* gf = (const f32x4*)F.in[I_NF] + F.lane;
    for (int m = gw; m < MV; m += NGW) {
        const float r = 1.0f / sqrtf(ss3[m] * (1.0f / DM) + RMS_EPS);
        const f32x4* x4 = (const f32x4*)(F.out + (size_t)m * DM) + F.lane; f32x4* y4 = (f32x4*)(dst + (size_t)m * DM) + F.lane;
#pragma unroll
        for (int j = 0; j < 8; ++j) y4[64 * j] = x4[64 * j] * r * gf[64 * j];
    }
}

#define XB_TMO      128
#define XB_XCNT(j)  (256  + 64 * (j))
#define XB_XSUB(j)  (1280 + 64 * (j))
#define XB_XGEN(j)  (2304 + 64 * (j))
#define XB_TOP      3328
#define XB_TOPGEN   3392
#define XCD_BAR_WORDS 3456
#define XB_SPIN_CAP (1u << 18)

__device__ __forceinline__ unsigned xb_ld(unsigned* p)              { return __hip_atomic_load(p, __ATOMIC_RELAXED, __HIP_MEMORY_SCOPE_AGENT); }
__device__ __forceinline__ unsigned xb_add(unsigned* p, unsigned v) { return __hip_atomic_fetch_add(p, v, __ATOMIC_RELAXED, __HIP_MEMORY_SCOPE_AGENT); }
__device__ __forceinline__ unsigned xb_xcc_id() { return (unsigned)__builtin_amdgcn_s_getreg((3 << 11) | 20) & 0xFu; }
#define XB_SPIN(cond, bar) do { unsigned _sp = 0; while (cond) { __builtin_amdgcn_s_sleep(1); \
    if ((++_sp & 255u) == 0u) { if (xb_ld(&(bar)[XB_TMO])) break; if (_sp > XB_SPIN_CAP) { atomicAdd(&(bar)[XB_TMO], 1u); break; } } } } while (0)

struct XcdBarrier {
    unsigned* bar; unsigned x;
    volatile LAS unsigned* st;
};

__device__ __forceinline__ XcdBarrier xcd_barrier_post(unsigned* bar, volatile LAS unsigned* st) {
    XcdBarrier b; b.bar = bar; b.x = xb_xcc_id(); b.st = st;
    if (threadIdx.x == 0) (void)xb_add(&bar[XB_XCNT(b.x)], 1u);
    return b;
}
__device__ __forceinline__ void xcd_barrier_complete(unsigned* bar, unsigned x, unsigned& nloc, unsigned& nx) {
    const unsigned G = gridDim.x * gridDim.y * gridDim.z;
    unsigned sum, cnt, mine, sp = 0u;
    for (;;) {
        sum = 0u; cnt = 0u; mine = 0u;
#pragma unroll
        for (unsigned j = 0; j < 16; ++j) { const unsigned c = xb_ld(&bar[XB_XCNT(j)]); sum += c; cnt += (c > 0u) ? 1u : 0u; mine = (j == x) ? c : mine; }
        if (sum == G) break;
        __builtin_amdgcn_s_sleep(1);
        if ((++sp & 255u) == 0u) { if (xb_ld(&bar[XB_TMO])) break; if (sp > XB_SPIN_CAP) { atomicAdd(&bar[XB_TMO], 1u); break; } }
    }
    nloc = mine > 0u ? mine : 1u; nx = cnt > 0u ? cnt : 1u;
}

__device__ __forceinline__ void xcd_barrier(const XcdBarrier& b) {
    asm volatile("s_waitcnt vmcnt(0)" ::: "memory");
    __syncthreads();
    if (threadIdx.x == 0) {
        unsigned* bar = b.bar;
        __builtin_amdgcn_s_waitcnt(0);
        unsigned nloc = b.st[0], nx = b.st[1];
        if (nloc == 0u) { xcd_barrier_complete(bar, b.x, nloc, nx); b.st[0] = nloc; b.st[1] = nx; }
        const unsigned old = xb_add(&bar[XB_XSUB(b.x)], 1u);
        const unsigned gen = old / nloc;
        if (old + 1u == (gen + 1u) * nloc) {
            __builtin_amdgcn_fence(__ATOMIC_RELEASE, "agent");
            asm volatile("s_waitcnt vmcnt(0)" ::: "memory");
            const unsigned og = xb_add(&bar[XB_TOP], 1u);
            const unsigned tg = og / nx;
            if (og + 1u == (tg + 1u) * nx) xb_add(&bar[XB_TOPGEN], 1u);
            else XB_SPIN(xb_ld(&bar[XB_TOPGEN]) == tg, bar);
            __builtin_amdgcn_fence(__ATOMIC_ACQUIRE, "agent");
            xb_add(&bar[XB_XGEN(b.x)], 1u);
            asm volatile("s_waitcnt vmcnt(0)" ::: "memory");
        } else {
            XB_SPIN(xb_ld(&bar[XB_XGEN(b.x)]) == gen, bar);
            __builtin_amdgcn_fence(__ATOMIC_ACQUIRE, "agent");
            asm volatile("s_waitcnt vmcnt(0)" ::: "memory");
        }
    }
    __syncthreads();
}

#ifndef N_LAUNCHES
#define N_LAUNCHES 1
#endif
constexpr int NPHASE = 9;
__global__ void __launch_bounds__(NTHR, 2) hybrid_fwd(Args args) {
    extern __shared__ __attribute__((aligned(16))) unsigned char lds_raw[];
    cg::grid_group grid = cg::this_grid();
    Frame F;
    F.lds = (LAS unsigned char*)lds_raw; F.tid = threadIdx.x; F.lane = F.tid & 63; F.wave = __builtin_amdgcn_readfirstlane(F.tid >> 6);
    F.G = gridDim.x; F.bid = blockIdx.x; F.out = args.out; F.ws = args.ws;
#pragma unroll
    for (int i = 0; i < 25; ++i) F.in[i] = args.in[i];
    const int lo = args.ph_lo, hi = args.ph_hi;
    if (hi > 1000) grid.sync();
#ifndef REPMASK
#define REPMASK 0
#endif
#ifndef SKIPMASK
#define SKIPMASK 0
#endif
#ifndef PHMASK
#define PHMASK 0x1ff
#endif
#define IN(k) (((PHMASK >> (k)) & 1) && lo <= (k) && (k) < hi)
#ifndef XSYNC
#define XSYNC 0
#endif
#ifndef CG_SEAMS
#define CG_SEAMS 0x0
#endif
    { volatile LAS unsigned* st = (volatile LAS unsigned*)(F.lds + LDS_BAR_OFF); if (F.tid < 2) st[F.tid] = 0u; __syncthreads(); }
    const XcdBarrier xbar = xcd_barrier_post((unsigned*)(F.ws + WS_BAR), (volatile LAS unsigned*)(F.lds + LDS_BAR_OFF));
#define SEAM(k) do { if (IN(k) && IN((k) + 1)) { if ((CG_SEAMS >> (k)) & 1) grid.sync(); else xcd_barrier(xbar); if ((k) == 4) { for (int xs = 0; xs < XSYNC; ++xs) xcd_barrier(xbar); } } } while (0)
    typedef pg8::bf16_t pb;
    if (IN(0)) { p0_prologue(F); if ((REPMASK >> 0) & 1) { __syncthreads(); p0_prologue(F); } } SEAM(0);
    if (IN(1)) {
        pg8::Gemm g{(const pb*)(F.ws + WS_XB), (const pb*)(F.ws + WS_WIN), MP, NIN, DM, DM}; pg8::StaticOrder S; S.init(MP, NIN, F.G, F.bid);
        pg8::EpiIn E{(pb*)(F.ws + WS_PB), (const float*)(F.ws + WS_RS1), NIN};
        pg8::gemm_phase<pg8::EpiIn, pg8::StaticOrder, true, true>(F.lds, g, S, E);
#if (REPMASK >> 1) & 1
        pg8::gemm_phase<pg8::EpiIn, pg8::StaticOrder, true, true>(F.lds, g, S, E);
#endif
        late_convert(F);
    } SEAM(1);
    if (IN(2)) {
#if (REPMASK >> 11) & 1
        for (int u = F.bid; u < NB * SG; u += F.G) s5_prompt_unit(F, u);
#endif
        for (int u = F.bid; u < NB * SG; u += F.G) s5_prompt_unit(F, u);
#if (REPMASK >> 12) & 1
        for (int u = F.bid; u < NB * NH * 8; u += F.G) hgrn_local_unit<true>(F, u);
#endif
        for (int u = F.bid; u < NB * NH * 8; u += F.G) hgrn_local_unit<false>(F, u);
#if (REPMASK >> 13) & 1
        hgrn_sample_all(F);
#endif
        hgrn_sample_all(F);
        { const int gw = F.bid * NWAVES + F.wave, NGW = F.G * NWAVES; for (int u = gw; u < NSMP * SG; u += NGW) s5_sample_wave(F, u >> 6, u & 63); }
        __syncthreads();
    } SEAM(2);
    if (IN(3)) {
#pragma unroll 1
        for (int rep = ((REPMASK >> 9) & 1) ? 0 : 1; rep < 2; ++rep)
        for (int u = F.bid; u < NB * NH * 8; u += F.G) hgrn_finish_unit(F, u);
#ifndef NO_GLU
        pg8::Gemm g{(const pb*)(F.ws + WS_Z), (const pb*)(F.ws + WS_WGLU), TP, 2 * SW, SW, SW}; pg8::StaticOrder S; S.init(TP, 2 * SW, F.G, F.bid);
        pg8::EpiGlu E{(pb*)(F.ws + WS_OAB) + HW, DM};
        pg8::gemm_phase<pg8::EpiGlu, pg8::StaticOrder, true, true>(F.lds, g, S, E);
#if (REPMASK >> 3) & 1
        pg8::gemm_phase<pg8::EpiGlu, pg8::StaticOrder, true, true>(F.lds, g, S, E);
#endif
#endif
        smm_glu(F);
#if (REPMASK >> 10) & 1
        smm_glu(F);
#endif
    } SEAM(3);
    if (IN(4)) {
        pg8::Gemm g{(const pb*)(F.ws + WS_OAB), (const pb*)(F.ws + WS_WCAT), TP, DM, DM, MERGE_MID ? DM / 2 : DM}; pg8::HalvedOrder S; S.init(TP, DM, F.G, F.bid);
        pg8::EpiMerge E{(pb*)(F.ws + WS_MRG), (const pb*)(F.ws + WS_PB), NIN, C_GA, C_GB, DM};
        pg8::gemm_phase<pg8::EpiMerge, pg8::HalvedOrder, true, true>(F.lds, g, S, E);
#if (REPMASK >> 4) & 1
        pg8::gemm_phase<pg8::EpiMerge, pg8::HalvedOrder, true, true>(F.lds, g, S, E);
#endif
        smm_merge(F);
#if (REPMASK >> 10) & 1
        smm_merge(F);
#endif
    } SEAM(4);
    if (IN(5)) {
        pg8::Gemm g{(const pb*)(F.ws + WS_MRG), (const pb*)(F.ws + WS_WOUT), TP, DM, DM, DM}; pg8::StaticOrder S; S.init(TP, DM, F.G, F.bid);
        pg8::EpiRes<true> E{F.in[I_XP], F.in[I_XS], TP, (float*)(F.ws + WS_X1), (pb*)(F.ws + WS_X1B), (float*)(F.ws + WS_SS2), MV, DM};
        pg8::gemm_phase<pg8::EpiRes<true>, pg8::StaticOrder, true, true>(F.lds, g, S, E);
#if (REPMASK >> 5) & 1
        pg8::gemm_phase<pg8::EpiRes<true>, pg8::StaticOrder, true, true>(F.lds, g, S, E);
#endif
#if (REPMASK >> 14) & 1
        smm_res<true>(F, (const bf16*)(F.ws + WS_MRG), (const bf16*)(F.ws + WS_WOUT), DM, F.in[I_XS], (float*)(F.ws + WS_X1) + (size_t)TP * DM, (bf16*)(F.ws + WS_X1B) + (size_t)TP * DM, (float*)(F.ws + WS_RS1) + TP);
#endif
        smm_res<true>(F, (const bf16*)(F.ws + WS_MRG), (const bf16*)(F.ws + WS_WOUT), DM, F.in[I_XS], (float*)(F.ws + WS_X1) + (size_t)TP * DM, (bf16*)(F.ws + WS_X1B) + (size_t)TP * DM, (float*)(F.ws + WS_SS2) + TP);
    } SEAM(5);
    if (IN(6)) {
        pg8::Gemm g{(const pb*)(F.ws + WS_X1B), (const pb*)(F.ws + WS_WUP), MP, 2 * FF, DM, DM}; pg8::StaticOrder S; S.init(MP, 2 * FF, F.G, F.bid);
        pg8::EpiSwiGlu E{(pb*)(F.ws + WS_ACT), (const float*)(F.ws + WS_SS2), FF};
        pg8::gemm_phase<pg8::EpiSwiGlu, pg8::StaticOrder, true, true>(F.lds, g, S, E);
#if (REPMASK >> 6) & 1
        pg8::gemm_phase<pg8::EpiSwiGlu, pg8::StaticOrder, true, true>(F.lds, g, S, E);
#endif
    } SEAM(6);
    if (IN(7)) {
        pg8::Gemm g{(const pb*)(F.ws + WS_ACT), (const pb*)(F.ws + WS_WDN), TP, DM, FF, FF}; pg8::StaticOrder S; S.init(TP, DM, F.G, F.bid);
        pg8::EpiRes<false> E{(const float*)(F.ws + WS_X1), (const float*)(F.ws + WS_X1), MP, F.out, nullptr, (float*)(F.ws + WS_SS3), MV, DM};
        pg8::gemm_phase<pg8::EpiRes<false>, pg8::StaticOrder, true, true>(F.lds, g, S, E);
#if (REPMASK >> 7) & 1
        pg8::gemm_phase<pg8::EpiRes<false>, pg8::StaticOrder, true, true>(F.lds, g, S, E);
#endif
#if (REPMASK >> 15) & 1
        smm_res<false>(F, (const bf16*)(F.ws + WS_ACT), (const bf16*)(F.ws + WS_WDN), FF, (const float*)(F.ws + WS_X1) + (size_t)TP * DM, F.out + (size_t)TP * DM, nullptr, (float*)(F.ws + WS_RS1) + TP);
#endif
        smm_res<false>(F, (const bf16*)(F.ws + WS_ACT), (const bf16*)(F.ws + WS_WDN), FF, (const float*)(F.ws + WS_X1) + (size_t)TP * DM, F.out + (size_t)TP * DM, nullptr, (float*)(F.ws + WS_SS3) + TP);
    } SEAM(7);
#if (REPMASK >> 8) & 1
    if (IN(8)) final_norm(F, (float*)(F.ws + WS_X1));
#endif
    if (IN(8)) final_norm(F, F.out);
#undef IN
#undef SEAM
}

extern "C" void kernel_launch(void* const* d_in, const int* in_sizes, int n_in, void* d_out, int out_size, void* d_ws, size_t ws_size, hipStream_t stream) {
    static int grid = 0;
    if (grid == 0) {
        if (n_in != 25 || ws_size < WS_END || (size_t)out_size != O_END) { fprintf(stderr, "kernel_launch: unexpected problem: n_in %d ws %zu (need %zu) out %d (expect %zu)\n", n_in, ws_size, (size_t)WS_END, out_size, (size_t)O_END); grid = -1; return; }
        int dev = 0, cus = 0, per_cu = 0;
        hipGetDevice(&dev); hipDeviceGetAttribute(&cus, hipDeviceAttributeMultiprocessorCount, dev);
        hipFuncSetAttribute((const void*)hybrid_fwd, hipFuncAttributeMaxDynamicSharedMemorySize, LDS_BYTES);
        hipOccupancyMaxActiveBlocksPerMultiprocessor(&per_cu, (const void*)hybrid_fwd, NTHR, LDS_BYTES);
        if (per_cu < 1) { fprintf(stderr, "kernel_launch: occupancy query reports %d blocks per CU\n", per_cu); per_cu = 1; }
        (void)hipGetLastError();
        grid = cus;
    }
    if (grid < 0) return;
    if (hipMemsetAsync((char*)d_ws + WS_BAR, 0, WS_BAR_BYTES, stream) != hipSuccess) { fprintf(stderr, "kernel_launch: memset of the barrier words failed\n"); return; }
    Args a{};
    for (int i = 0; i < 25; ++i) a.in[i] = (const float*)d_in[i];
    a.out = (float*)d_out; a.ws = (unsigned char*)d_ws;
#if N_LAUNCHES == 1
    a.ph_lo = 0; a.ph_hi = NPHASE;
    void* params[] = {&a};
    hipError_t e = hipLaunchCooperativeKernel((const void*)hybrid_fwd, dim3(grid), dim3(NTHR), params, LDS_BYTES, stream);
    if (e != hipSuccess) fprintf(stderr, "cooperative launch failed: %s (grid %d)\n", hipGetErrorString(e), grid);
#else
    for (int p = 0; p < NPHASE; ++p) { a.ph_lo = p; a.ph_hi = p + 1; hipLaunchKernelGGL(hybrid_fwd, dim3(grid), dim3(NTHR), LDS_BYTES, stream, a); }
#endif
}
```
